# Optimizing an MI355X kernel written in HIP

```python
import jax, jax.numpy as jnp
from jax import lax
import numpy as np

D_MODEL = 2048
BATCH = 16
SEQ = 256
DEPTH = 2
DEC_BATCH = 8
DEC_SEQ = 4096
PAST_LEN = 512

GRID_W = 64
N_EVEN = (DEPTH + 1) // 2
N_ODD = DEPTH // 2
N_MOD = 9
D_FF = 5632
EPS = 1e-6
Q_BLOCK = 128
H_A = 8
HD_A = 128
D_A = H_A * HD_A
WIN_R = 8
WIN_C = 16
QB_C = 16
KB_C = QB_C + WIN_C
D_RNN = 1024
H_B = 8
BD_B = D_RNN // H_B
CONV_W = 4
LRU_C = 8.0
H_C = 8
DK_C = 256
DV_C = 256
D_C = H_C * DV_C
CHUNK = 128
ROPE_BASE = 10000.0
IN_AB = 3 * D_A + 2 * D_RNN
IN_C = 2 * H_C * DK_C + 2 * D_C + 4 * H_C

kernel_name = 'hybrid_na_rglru_mlstm_diffusion_step'


def rms_norm(x, g):
    xf = x.astype(jnp.float32)
    y = xf * lax.rsqrt(jnp.mean(xf * xf, axis=-1, keepdims=True) + EPS)
    return (y * g.astype(jnp.float32)).astype(x.dtype)


def modulation(cond, w, b):
    m = jax.nn.silu(cond) @ w + b
    return m.reshape(cond.shape[0], N_MOD, -1)


def adaln(x, g, mod, j):
    return rms_norm(x, g) * (1.0 + mod[:, 3 * j + 1][:, None]) + mod[:, 3 * j][:, None]


def macaron_ffn(x, mod, j, g, w_gate, w_up, w_down):
    h = adaln(x, g, mod, j)
    y = (jax.nn.silu(h @ w_gate) * (h @ w_up)) @ w_down
    return x + 0.5 * mod[:, 3 * j + 2][:, None] * y


def ab_project(h, w_in, qg, kg):
    b, t, _ = h.shape
    z = h @ w_in
    qa, ka, va, xb, gb = jnp.split(z, [D_A, 2 * D_A, 3 * D_A, 3 * D_A + D_RNN], axis=-1)
    qa = rms_norm(qa.reshape(b, t, H_A, HD_A), qg)
    ka = rms_norm(ka.reshape(b, t, H_A, HD_A), kg)
    va = va.reshape(b, t, H_A, HD_A)
    return qa, ka, va, xb, gb


def ctx_attention(q, k, v):
    b, l, h, hd = q.shape
    qb = jnp.moveaxis(q.reshape(b, l // Q_BLOCK, Q_BLOCK, h, hd), 1, 0)

    def blk(qq):
        s = jnp.einsum('bqhd,bkhd->bhqk', qq, k).astype(jnp.float32) * (hd ** -0.5)
        p = jax.nn.softmax(s, axis=-1).astype(v.dtype)
        return jnp.einsum('bhqk,bkhd->bqhd', p, v)

    o = lax.map(blk, qb)
    return jnp.moveaxis(o, 0, 1).reshape(b, l, h * hd)


def neighbourhood_attention(q, k, v, ck, cv, rpb):
    b, t, h, hd = q.shape
    rows = t // GRID_W
    kr = min(WIN_R, rows)
    ncb = GRID_W // QB_C
    scale = hd ** -0.5
    starts = np.clip(np.arange(ncb) * QB_C - WIN_C // 2, 0, GRID_W - KB_C)
    qcol = np.arange(GRID_W).reshape(ncb, QB_C)
    c0 = np.clip(qcol - WIN_C // 2, 0, GRID_W - WIN_C)
    kcol = starts[:, None] + np.arange(KB_C)[None, :]
    col_ok = (kcol[:, None, :] >= c0[:, :, None]) & (kcol[:, None, :] < c0[:, :, None] + WIN_C)
    dc_idx = np.clip(kcol[:, None, :] - qcol[:, :, None] + WIN_C - 1, 0, 2 * WIN_C - 2)
    mask = col_ok[None, None, :, :, None, :]
    kg = k.reshape(b, rows, GRID_W, h, hd)
    vg = v.reshape(b, rows, GRID_W, h, hd)
    qg = jnp.moveaxis(q.reshape(b, rows, ncb, QB_C, h, hd), 1, 0)

    def one_row(args):
        r, qr = args
        r0 = jnp.clip(r - WIN_R // 2, 0, rows - kr)
        kw = lax.dynamic_slice_in_dim(kg, r0, kr, axis=1)[:, :, kcol]
        vw = lax.dynamic_slice_in_dim(vg, r0, kr, axis=1)[:, :, kcol]
        s_win = jnp.einsum('bjqhd,brjkhd->bhjqrk', qr, kw).astype(jnp.float32) * scale
        dr_idx = r0 + jnp.arange(kr) - r + (WIN_R - 1)
        bias = jnp.transpose(rpb[:, dr_idx][:, :, dc_idx], (0, 2, 3, 1, 4))
        s_win = jnp.where(mask, s_win + bias[None].astype(jnp.float32), -jnp.inf)
        s_win = s_win.reshape(b, h, ncb, QB_C, kr * KB_C)
        s_ctx = jnp.einsum('bjqhd,blhd->bhjql', qr, ck).astype(jnp.float32) * scale
        p = jax.nn.softmax(jnp.concatenate([s_win, s_ctx], axis=-1), axis=-1).astype(v.dtype)
        p_win = p[..., :kr * KB_C].reshape(b, h, ncb, QB_C, kr, KB_C)
        p_ctx = p[..., kr * KB_C:]
        o = jnp.einsum('bhjqrk,brjkhd->bjqhd', p_win, vw) + jnp.einsum('bhjql,blhd->bjqhd', p_ctx, cv)
        return o.reshape(b, GRID_W, h, hd)

    out = lax.map(one_row, (jnp.arange(rows), qg))
    return jnp.moveaxis(out, 0, 1).reshape(b, t, h * hd)


def centred_dwconv(x, w, bias):
    t = x.shape[1]
    left = (CONV_W - 1) // 2
    xp = jnp.pad(x, ((0, 0), (left, CONV_W - 1 - left), (0, 0)))
    return sum(xp[:, i:i + t] * w[i] for i in range(CONV_W)) + bias


def blockdiag(x, w, bias):
    xb = x.reshape(x.shape[0], x.shape[1], H_B, BD_B)
    return jnp.einsum('bthi,hij->bthj', xb, w).reshape(x.shape) + bias


def _lin_combine(left, right):
    a1, b1 = left
    a2, b2 = right
    return a1 * a2, a2 * b1 + b2


def rglru_scan(x, wa, ba, wx, bx, lam, h0, reverse):
    r = jax.nn.sigmoid(blockdiag(x, wa, ba).astype(jnp.float32))
    i = jax.nn.sigmoid(blockdiag(x, wx, bx).astype(jnp.float32))
    log_a = -LRU_C * r * jax.nn.softplus(-lam.astype(jnp.float32))
    a = jnp.exp(log_a)
    u = jnp.sqrt(-jnp.expm1(2.0 * log_a)) * (i * x)
    t0 = -1 if reverse else 0
    u = u.at[:, t0].add(a[:, t0] * h0.astype(jnp.float32))
    _, hs = lax.associative_scan(_lin_combine, (a, u), axis=1, reverse=reverse)
    return hs, hs[:, 0 if reverse else -1]


def rglru_branch(xb, gb, conv_w, conv_b, wa, ba, wx, bx, lam, h0):
    xc = centred_dwconv(xb, conv_w, conv_b).astype(jnp.float32)
    hf, fin_f = rglru_scan(xc, wa[0], ba[0], wx[0], bx[0], lam[0], h0[:, 0], False)
    hb, fin_b = rglru_scan(xc, wa[1], ba[1], wx[1], bx[1], lam[1], h0[:, 1], True)
    out = (hf + hb) * jax.nn.gelu(gb.astype(jnp.float32))
    return out.astype(xb.dtype), jnp.stack([fin_f, fin_b], axis=1)


def rope_2d(x):
    t, dh = x.shape[1], x.shape[-1]
    half = dh // 2
    nf = half // 2
    pos = jnp.arange(t)
    freqs = ROPE_BASE ** (-jnp.arange(nf, dtype=jnp.float32) / nf)

    def rot(xa, p):
        ang = p.astype(jnp.float32)[:, None] * freqs[None, :]
        cos = jnp.cos(ang)[None, :, None, :]
        sin = jnp.sin(ang)[None, :, None, :]
        x1, x2 = xa[..., :nf], xa[..., nf:]
        return jnp.concatenate([x1 * cos - x2 * sin, x1 * sin + x2 * cos], axis=-1)

    xf = x.astype(jnp.float32)
    return jnp.concatenate([rot(xf[..., :half], pos // GRID_W), rot(xf[..., half:], pos % GRID_W)], axis=-1)


def mlstm_scan(q, k, v, ig, lf, c0, n0, m0):
    b, t, h, _ = q.shape
    nc = t // CHUNK

    def to_chunks(a):
        return jnp.moveaxis(a.reshape(b, nc, CHUNK, *a.shape[2:]), 1, 0)

    causal = np.tril(np.ones((CHUNK, CHUNK), dtype=bool))[None, :, :, None]

    def step(carry, inp):
        cm, nv, m = carry
        qq, kk, vv, ii, ff = inp
        bc = jnp.cumsum(ff, axis=1)
        dmat = bc[:, :, None, :] - bc[:, None, :, :] + ii[:, None, :, :]
        dmat = jnp.where(causal, dmat, -jnp.inf)
        inter = bc + m[:, None, :]
        m_t = jnp.maximum(inter, jnp.max(dmat, axis=2))
        w = jnp.exp(dmat - m_t[:, :, None, :])
        g = jnp.exp(inter - m_t)
        s = jnp.einsum('bthd,bshd->btsh', qq, kk) * w
        num = jnp.einsum('btsh,bshe->bthe', s, vv) + g[..., None] * jnp.einsum('bthd,bhde->bthe', qq, cm)
        den = jnp.sum(s, axis=2) + g * jnp.einsum('bthd,bhd->bth', qq, nv)
        hout = num / jnp.maximum(jnp.abs(den), jnp.exp(-m_t))[..., None]
        bk = bc[:, -1]
        dend = bk[:, None, :] - bc + ii
        m_new = jnp.maximum(bk + m, jnp.max(dend, axis=1))
        we = jnp.exp(dend - m_new[:, None, :])
        ge = jnp.exp(bk + m - m_new)
        c_new = ge[..., None, None] * cm + jnp.einsum('bsh,bshd,bshe->bhde', we, kk, vv)
        n_new = ge[..., None] * nv + jnp.einsum('bsh,bshd->bhd', we, kk)
        return (c_new, n_new, m_new), hout

    (cf, nf, mf), hs = lax.scan(step, (c0, n0, m0), (to_chunks(q), to_chunks(k), to_chunks(v), to_chunks(ig), to_chunks(lf)))
    return jnp.moveaxis(hs, 0, 1).reshape(b, t, h, v.shape[-1]), cf, nf, mf


def mlstm_mixer(hin, w_in, b_gate, mh_g, w_out, c0, n0, m0, rotary):
    b, t, _ = hin.shape
    f32 = jnp.float32
    qk = H_C * DK_C
    z = hin @ w_in
    q, k, v, o, gates = jnp.split(z, [qk, 2 * qk, 2 * qk + D_C, 2 * qk + 2 * D_C], axis=-1)
    q = q.reshape(b, t, H_C, DK_C).astype(f32)
    k = k.reshape(b, t, H_C, DK_C).astype(f32) * (DK_C ** -0.5)
    v = v.reshape(b, t, H_C, DV_C).astype(f32)
    if rotary:
        q = rope_2d(q)
        k = rope_2d(k)
    gates = gates.reshape(b, t, 4, H_C).astype(f32) + b_gate.astype(f32)
    ig_f, lf_f = gates[:, :, 0], jax.nn.log_sigmoid(gates[:, :, 1])
    ig_b, lf_b = gates[:, :, 2], jax.nn.log_sigmoid(gates[:, :, 3])
    c0 = c0.astype(f32)
    n0 = n0.astype(f32)
    m0 = m0.astype(f32)
    hf, cf, nf, mf = mlstm_scan(q, k, v, ig_f, lf_f, c0[:, 0], n0[:, 0], m0[:, 0])
    fl = lambda a: jnp.flip(a, axis=1)
    hb, cb, nb, mb = mlstm_scan(fl(q), fl(k), fl(v), fl(ig_b), fl(lf_b), c0[:, 1], n0[:, 1], m0[:, 1])
    hsum = hf + fl(hb)
    hn = rms_norm(hsum, mh_g) * jax.nn.sigmoid(o.reshape(b, t, H_C, DV_C).astype(f32))
    y = hn.reshape(b, t, D_C).astype(hin.dtype) @ w_out
    return y, jnp.stack([cf, cb], axis=1), jnp.stack([nf, nb], axis=1), jnp.stack([mf, mb], axis=1)


def setup_inputs(seed: int = 0) -> dict:
    key = jax.random.key(seed)
    ks = iter(jax.random.split(key, 40))
    f32 = jnp.float32

    def nrm(shape, s):
        return jax.random.normal(next(ks), shape, f32) * s

    x_prompt = nrm((BATCH, SEQ, D_MODEL), 1.0)
    x_sample = nrm((DEC_BATCH, DEC_SEQ, D_MODEL), 1.0)
    cache_k = nrm((DEC_BATCH, N_EVEN, PAST_LEN, H_A, HD_A), 1.0)
    cache_v = nrm((DEC_BATCH, N_EVEN, PAST_LEN, H_A, HD_A), 1.0)
    state_lru = nrm((DEC_BATCH, N_EVEN, 2, D_RNN), 0.5)
    state_mlstm_c = nrm((DEC_BATCH, N_ODD, 2, H_C, DK_C, DV_C), 0.5)
    state_mlstm_n = nrm((DEC_BATCH, N_ODD, 2, H_C, DK_C), 0.5)
    state_mlstm_m = nrm((DEC_BATCH, N_ODD, 2, H_C), 1.0)
    c = nrm((DEC_BATCH, D_MODEL), 1.0)
    c_ctx = nrm((D_MODEL,), 1.0)
    w_mod = nrm((DEPTH, D_MODEL, N_MOD * D_MODEL), 0.5 * D_MODEL ** -0.5)
    b_mod = nrm((DEPTH, N_MOD * D_MODEL), 0.02)
    norm_g = 1.0 + nrm((DEPTH, 3, D_MODEL), 0.02)
    w_ffn_gate = nrm((DEPTH, 2, D_MODEL, D_FF), D_MODEL ** -0.5)
    w_ffn_up = nrm((DEPTH, 2, D_MODEL, D_FF), D_MODEL ** -0.5)
    w_ffn_down = nrm((DEPTH, 2, D_FF, D_MODEL), D_FF ** -0.5)
    w_in_ab = nrm((N_EVEN, D_MODEL, IN_AB), D_MODEL ** -0.5)
    w_out_ab = nrm((N_EVEN, D_A + D_RNN, D_MODEL), (D_A + D_RNN) ** -0.5)
    qn_g = 1.0 + nrm((N_EVEN, HD_A), 0.02)
    kn_g = 1.0 + nrm((N_EVEN, HD_A), 0.02)
    rpb = nrm((N_EVEN, H_A, 2 * WIN_R - 1, 2 * WIN_C - 1), 0.1)
    conv_w = nrm((N_EVEN, CONV_W, D_RNN), CONV_W ** -0.5)
    conv_b = nrm((N_EVEN, D_RNN), 0.02)
    lru_wa = nrm((N_EVEN, 2, H_B, BD_B, BD_B), BD_B ** -0.5)
    lru_ba = nrm((N_EVEN, 2, D_RNN), 0.02)
    lru_wx = nrm((N_EVEN, 2, H_B, BD_B, BD_B), BD_B ** -0.5)
    lru_bx = nrm((N_EVEN, 2, D_RNN), 0.02)
    u = jax.random.uniform(next(ks), (N_EVEN, 2, D_RNN), f32, 0.9, 0.999)
    a = u ** (1.0 / LRU_C)
    lru_lam = jnp.log(a) - jnp.log1p(-a)
    w_in_c = nrm((N_ODD, D_MODEL, IN_C), D_MODEL ** -0.5)
    b_gate_c = nrm((N_ODD, 4, H_C), 0.1) + jnp.array([-1.0, 3.0, -1.0, 3.0], f32)[None, :, None]
    mh_norm_g = 1.0 + nrm((N_ODD, H_C, DV_C), 0.02)
    w_out_c = nrm((N_ODD, D_C, D_MODEL), D_C ** -0.5)
    return {'x_prompt': x_prompt, 'x_sample': x_sample, 'cache_k': cache_k, 'cache_v': cache_v,
            'state_lru': state_lru, 'state_mlstm_c': state_mlstm_c, 'state_mlstm_n': state_mlstm_n,
            'state_mlstm_m': state_mlstm_m, 'c': c, 'c_ctx': c_ctx, 'w_mod': w_mod, 'b_mod': b_mod,
            'norm_g': norm_g, 'w_ffn_gate': w_ffn_gate, 'w_ffn_up': w_ffn_up, 'w_ffn_down': w_ffn_down,
            'w_in_ab': w_in_ab, 'w_out_ab': w_out_ab, 'qn_g': qn_g, 'kn_g': kn_g, 'rpb': rpb,
            'conv_w': conv_w, 'conv_b': conv_b, 'lru_wa': lru_wa, 'lru_ba': lru_ba, 'lru_wx': lru_wx,
            'lru_bx': lru_bx, 'lru_lam': lru_lam, 'w_in_c': w_in_c, 'b_gate_c': b_gate_c,
            'mh_norm_g': mh_norm_g, 'w_out_c': w_out_c}


def reference(x_prompt, x_sample, cache_k, cache_v, state_lru, state_mlstm_c, state_mlstm_n, state_mlstm_m, c, c_ctx, w_mod, b_mod, norm_g, w_ffn_gate, w_ffn_up, w_ffn_down, w_in_ab, w_out_ab, qn_g, kn_g, rpb, conv_w, conv_b, lru_wa, lru_ba, lru_wx, lru_bx, lru_lam, w_in_c, b_gate_c, mh_norm_g, w_out_c):
    f32 = jnp.float32
    xp, xs = x_prompt, x_sample
    bp = xp.shape[0]
    new_k, new_v, new_lru, new_c, new_n, new_m = [], [], [], [], [], []
    for l in range(DEPTH):
        j = l // 2
        mp = modulation(c_ctx[None, :], w_mod[l], b_mod[l])
        ms = modulation(c, w_mod[l], b_mod[l])
        xp = macaron_ffn(xp, mp, 0, norm_g[l, 0], w_ffn_gate[l, 0], w_ffn_up[l, 0], w_ffn_down[l, 0])
        xs = macaron_ffn(xs, ms, 0, norm_g[l, 0], w_ffn_gate[l, 0], w_ffn_up[l, 0], w_ffn_down[l, 0])
        hp = adaln(xp, norm_g[l, 1], mp, 1)
        hs = adaln(xs, norm_g[l, 1], ms, 1)
        if l % 2 == 0:
            lru_p = (conv_w[j], conv_b[j], lru_wa[j], lru_ba[j], lru_wx[j], lru_bx[j], lru_lam[j])
            qa, ka, va, xb, gb = ab_project(hp, w_in_ab[j], qn_g[j], kn_g[j])
            oa = ctx_attention(qa, ka, va)
            ob, h_fin = rglru_branch(xb, gb, *lru_p, jnp.zeros((bp, 2, D_RNN), f32))
            yp = jnp.concatenate([oa, ob], axis=-1) @ w_out_ab[j]
            new_k.append(ka)
            new_v.append(va)
            new_lru.append(h_fin.astype(xp.dtype))
            qa, ka, va, xb, gb = ab_project(hs, w_in_ab[j], qn_g[j], kn_g[j])
            oa = neighbourhood_attention(qa, ka, va, cache_k[:, j], cache_v[:, j], rpb[j])
            ob, _ = rglru_branch(xb, gb, *lru_p, state_lru[:, j])
            ys = jnp.concatenate([oa, ob], axis=-1) @ w_out_ab[j]
        else:
            zc = jnp.zeros((bp, 2, H_C, DK_C, DV_C), f32)
            zn = jnp.zeros((bp, 2, H_C, DK_C), f32)
            zm = jnp.zeros((bp, 2, H_C), f32)
            yp, cfin, nfin, mfin = mlstm_mixer(hp, w_in_c[j], b_gate_c[j], mh_norm_g[j], w_out_c[j], zc, zn, zm, False)
            new_c.append(cfin.astype(xp.dtype))
            new_n.append(nfin.astype(xp.dtype))
            new_m.append(mfin.astype(xp.dtype))
            ys, _, _, _ = mlstm_mixer(hs, w_in_c[j], b_gate_c[j], mh_norm_g[j], w_out_c[j], state_mlstm_c[:, j], state_mlstm_n[:, j], state_mlstm_m[:, j], True)
        xp = xp + mp[:, 5][:, None] * yp
        xs = xs + ms[:, 5][:, None] * ys
        xp = macaron_ffn(xp, mp, 2, norm_g[l, 2], w_ffn_gate[l, 1], w_ffn_up[l, 1], w_ffn_down[l, 1])
        xs = macaron_ffn(xs, ms, 2, norm_g[l, 2], w_ffn_gate[l, 1], w_ffn_up[l, 1], w_ffn_down[l, 1])
    return (xp, xs, jnp.stack(new_k, axis=1), jnp.stack(new_v, axis=1), jnp.stack(new_lru, axis=1), jnp.stack(new_c, axis=1), jnp.stack(new_n, axis=1), jnp.stack(new_m, axis=1))
```

```cpp
#include <hip/hip_runtime.h>
#include <cstdio>
#include <cstdint>
#define MK_ONE_LAUNCH 1

namespace pg8 {
#define PG8_LAS __attribute__((address_space(3)))
typedef unsigned short bf16_t;
typedef short bf16x8 __attribute__((ext_vector_type(8)));
typedef float f32x4 __attribute__((ext_vector_type(4)));
typedef unsigned u32x4 __attribute__((ext_vector_type(4)));
typedef int i32x4 __attribute__((ext_vector_type(4)));
typedef int i32x8 __attribute__((ext_vector_type(8)));
constexpr int BM = 256, BK = 64, HALF = 128, HTB = HALF * BK * 2  , STAGE_BYTES = 8 * HTB, NXCD = 8, WGM = 4;

__host__ __device__ __forceinline__ int lds_byte(int r, int c) { const int st = (r >> 4) * 2 + (c >> 5), rr = r & 15, cc = c & 31, ob = rr * 64 + cc * 2; return st * 1024 + (ob ^ (((ob >> 9) & 1) << 5)); }
__host__ __device__ __forceinline__ void stage_rc(int b, int& R, int& C) { const int st = b / 1024, sb = b % 1024, swz = sb ^ (((sb >> 9) & 1) << 5); R = (st >> 1) * 16 + swz / 64; C = (st & 1) * 32 + (swz % 64) / 2; }
__host__ __device__ __forceinline__ int perm32(int rho) { const int n = rho >> 4, i = rho & 15; return 8 * (i >> 2) + 4 * n + (i & 3); }

struct Unit { int pm, pn; };
struct Gemm { const bf16_t* A; const bf16_t* Bt; int M, N, K; };

struct StaticOrder {
    int nM, nN, nwg, G, c, wgm;
    __host__ __device__ void init(int M, int N, int G_, int c_, int wgm_ = WGM) { nM = M / BM; nN = N / BM; nwg = nM * nN; G = G_; c = c_; wgm = wgm_; }
    __host__ __device__ bool next(int i, Unit& u) const {
        const long L = (long)i * G + c; if (L >= nwg) return false;
        int wgid = (int)L; { const int q = nwg / NXCD, r = nwg % NXCD, xcd = wgid % NXCD, off = wgid / NXCD; wgid = (xcd < r ? xcd * (q + 1) : r * (q + 1) + (xcd - r) * q) + off; }
        const int nig = wgm * nN, gid = wgid / nig, fm = gid * wgm, gsz = (nM - fm) < wgm ? (nM - fm) : wgm;
        u.pm = fm + ((wgid % nig) % gsz); u.pn = (wgid % nig) / gsz; return true;
    }
    __device__ __forceinline__ void a_ready(const Unit&) const {}
    __device__ __forceinline__ void done(const Unit&) const {}
};

__device__ __forceinline__ unsigned cvt_pk_bf16(float lo, float hi) { unsigned r; asm volatile("v_cvt_pk_bf16_f32 %0, %1, %2" : "=v"(r) : "v"(lo), "v"(hi)); return r; }
typedef float f32x2 __attribute__((ext_vector_type(2)));
__device__ __forceinline__ f32x2 gelu_pk(f32x2 v) {
    const f32x2 av = __builtin_elementwise_abs(v), d = av * 0.2316418882f + 1.0f;
    f32x2 t; t.x = __builtin_amdgcn_rcpf(d.x); t.y = __builtin_amdgcn_rcpf(d.y);
    f32x2 q = t * 0.5307027145f + (-0.7265760135f); q = q * t + 0.7107068705f; q = q * t + (-0.142248368f); q = q * t + 0.127414796f; q = q * t;
    const f32x2 s = (v * v) * (-0.72134752044f);
    f32x2 e; e.x = __builtin_amdgcn_exp2f(s.x); e.y = __builtin_amdgcn_exp2f(s.y);
    const f32x2 m = v * (q * e), r = v - m;
    f32x2 o; o.x = v.x < 0.f ? m.x : r.x; o.y = v.y < 0.f ? m.y : r.y; return o;
}

template <int ACT  > struct EpiBf16 {
    static constexpr bool PERM = true, AFTER_DRAIN = false; static_assert(ACT == 0 || ACT == 1, "EpiBf16: ACT is 0 (none) or 1 (gelu_pk)");
    bf16_t* O; int ldc; const float* bias; int split_cols; size_t split_stride; float scale0;
    __device__ __forceinline__ void operator()(const f32x4 (&acc)[2][2][4][2], const Unit& u, int wr, int wc, int fr, int fq) const {
        const int row0 = u.pm * BM + wr * 64 + fr; int colt = u.pn * BM; bf16_t* base = O;
        float sc = 1.f; if (split_cols) { const int t = colt / split_cols; base += (size_t)t * split_stride; colt -= t * split_cols; if (t == 0) sc = scale0; }
        const int col0 = colt + wc * 32 + 8 * fq, bcol0 = u.pn * BM + wc * 32 + 8 * fq;
        f32x4 bv[2][2];
#pragma unroll
        for (int bj = 0; bj < 2; ++bj)
#pragma unroll
            for (int n = 0; n < 2; ++n) bv[bj][n] = bias ? *(const f32x4*)(bias + bcol0 + bj * HALF + 4 * n) : (f32x4){0.f, 0.f, 0.f, 0.f};
#pragma unroll
        for (int ai = 0; ai < 2; ++ai)
#pragma unroll
            for (int m = 0; m < 4; ++m) { bf16_t* rowp = base + (size_t)(row0 + ai * HALF + m * 16) * ldc + col0;
#pragma unroll
                for (int bj = 0; bj < 2; ++bj) { f32x4 v0 = acc[ai][bj][m][0] + bv[bj][0], v1 = acc[ai][bj][m][1] + bv[bj][1];
                    if (ACT == 1) { f32x2 a = gelu_pk((f32x2){v0[0], v0[1]}), b = gelu_pk((f32x2){v0[2], v0[3]}), c = gelu_pk((f32x2){v1[0], v1[1]}), d = gelu_pk((f32x2){v1[2], v1[3]});
                        v0 = (f32x4){a.x, a.y, b.x, b.y}; v1 = (f32x4){c.x, c.y, d.x, d.y}; }
                    v0 = v0 * sc; v1 = v1 * sc; u32x4 w; w.x = cvt_pk_bf16(v0[0], v0[1]); w.y = cvt_pk_bf16(v0[2], v0[3]); w.z = cvt_pk_bf16(v1[0], v1[1]); w.w = cvt_pk_bf16(v1[2], v1[3]);
                    *(u32x4*)(rowp + bj * HALF) = w; } }
    }
};

constexpr int EP_M = 36864, EP_D = 2048, EP_FF = 5632, EP_MODS = 9 * 2048;
__device__ __forceinline__ int set_of_pm(int pm) { return pm < 16 ? 0 : 1 + ((pm - 16) >> 4); }
__device__ __forceinline__ unsigned pk4_fp8(float a, float b, float c, float d) { int w = 0; w = __builtin_amdgcn_cvt_pk_fp8_f32(a, b, w, false); w = __builtin_amdgcn_cvt_pk_fp8_f32(c, d, w, true); return (unsigned)w; }
struct EpiGluQ {
    static constexpr bool PERM = true, AFTER_DRAIN = false;
    unsigned char* O; const float* sa; const float* sb;
    __device__ __forceinline__ void operator()(const f32x4 (&acc)[2][2][4][2], const Unit& u, int wr, int wc, int fr, int fq) const {
        const int row0 = u.pm * BM + wr * 64 + fr, col0 = u.pn * HALF + wc * 32 + 8 * fq, brow = u.pn * BM + wc * 32 + 8 * fq;
        float sr[2][4];
#pragma unroll
        for (int ai = 0; ai < 2; ++ai)
#pragma unroll
            for (int m = 0; m < 4; ++m) sr[ai][m] = sa[row0 + ai * HALF + m * 16];
        const f32x4 sg0 = *(const f32x4*)(sb + brow), sg1 = *(const f32x4*)(sb + brow + 4), su0 = *(const f32x4*)(sb + brow + HALF), su1 = *(const f32x4*)(sb + brow + HALF + 4);
#pragma unroll
        for (int ai = 0; ai < 2; ++ai)
#pragma unroll
            for (int m = 0; m < 4; ++m) { const int row = row0 + ai * HALF + m * 16; const float s = sr[ai][m];
                float v[8];
#pragma unroll
                for (int n = 0; n < 2; ++n) { const i32x4 gi = __builtin_bit_cast(i32x4, acc[ai][0][m][n]), ui = __builtin_bit_cast(i32x4, acc[ai][1][m][n]);
#pragma unroll
                    for (int j = 0; j < 4; ++j) { const float g = (float)gi[j] * s * (n ? sg1[j] : sg0[j]), up = (float)ui[j] * s * (n ? su1[j] : su0[j]); v[4 * n + j] = g * up * __builtin_amdgcn_rcpf(1.0f + __expf(-g)); } }
                typedef unsigned u32x2 __attribute__((ext_vector_type(2)));
                *(u32x2*)(O + (size_t)row * EP_FF + col0) = (u32x2){pk4_fp8(v[0], v[1], v[2], v[3]), pk4_fp8(v[4], v[5], v[6], v[7])}; }
    }
};

template <bool F32> struct ResRaw { typedef f32x4 T; };
template <> struct ResRaw<false> { typedef unsigned T __attribute__((ext_vector_type(2))); };
template <bool BASE_F32, bool OUT_F32, bool QS, bool I8A = false> struct EpiRes2 {
    static constexpr bool PERM = false, AFTER_DRAIN = false;
    const void* base_p; const void* base_s; void* out; const float* modg; const float* sb; const float* sa; int bpitch, opitch; float coef;
    __device__ __forceinline__ void operator()(const f32x4 (&acc)[2][2][4][2], const Unit& u, int wr, int wc, int fr, int fq) const {
        typedef unsigned u32x2_ __attribute__((ext_vector_type(2)));
        typedef typename ResRaw<BASE_F32>::T RawT;
        constexpr int NB = 8, D = BASE_F32 ? 2 : 4;
        const int row0 = u.pm * BM + wr * 64 + fr, col0 = u.pn * BM + wc * 32 + 4 * fq;
        const float* gp = modg + (size_t)set_of_pm(u.pm) * EP_MODS + col0;
        const float* bf = (const float*)(u.pm < 16 ? base_p : base_s); const bf16_t* bh = (const bf16_t*)base_p;
        float rsv[NB];
        if (I8A) {
#pragma unroll
            for (int k = 0; k < NB; ++k) rsv[k] = sa[row0 + (k >> 2) * HALF + (k & 3) * 16]; }
        f32x4 gv[2][2], sv[2][2];
#pragma unroll
        for (int bj = 0; bj < 2; ++bj)
#pragma unroll
            for (int n = 0; n < 2; ++n) { gv[bj][n] = *(const f32x4*)(gp + bj * HALF + n * 16); if (QS) sv[bj][n] = *(const f32x4*)(sb + col0 + bj * HALF + n * 16); }
#pragma unroll
        for (int g = 0; g < NB / D; ++g) {
            RawT raw[D][2][2];
#pragma unroll
            for (int d = 0; d < D; ++d) { const int k = g * D + d, row = row0 + (k >> 2) * HALF + (k & 3) * 16;
#pragma unroll
                for (int bj = 0; bj < 2; ++bj)
#pragma unroll
                    for (int n = 0; n < 2; ++n) { const int col = col0 + bj * HALF + n * 16;
                        if (BASE_F32) raw[d][bj][n] = *(const RawT*)(bf + (size_t)row * EP_D + col); else raw[d][bj][n] = *(const RawT*)(bh + (size_t)row * bpitch + col); } }
            if (g == 0) {
#pragma unroll
                for (int bj = 0; bj < 2; ++bj)
#pragma unroll
                    for (int n = 0; n < 2; ++n) { gv[bj][n] = gv[bj][n] * coef; if (QS) gv[bj][n] = gv[bj][n] * sv[bj][n]; } }
#pragma unroll
            for (int d = 0; d < D; ++d) { const int k = g * D + d, ai = k >> 2, m = k & 3, row = row0 + ai * HALF + m * 16; const float rs = I8A ? rsv[k] : 1.0f;
#pragma unroll
                for (int bj = 0; bj < 2; ++bj)
#pragma unroll
                    for (int n = 0; n < 2; ++n) { const int col = col0 + bj * HALF + n * 16; f32x4 b;
                        if constexpr (BASE_F32) b = raw[d][bj][n];
                        else { const u32x2_ w = raw[d][bj][n]; b = (f32x4){__uint_as_float(w.x << 16), __uint_as_float(w.x & 0xffff0000u), __uint_as_float(w.y << 16), __uint_as_float(w.y & 0xffff0000u)}; }
                        f32x4 av = acc[ai][bj][m][n];
                        if (I8A) { const i32x4 iv = __builtin_bit_cast(i32x4, av); av = (f32x4){(float)iv[0], (float)iv[1], (float)iv[2], (float)iv[3]} * rs; }
                        f32x4 o = b + gv[bj][n] * av;
#ifdef PROBE_YSCALE
                        if (OUT_F32) o = o * PROBE_YSCALE;
#endif
                        if (OUT_F32) *(f32x4*)((float*)out + (size_t)row * EP_D + col) = o;
                        else *(u32x2_*)((bf16_t*)out + (size_t)row * opitch + col) = (u32x2_){cvt_pk_bf16(o[0], o[1]), cvt_pk_bf16(o[2], o[3])}; } }
        }
    }
};
template <bool I8, int WHICH> struct EpiProj {
    static constexpr bool PERM = true, AFTER_DRAIN = false;
    bf16_t* dst; float* gates; const float* sa; const float* sb;
    __device__ __forceinline__ void operator()(const f32x4 (&acc)[2][2][4][2], const Unit& u, int wr, int wc, int fr, int fq) const {
        const int row0 = u.pm * BM + wr * 64 + fr;
        if (!I8 && WHICH == 1 && u.pn == 16) {
            if (wc == 0) {
#pragma unroll
                for (int ai = 0; ai < 2; ++ai)
#pragma unroll
                    for (int m = 0; m < 4; ++m) { float* gp = gates + (size_t)(row0 + ai * HALF + m * 16) * 32 + 8 * fq; *(f32x4*)gp = acc[ai][0][m][0]; *(f32x4*)(gp + 4) = acc[ai][0][m][1]; }
            }
            return;
        }
        bf16_t* base; int pitch;
        if (WHICH == 0) { pitch = 5120; base = dst + (I8 ? (u.pn < 4 ? 256 * u.pn : 3072 + 256 * (u.pn - 4)) : 1024 + 256 * u.pn); }
        else { pitch = EP_D; base = dst + (size_t)(I8 ? (u.pn < 8 ? 0 : 3) : 1 + (u.pn >> 3)) * ((size_t)EP_M * EP_D) + 256 * (u.pn & 7); }
        const int col0 = wc * 32 + 8 * fq, brow = u.pn * BM + wc * 32 + 8 * fq;
        f32x4 sc[2][2]; float sr[2][4];
        if (I8) {
#pragma unroll
            for (int ai = 0; ai < 2; ++ai)
#pragma unroll
                for (int m = 0; m < 4; ++m) sr[ai][m] = sa[row0 + ai * HALF + m * 16];
#pragma unroll
            for (int bj = 0; bj < 2; ++bj) { sc[bj][0] = *(const f32x4*)(sb + brow + bj * HALF); sc[bj][1] = *(const f32x4*)(sb + brow + bj * HALF + 4); } }
#pragma unroll
        for (int ai = 0; ai < 2; ++ai)
#pragma unroll
            for (int m = 0; m < 4; ++m) { const int row = row0 + ai * HALF + m * 16; bf16_t* rowp = base + (size_t)row * pitch + col0; const float s = I8 ? sr[ai][m] : 1.0f;
#pragma unroll
                for (int bj = 0; bj < 2; ++bj) { f32x4 v0, v1;
                    if (I8) { const i32x4 i0 = __builtin_bit_cast(i32x4, acc[ai][bj][m][0]), i1 = __builtin_bit_cast(i32x4, acc[ai][bj][m][1]);
                        v0 = (f32x4){(float)i0[0], (float)i0[1], (float)i0[2], (float)i0[3]} * sc[bj][0] * s; v1 = (f32x4){(float)i1[0], (float)i1[1], (float)i1[2], (float)i1[3]} * sc[bj][1] * s; }
                    else { v0 = acc[ai][bj][m][0]; v1 = acc[ai][bj][m][1]; }
                    u32x4 w; w.x = cvt_pk_bf16(v0[0], v0[1]); w.y = cvt_pk_bf16(v0[2], v0[3]); w.z = cvt_pk_bf16(v1[0], v1[1]); w.w = cvt_pk_bf16(v1[2], v1[3]);
                    *(u32x4*)(rowp + bj * HALF) = w; } }
    }
};

template <class Epi, class Sched, bool ALIGN_EPI = false, bool SP2 = false, int MODE = 0  >
__device__ __forceinline__ void gemm_phase(PG8_LAS unsigned char* lds, const Gemm g, const Sched& S, const Epi& E) {
    int tid_ = threadIdx.x; asm volatile("" : "+v"(tid_));
    const int tid = tid_, wid = __builtin_amdgcn_readfirstlane(tid >> 6), lane = tid & 63, wr = wid >> 2, wc = wid & 3, fr = lane & 15, fq = lane >> 4;
    const int K = g.K, nt = K / BK;
    unsigned voffA[2], voffB[2];
#pragma unroll
    for (int i = 0; i < 2; ++i) { int R, C; stage_rc(tid * 16 + i * 8192, R, C); const int Rb = Epi::PERM ? ((R & ~31) + perm32(R & 31)) : R;
        voffA[i] = (unsigned)(R * K + C) * 2u; voffB[i] = (unsigned)(Rb * K + C) * 2u; }
    const size_t kstep = (size_t)(BK * 2);
    const size_t hstep = (size_t)HALF * K * 2;
    const size_t tstep = 2 * hstep;
    const unsigned ldsw = (unsigned)wid * 1024u;
    const int aoff = lds_byte(wr * 64 + fr, fq * 8), boff = lds_byte(wc * 32 + fr, fq * 8);
#define PG8_SA(b, h) (((b) * 2 + (h)) * HTB)
#define PG8_SB(b, h) ((4 + (b) * 2 + (h)) * HTB)
#define PG8_STAGE(bufoff, gbase, voff) do { _Pragma("unroll") for (int _i = 0; _i < 2; ++_i) \
        __builtin_amdgcn_global_load_lds((const unsigned*)((const char*)(gbase) + (voff)[_i]), (PG8_LAS unsigned*)(lds + (bufoff) + ldsw + _i * 8192), 16, 0, 0); } while (0)
#define PG8_LDA(dst, b, h) do { if constexpr (MODE == 2) { _Pragma("unroll") for (int m = 0; m < 4; ++m) { const i32x4 lo_ = *(const PG8_LAS i32x4*)(lds + PG8_SA(b, h) + aoff + m * 2048), hi_ = *(const PG8_LAS i32x4*)(lds + PG8_SA(b, h) + aoff + m * 2048 + 1024); dst##8[m] = __builtin_shufflevector(lo_, hi_, 0, 1, 2, 3, 4, 5, 6, 7); } } \
        else { _Pragma("unroll") for (int m = 0; m < 4; ++m) _Pragma("unroll") for (int k = 0; k < 2; ++k) dst[m][k] = *(const PG8_LAS bf16x8*)(lds + PG8_SA(b, h) + aoff + m * 2048 + k * 1024); } } while (0)
#define PG8_LDB(dst, b, h) do { if constexpr (MODE == 2) { _Pragma("unroll") for (int n = 0; n < 2; ++n) { const i32x4 lo_ = *(const PG8_LAS i32x4*)(lds + PG8_SB(b, h) + boff + n * 2048), hi_ = *(const PG8_LAS i32x4*)(lds + PG8_SB(b, h) + boff + n * 2048 + 1024); dst##8[n] = __builtin_shufflevector(lo_, hi_, 0, 1, 2, 3, 4, 5, 6, 7); } } \
        else { _Pragma("unroll") for (int n = 0; n < 2; ++n) _Pragma("unroll") for (int k = 0; k < 2; ++k) dst[n][k] = *(const PG8_LAS bf16x8*)(lds + PG8_SB(b, h) + boff + n * 2048 + k * 1024); } } while (0)
#define PG8_MMA(ai, bj, At, Bt) do { __builtin_amdgcn_s_setprio(1); _Pragma("unroll") for (int m = 0; m < 4; ++m) _Pragma("unroll") for (int n = 0; n < 2; ++n) { \
        if constexpr (MODE == 0) { _Pragma("unroll") for (int k = 0; k < 2; ++k) acc[ai][bj][m][n] = __builtin_amdgcn_mfma_f32_16x16x32_bf16(Bt[n][k], At[m][k], acc[ai][bj][m][n], 0, 0, 0); } \
        else if constexpr (MODE == 1) { _Pragma("unroll") for (int k = 0; k < 2; ++k) acc[ai][bj][m][n] = __builtin_bit_cast(f32x4, __builtin_amdgcn_mfma_i32_16x16x64_i8(__builtin_bit_cast(i32x4, Bt[n][k]), __builtin_bit_cast(i32x4, At[m][k]), __builtin_bit_cast(i32x4, acc[ai][bj][m][n]), 0, 0, 0)); } \
        else { asm volatile("v_mfma_f32_16x16x128_f8f6f4 %0, %1, %2, %0" : "+v"(acc[ai][bj][m][n]) : "v"(Bt##8[n]), "v"(At##8[m])); } } \
        __builtin_amdgcn_s_setprio(0); } while (0)
#define PG8_WAIT_V(n) asm volatile("s_waitcnt vmcnt(" #n ")" ::: "memory")
#define PG8_WAIT_L(n) asm volatile("s_waitcnt lgkmcnt(" #n ")" ::: "memory")
#define PG8_BAR __builtin_amdgcn_s_barrier()
#define PG8_SCHED __builtin_amdgcn_sched_barrier(0)
    Unit cur, nxt; int ui = 0;
    if (!S.next(0, cur)) return;
    f32x4 acc[2][2][4][2];
#pragma unroll
    for (int a = 0; a < 2; ++a)
#pragma unroll
        for (int b = 0; b < 2; ++b)
#pragma unroll
            for (int m = 0; m < 4; ++m)
#pragma unroll
                for (int n = 0; n < 2; ++n) acc[a][b][m][n] = (f32x4){0.f, 0.f, 0.f, 0.f};
    bf16x8 At[4][2], B0[2][2], B1[2][2]; i32x8 At8[4], B08[2], B18[2];
    const char* cA = (const char*)g.A + (size_t)cur.pm * tstep; const char* cB = (const char*)g.Bt + (size_t)cur.pn * tstep;
    S.a_ready(cur);
    if constexpr (SP2) {
        PG8_STAGE(PG8_SB(0, 0), cB, voffB); PG8_STAGE(PG8_SB(0, 1), cB + hstep, voffB); PG8_STAGE(PG8_SA(0, 0), cA, voffA); PG8_STAGE(PG8_SA(0, 1), cA + hstep, voffA);
        if (wr == 1) PG8_BAR;
        PG8_WAIT_V(2); PG8_BAR;
        PG8_STAGE(PG8_SB(1, 0), cB + kstep, voffB); PG8_STAGE(PG8_SA(1, 0), cA + kstep, voffA); PG8_STAGE(PG8_SB(1, 1), cB + hstep + kstep, voffB);
        PG8_WAIT_V(6); PG8_BAR;
    } else {
        PG8_STAGE(PG8_SB(0, 0), cB, voffB); PG8_STAGE(PG8_SA(0, 0), cA, voffA); PG8_STAGE(PG8_SB(0, 1), cB + hstep, voffB); PG8_STAGE(PG8_SA(0, 1), cA + hstep, voffA);
        if (wr == 1) PG8_BAR;
        PG8_WAIT_V(4); PG8_BAR;
        PG8_STAGE(PG8_SB(1, 0), cB + kstep, voffB); PG8_STAGE(PG8_SA(1, 0), cA + kstep, voffA); PG8_STAGE(PG8_SB(1, 1), cB + hstep + kstep, voffB);
        PG8_WAIT_V(6); PG8_BAR;
    }
    for (;;) {
        const bool has_next = S.next(ui + 1, nxt);
        const char* nA = has_next ? (const char*)g.A + (size_t)nxt.pm * tstep : cA; const char* nB = has_next ? (const char*)g.Bt + (size_t)nxt.pn * tstep : cB;
        for (int t = 0; t < nt; t += 2) {
            const bool last = (t == nt - 2);
            const char* a1 = cA + (size_t)(t + 1) * kstep;
            const char* a2 = last ? nA : cA + (size_t)(t + 2) * kstep; const char* b2 = last ? nB : cB + (size_t)(t + 2) * kstep;
            const char* a3 = a2 + kstep; const char* b3 = b2 + kstep;
            if (last && has_next) S.a_ready(nxt);
            if constexpr (SP2) {
            PG8_LDB(B0, 0, 0); PG8_LDB(B1, 0, 1); PG8_SCHED; PG8_LDA(At, 0, 0); PG8_STAGE(PG8_SA(1, 1), a1 + hstep, voffA);
            PG8_WAIT_V(8); PG8_WAIT_L(0); PG8_BAR; PG8_MMA(0, 0, At, B0); PG8_MMA(0, 1, At, B1); PG8_BAR; PG8_SCHED;
            PG8_LDA(At, 0, 1); PG8_STAGE(PG8_SB(0, 0), b2, voffB); PG8_STAGE(PG8_SB(0, 1), b2 + hstep, voffB); PG8_STAGE(PG8_SA(0, 0), a2, voffA);
            PG8_WAIT_V(8); PG8_WAIT_L(0); PG8_BAR; PG8_MMA(1, 0, At, B0); PG8_MMA(1, 1, At, B1); PG8_BAR; PG8_SCHED;
            PG8_LDB(B0, 1, 0); PG8_LDB(B1, 1, 1); PG8_SCHED; PG8_LDA(At, 1, 0); PG8_STAGE(PG8_SA(0, 1), a2 + hstep, voffA);
            PG8_WAIT_V(8); PG8_WAIT_L(0); PG8_BAR; PG8_MMA(0, 0, At, B0); PG8_MMA(0, 1, At, B1); PG8_BAR; PG8_SCHED;
            PG8_LDA(At, 1, 1); PG8_STAGE(PG8_SB(1, 0), b3, voffB); PG8_STAGE(PG8_SB(1, 1), b3 + hstep, voffB); PG8_STAGE(PG8_SA(1, 0), a3, voffA);
            PG8_WAIT_V(8); PG8_WAIT_L(0); PG8_BAR; PG8_MMA(1, 0, At, B0); PG8_MMA(1, 1, At, B1); PG8_BAR; PG8_SCHED;
            } else {
            PG8_LDB(B0, 0, 0); PG8_SCHED; PG8_LDA(At, 0, 0); PG8_STAGE(PG8_SA(1, 1), a1 + hstep, voffA);
            PG8_WAIT_L(8); PG8_BAR; PG8_WAIT_L(0); PG8_MMA(0, 0, At, B0); PG8_BAR; PG8_SCHED;
            PG8_LDB(B1, 0, 1); PG8_STAGE(PG8_SB(0, 0), b2, voffB);
            PG8_BAR; PG8_WAIT_L(0); PG8_MMA(0, 1, At, B1); PG8_BAR;
            PG8_LDA(At, 0, 1); PG8_STAGE(PG8_SA(0, 0), a2, voffA);
            PG8_BAR; PG8_WAIT_L(0); PG8_MMA(1, 0, At, B0); PG8_BAR; PG8_SCHED;
            PG8_STAGE(PG8_SB(0, 1), b2 + hstep, voffB);
            PG8_WAIT_V(6); PG8_BAR; PG8_MMA(1, 1, At, B1); PG8_BAR;
            PG8_LDB(B0, 1, 0); PG8_SCHED; PG8_LDA(At, 1, 0); PG8_STAGE(PG8_SA(0, 1), a2 + hstep, voffA);
            PG8_WAIT_L(8); PG8_BAR; PG8_WAIT_L(0); PG8_MMA(0, 0, At, B0); PG8_BAR; PG8_SCHED;
            PG8_LDB(B1, 1, 1); PG8_STAGE(PG8_SB(1, 0), b3, voffB);
            PG8_BAR; PG8_WAIT_L(0); PG8_MMA(0, 1, At, B1); PG8_BAR;
            PG8_LDA(At, 1, 1); PG8_STAGE(PG8_SA(1, 0), a3, voffA);
            PG8_BAR; PG8_WAIT_L(0); PG8_MMA(1, 0, At, B0); PG8_BAR; PG8_SCHED;
            PG8_STAGE(PG8_SB(1, 1), b3 + hstep, voffB);
            PG8_WAIT_V(6); PG8_BAR; PG8_MMA(1, 1, At, B1); PG8_BAR;
            }
        }
        if constexpr (MODE == 2) asm volatile("s_nop 15\n\ts_nop 15" ::: "memory");
        if constexpr (ALIGN_EPI) { if (wr == 0) PG8_BAR; }
        if constexpr (!Epi::AFTER_DRAIN) { E(acc, cur, wr, wc, fr, fq); S.done(cur); }
        if (!has_next) break;
#pragma unroll
        for (int a = 0; a < 2; ++a)
#pragma unroll
            for (int b = 0; b < 2; ++b)
#pragma unroll
                for (int m = 0; m < 4; ++m)
#pragma unroll
                    for (int n = 0; n < 2; ++n) acc[a][b][m][n] = (f32x4){0.f, 0.f, 0.f, 0.f};
        cur = nxt; cA = nA; cB = nB; ++ui;
        if constexpr (ALIGN_EPI) { if (wr == 1) PG8_BAR; }
    }
    PG8_WAIT_V(0);
    if constexpr (!ALIGN_EPI) { if (wr == 0) PG8_BAR; }
    PG8_BAR;
    if constexpr (Epi::AFTER_DRAIN) { E.fused(acc, cur, wr, wc, fr, fq, lds, wid, lane); S.done(cur); }
#undef PG8_SA
#undef PG8_SB
#undef PG8_STAGE
#undef PG8_LDA
#undef PG8_LDB
#undef PG8_MMA
#undef PG8_WAIT_V
#undef PG8_WAIT_L
#undef PG8_BAR
#undef PG8_SCHED
}
}

#ifndef PG8_SP2
#define PG8_SP2 true
#endif
#ifndef PG8_ALIGN
#define PG8_ALIGN true
#endif
#define GAS __attribute__((address_space(1)))
#define LAS __attribute__((address_space(3)))
typedef unsigned short bf16;
typedef unsigned v4u __attribute__((ext_vector_type(4)));
typedef unsigned v2u __attribute__((ext_vector_type(2)));
typedef float f32x4 __attribute__((ext_vector_type(4)));
typedef short bf16x8 __attribute__((ext_vector_type(8)));
#define LDS_WAIT() asm volatile("s_waitcnt lgkmcnt(0)" ::: "memory")
#define VM_WAIT() asm volatile("s_waitcnt vmcnt(0)" ::: "memory")
#define MFMA16(a, b, c) __builtin_amdgcn_mfma_f32_16x16x32_bf16((a), (b), (c), 0, 0, 0)

constexpr int NWAVES = 8, NTHR = 512;
constexpr int DM = 2048, MP = 4096, MS = 32768, MT = 36864, DFF = 5632, MODS = 9 * 2048;
constexpr float EPS = 1e-6f;
constexpr int N_PHASES = 24;
#ifndef MK_ONE_LAUNCH
#define MK_ONE_LAUNCH 1
#endif
constexpr size_t MiB = 1u << 20;
constexpr size_t WS_CTL = 0, CTL_ZERO_BYTES = 32768;
constexpr size_t WS_MOD = 1 * MiB, WS_ROPE = 3 * MiB, WS_LW = 4 * MiB, WS_KC = 5 * MiB, WS_VCT = 13 * MiB, WS_SUMW = 21 * MiB, WS_SUMB = 39 * MiB, WS_GATES = 42 * MiB;
constexpr size_t WS_W1A = 48 * MiB, WS_W2A = 92 * MiB, WS_W1B = 114 * MiB, WS_W2B = 158 * MiB, WS_WINAB = 180 * MiB, WS_WOUTAB = 200 * MiB, WS_WINC = 208 * MiB, WS_WOUTC = 241 * MiB;
constexpr size_t WS_H = 256 * MiB, WS_BIG = 400 * MiB;
constexpr size_t WS_ACT = WS_BIG;
constexpr size_t WS_Z = WS_BIG, WS_VTS = 760 * MiB, WS_VTP = 824 * MiB;
constexpr size_t WS_PL = WS_BIG, WS_KT = 976 * MiB, WS_HB = 1120 * MiB;
constexpr size_t WS_END = 1264 * MiB;
constexpr size_t WS_XB2 = 656 * MiB;
constexpr int XPITCH = 4096;
constexpr size_t WS_SA = 3 * MiB + 65536, WS_SB1 = 3 * MiB + 262144, WS_SB2 = 3 * MiB + 393216;
constexpr size_t WS_H8M = 1120 * MiB;
constexpr size_t WS_WQAB = 70 * MiB, WS_WQC = 76 * MiB;
constexpr size_t WS_SBQAB = 3 * MiB + 458752, WS_SBQC = 3 * MiB + 475136, WS_SBOC = 3 * MiB + 491520;
constexpr size_t WS_WQOC = 84 * MiB;
constexpr size_t PLANE = (size_t)MT * DM;
constexpr int CW_BAR = 4096;
constexpr int SCR_BYTES = 147456, MISC_OFF = SCR_BYTES, LDS_BYTES = SCR_BYTES + 256;

__device__ __forceinline__ float bf2f(unsigned short b) { return __uint_as_float(((unsigned)b) << 16); }
__device__ __forceinline__ unsigned f2bf(float f) { unsigned u = __float_as_uint(f); return (u + 0x7fffu + ((u >> 16) & 1u)) >> 16; }
typedef float f32x2c_t __attribute__((ext_vector_type(2))); typedef __bf16 bf16x2c_t __attribute__((ext_vector_type(2)));
__device__ __forceinline__ unsigned pk2(float lo, float hi) { const f32x2c_t v = {lo, hi}; return __builtin_bit_cast(unsigned, __builtin_convertvector(v, bf16x2c_t)); }
typedef unsigned u32x2s __attribute__((ext_vector_type(2)));
__device__ __forceinline__ float rows_max(float v) { u32x2s r = __builtin_amdgcn_permlane16_swap(__float_as_uint(v), __float_as_uint(v), false, false); v = fmaxf(__uint_as_float(r.x), __uint_as_float(r.y));
    r = __builtin_amdgcn_permlane32_swap(__float_as_uint(v), __float_as_uint(v), false, false); return fmaxf(__uint_as_float(r.x), __uint_as_float(r.y)); }
__device__ __forceinline__ float rows_sum(float v) { u32x2s r = __builtin_amdgcn_permlane16_swap(__float_as_uint(v), __float_as_uint(v), false, false); v = __uint_as_float(r.x) + __uint_as_float(r.y);
    r = __builtin_amdgcn_permlane32_swap(__float_as_uint(v), __float_as_uint(v), false, false); return __uint_as_float(r.x) + __uint_as_float(r.y); }
#define DPP_MOV(v, ctrl) __builtin_bit_cast(float, __builtin_amdgcn_update_dpp(0, __builtin_bit_cast(int, (v)), (ctrl), 0xf, 0xf, true))
__device__ __forceinline__ float wave_sum(float v) { v += DPP_MOV(v, 0xB1); v += DPP_MOV(v, 0x4E); v += DPP_MOV(v, 0x141); v += DPP_MOV(v, 0x140); return rows_sum(v); }
__device__ __forceinline__ float wave_max(float v) { v = fmaxf(v, DPP_MOV(v, 0xB1)); v = fmaxf(v, DPP_MOV(v, 0x4E)); v = fmaxf(v, DPP_MOV(v, 0x141)); v = fmaxf(v, DPP_MOV(v, 0x140)); return rows_max(v); }
__device__ __forceinline__ int set_of_row(int m) { return m < MP ? 0 : 1 + ((m - MP) >> 12); }
__device__ __forceinline__ float sigmoidf_(float x) { return __builtin_amdgcn_rcpf(1.0f + __expf(-x)); }

#define XB_TMO      128
#define XB_XCNT(j)  (256  + 64 * (j))
#define XB_XSUB(j)  (1280 + 64 * (j))
#define XB_XGEN(j)  (2304 + 64 * (j))
#define XB_TOP      3328
#define XB_TOPGEN   3392
#define XCD_BAR_WORDS 3456
#define XB_SPIN_CAP (1u << 18)

__device__ __forceinline__ unsigned xb_ld(unsigned* p)              { return __hip_atomic_load(p, __ATOMIC_RELAXED, __HIP_MEMORY_SCOPE_AGENT); }
__device__ __forceinline__ unsigned xb_add(unsigned* p, unsigned v) { return __hip_atomic_fetch_add(p, v, __ATOMIC_RELAXED, __HIP_MEMORY_SCOPE_AGENT); }
__device__ __forceinline__ unsigned xb_xcc_id() { return (unsigned)__builtin_amdgcn_s_getreg((3 << 11) | 20) & 0xFu; }
#define XB_SPIN(cond, bar) do { unsigned _sp = 0; while (cond) { __builtin_amdgcn_s_sleep(1); \
    if ((++_sp & 255u) == 0u) { if (xb_ld(&(bar)[XB_TMO])) break; if (_sp > XB_SPIN_CAP) { atomicAdd(&(bar)[XB_TMO], 1u); break; } } } } while (0)

struct XcdBarrier {
    unsigned* bar; unsigned x;
    volatile LAS unsigned* st;
};

__device__ __forceinline__ XcdBarrier xcd_barrier_post(unsigned* bar, volatile LAS unsigned* st) {
    XcdBarrier b; b.bar = bar; b.x = xb_xcc_id(); b.st = st;
    if (threadIdx.x == 0) (void)xb_add(&bar[XB_XCNT(b.x)], 1u);
    return b;
}
__device__ __forceinline__ void xcd_barrier_complete(unsigned* bar, unsigned x, unsigned& nloc, unsigned& nx) {
    const unsigned G = gridDim.x * gridDim.y * gridDim.z;
    unsigned sum, cnt, mine, sp = 0u;
    for (;;) {
        sum = 0u; cnt = 0u; mine = 0u;
#pragma unroll
        for (unsigned j = 0; j < 16; ++j) { const unsigned c = xb_ld(&bar[XB_XCNT(j)]); sum += c; cnt += (c > 0u) ? 1u : 0u; mine = (j == x) ? c : mine; }
        if (sum == G) break;
        __builtin_amdgcn_s_sleep(1);
        if ((++sp & 255u) == 0u) { if (xb_ld(&bar[XB_TMO])) break; if (sp > XB_SPIN_CAP) { atomicAdd(&bar[XB_TMO], 1u); break; } }
    }
    nloc = mine > 0u ? mine : 1u; nx = cnt > 0u ? cnt : 1u;
}

__device__ __forceinline__ void xcd_barrier(const XcdBarrier& b) {
    asm volatile("s_waitcnt vmcnt(0)" ::: "memory");
    __syncthreads();
    if (threadIdx.x == 0) {
        unsigned* bar = b.bar;
        __builtin_amdgcn_s_waitcnt(0);
        unsigned nloc = b.st[0], nx = b.st[1];
        if (nloc == 0u) { xcd_barrier_complete(bar, b.x, nloc, nx); b.st[0] = nloc; b.st[1] = nx; }
        const unsigned old = xb_add(&bar[XB_XSUB(b.x)], 1u);
        const unsigned gen = old / nloc;
        if (old + 1u == (gen + 1u) * nloc) {
            __builtin_amdgcn_fence(__ATOMIC_RELEASE, "agent");
            asm volatile("s_waitcnt vmcnt(0)" ::: "memory");
            const unsigned og = xb_add(&bar[XB_TOP], 1u);
            const unsigned tg = og / nx;
            if (og + 1u == (tg + 1u) * nx) xb_add(&bar[XB_TOPGEN], 1u);
            else XB_SPIN(xb_ld(&bar[XB_TOPGEN]) == tg, bar);
            __builtin_amdgcn_fence(__ATOMIC_ACQUIRE, "agent");
            xb_add(&bar[XB_XGEN(b.x)], 1u);
            asm volatile("s_waitcnt vmcnt(0)" ::: "memory");
        } else {
            XB_SPIN(xb_ld(&bar[XB_XGEN(b.x)]) == gen, bar);
            __builtin_amdgcn_fence(__ATOMIC_ACQUIRE, "agent");
            asm volatile("s_waitcnt vmcnt(0)" ::: "memory");
        }
    }
    __syncthreads();
}


struct Args { const float* in[32]; float* out; unsigned char* ws; int ph_lo, ph_hi; };

__device__ __forceinline__ void xpose_sub(const float* src, int ldw, bf16* dst, int K, int k0, bool zero, LAS float* scr, int lane, float wsc = 1.0f) {
    const int c = lane & 7;
    if (zero) {
#pragma unroll
        for (int j = 0; j < 4; ++j) { const int n = (lane >> 3) + 8 * j; *(v4u*)(dst + (size_t)n * K + k0 + 8 * c) = (v4u){0u, 0u, 0u, 0u}; }
        return;
    }
    { float t32[32]; const float* p = src + (size_t)(k0 + (lane >> 5)) * ldw + (lane & 31);
#pragma unroll
      for (int i = 0; i < 32; ++i) t32[i] = p[(size_t)(2 * i) * ldw];
#pragma unroll
      for (int i = 0; i < 32; ++i) scr[(2 * i + (lane >> 5)) * 33 + (lane & 31)] = t32[i]; }
    LDS_WAIT(); asm volatile("" ::: "memory");
#pragma unroll
    for (int j = 0; j < 4; ++j) { const int n = (lane >> 3) + 8 * j; const LAS float* s = scr + (8 * c) * 33 + n;
        v4u o; o.x = pk2(s[0 * 33] * wsc, s[1 * 33] * wsc); o.y = pk2(s[2 * 33] * wsc, s[3 * 33] * wsc); o.z = pk2(s[4 * 33] * wsc, s[5 * 33] * wsc); o.w = pk2(s[6 * 33] * wsc, s[7 * 33] * wsc);
        *(v4u*)(dst + (size_t)n * K + k0 + 8 * c) = o; }
    LDS_WAIT(); asm volatile("" ::: "memory");
}
__device__ __forceinline__ void xpose_run(const float* s0, const float* s1, bf16* dst, int ldw, int K, int nblk, int mode, int sub, LAS float* scr, int lane) {
    const int kb = sub / nblk, nb = sub - kb * nblk, n0 = nb * 32;
    const float* sp; bool zero = false;
    if (mode == 1) { const int pn = n0 >> 8, r = n0 & 255; sp = (r < 128 ? s0 : s1) + pn * 128 + (r & 127); }
    else { sp = s0 + n0; if (mode == 2 && n0 >= 8224) zero = true; }
    xpose_sub(sp, ldw, dst + (size_t)n0 * K, K, kb * 64, zero, scr, lane);
}
template <int FMT>
__device__ __forceinline__ void quant_item(const float* sp, int ldw, int K, unsigned char* dst  , float* sbv  , LAS unsigned char* lds, int wave, int lane, int tid) {
    LAS float* scr = (LAS float*)(lds + wave * 8448); LAS float* pm = (LAS float*)(lds + 67584);
    const int kper = K >> 3, nsub = kper >> 6, kbase = wave * kper;
    const float QMAX = FMT == 1 ? 127.0f : 240.0f;
    float mx = 0.f;
    for (int st = 0; st < nsub; ++st) { const float* p = sp + (size_t)(kbase + 64 * st + (lane >> 5)) * ldw + (lane & 31);
        float t32[32];
#pragma unroll
        for (int i = 0; i < 32; ++i) t32[i] = p[(size_t)(2 * i) * ldw];
#pragma unroll
        for (int i = 0; i < 32; ++i) mx = fmaxf(mx, fabsf(t32[i])); }
    mx = fmaxf(mx, __shfl_xor(mx, 32));
    if (lane < 32) pm[wave * 32 + lane] = mx;
    __syncthreads();
    float inv[4];
#pragma unroll
    for (int j = 0; j < 4; ++j) { const int n = (lane >> 3) + 8 * j; float m = pm[n];
#pragma unroll
        for (int w = 1; w < 8; ++w) m = fmaxf(m, pm[w * 32 + n]);
        inv[j] = m > 0.f ? QMAX / m : 0.f; }
    if (tid < 32) { float m = pm[tid];
#pragma unroll
        for (int w = 1; w < 8; ++w) m = fmaxf(m, pm[w * 32 + tid]);
        sbv[tid] = m / QMAX; }
    const int c = lane & 7;
    for (int st = 0; st < nsub; ++st) { const int k0 = kbase + 64 * st;
        { float t32[32]; const float* p = sp + (size_t)(k0 + (lane >> 5)) * ldw + (lane & 31);
#pragma unroll
          for (int i = 0; i < 32; ++i) t32[i] = p[(size_t)(2 * i) * ldw];
#pragma unroll
          for (int i = 0; i < 32; ++i) scr[(2 * i + (lane >> 5)) * 33 + (lane & 31)] = t32[i]; }
        LDS_WAIT(); asm volatile("" ::: "memory");
#pragma unroll
        for (int j = 0; j < 4; ++j) { const int n = (lane >> 3) + 8 * j; const LAS float* s = scr + (8 * c) * 33 + n; float v[8];
#pragma unroll
            for (int e = 0; e < 8; ++e) v[e] = s[e * 33] * inv[j];
            v2u o;
            if (FMT == 1) { int q[8];
#pragma unroll
                for (int e = 0; e < 8; ++e) q[e] = (int)rintf(v[e]) & 0xff;
                o.x = (unsigned)(q[0] | (q[1] << 8) | (q[2] << 16) | (q[3] << 24)); o.y = (unsigned)(q[4] | (q[5] << 8) | (q[6] << 16) | (q[7] << 24)); }
            else { o.x = pg8::pk4_fp8(v[0], v[1], v[2], v[3]); o.y = pg8::pk4_fp8(v[4], v[5], v[6], v[7]); }
            *(v2u*)(dst + (size_t)n * K + k0 + 8 * c) = o; }
        LDS_WAIT(); asm volatile("" ::: "memory"); }
    __syncthreads();
}
__device__ __forceinline__ void ffn_quant_item(const Args& a, int l, int f, int slot, int item, LAS unsigned char* lds, int wave, int lane, int tid) {
    const size_t wo = (size_t)(l * 2 + f) * DM * DFF;
    if (item < 352) { const int n0 = 32 * item, pn = n0 >> 8, r = n0 & 255; const float* sp = (r < 128 ? a.in[13] : a.in[14]) + wo + pn * 128 + (r & 127);
        quant_item<1>(sp, DFF, DM, a.ws + (slot ? WS_W1B : WS_W1A) + (size_t)n0 * DM, (float*)(a.ws + WS_SB1) + slot * 11264 + n0, lds, wave, lane, tid); }
    else { const int n0 = 32 * (item - 352);
        quant_item<2>(a.in[15] + wo + n0, DM, DFF, a.ws + (slot ? WS_W2B : WS_W2A) + (size_t)n0 * DFF, (float*)(a.ws + WS_SB2) + slot * 2048 + n0, lds, wave, lane, tid); }
}
__device__ __forceinline__ void mod_item(const Args& a, int item, float* MOD, LAS unsigned char* lds, int wave, int lane, int tid) {
    const int l = item / 144, cb = item % 144;
    LAS float* sil = (LAS float*)(lds + wave * 9216);
    LAS float* part = (LAS float*)(lds + 73728);
    const float* cvec = a.in[8]; const float* cctx = a.in[9];
    for (int i = lane; i < 9 * 256; i += 64) { const int s = i >> 8, kk = i & 255, k = wave * 256 + kk; const float c = s == 0 ? cctx[k] : cvec[(s - 1) * DM + k]; sil[i] = c * sigmoidf_(c); }
    LDS_WAIT(); asm volatile("" ::: "memory");
    typedef float f32x2 __attribute__((ext_vector_type(2)));
    f32x2 acc[9];
#pragma unroll
    for (int s = 0; s < 9; ++s) acc[s] = (f32x2){0.f, 0.f};
    const float* wp = a.in[10] + ((size_t)l * DM + wave * 256) * (9 * DM) + cb * 128 + 2 * lane;
    for (int k16 = 0; k16 < 16; ++k16) {
        f32x2 w[16];
#pragma unroll
        for (int j = 0; j < 16; ++j) w[j] = *(const f32x2*)(wp + (size_t)(16 * k16 + j) * (9 * DM));
#pragma unroll
        for (int s = 0; s < 9; ++s) {
#pragma unroll
            for (int q = 0; q < 4; ++q) { const f32x4 c = *(const LAS f32x4*)(sil + s * 256 + 16 * k16 + 4 * q);
                acc[s] += w[4 * q] * c[0]; acc[s] += w[4 * q + 1] * c[1]; acc[s] += w[4 * q + 2] * c[2]; acc[s] += w[4 * q + 3] * c[3]; } }
    }
#pragma unroll
    for (int s = 0; s < 9; ++s) *(LAS f32x2*)(part + (wave * 9 + s) * 128 + 2 * lane) = acc[s];
    __syncthreads();
    for (int i = tid; i < 9 * 128; i += NTHR) { const int s = i >> 7, col = i & 127; float v = a.in[11][l * (9 * DM) + cb * 128 + col];
#pragma unroll
        for (int w = 0; w < 8; ++w) v += part[(w * 9 + s) * 128 + col];
        MOD[((size_t)l * 9 + s) * MODS + cb * 128 + col] = v; }
    __syncthreads();
}
__device__ __forceinline__ void tail_ids(int nwg, int G, int& ib, int& nidle) { const int rem = nwg % G, c = (int)blockIdx.x; if (rem == 0) { ib = c; nidle = G; } else if (c >= rem) { ib = c - rem; nidle = G - rem; } else { ib = -1; nidle = G - rem; } }
constexpr int P0_ITEMS = 3040;
__device__ __forceinline__ void p0_item(const Args& a, int it, LAS unsigned char* lds, int wave, int lane, int tid) {
    unsigned char* ws = a.ws; LAS float* scr = (LAS float*)(lds + wave * 8448);
    int r = it;
    if (r < 128) { ffn_quant_item(a, 0, r >> 6, r >> 6, 352 + (r & 63), lds, wave, lane, tid); return; } r -= 128;
    if (r < 288) { mod_item(a, r, (float*)(ws + WS_MOD), lds, wave, lane, tid); return; } r -= 288;
    if (r < 704) { const int f = r >= 352 ? 1 : 0; ffn_quant_item(a, 0, f, f, r - 352 * f, lds, wave, lane, tid); return; } r -= 704;
    if (r < 128) { const int n0 = 32 * r; const int col = n0 < 2048 ? n0 : 6144 + (n0 - 2048);
        quant_item<1>(a.in[28] + col, 8224, DM, ws + WS_WQC + (size_t)n0 * DM, (float*)(ws + WS_SBQC) + n0, lds, wave, lane, tid); return; } r -= 128;
    if (r < 64) { const int n0 = 32 * r; quant_item<1>(a.in[31] + n0, DM, DM, ws + WS_WQOC + (size_t)n0 * DM, (float*)(ws + WS_SBOC) + n0, lds, wave, lane, tid); return; } r -= 64;
    if (r < 640) { xpose_run(a.in[16], nullptr, (bf16*)(ws + WS_WINAB), 5120, DM, 160, 0, r * 8 + wave, scr, lane); return; } r -= 640;
    if (r < 256) { xpose_run(a.in[17], nullptr, (bf16*)(ws + WS_WOUTAB), DM, DM, 64, 0, r * 8 + wave, scr, lane); return; } r -= 256;
    if (r < 544) {
        const int sub = r * 8 + wave, kb = sub / 136, nb = sub - kb * 136, n0 = nb * 32; const int col = n0 < 4096 ? 2048 + n0 : 8192 + (n0 - 4096);
        xpose_sub(a.in[28] + col, 8224, (bf16*)(ws + WS_WINC) + (size_t)n0 * DM, DM, kb * 64, col >= 8224, scr, lane); return; } r -= 544;
    if (r < 32) { const int which = r >> 4, dh = r & 15;
        { const int sub = wave, kb = sub >> 2, nb = sub & 3;
          xpose_sub(a.in[which ? 25 : 23] + (size_t)dh * 16384 + nb * 32, 128, (bf16*)(ws + WS_LW) + (size_t)(dh * 2 + which) * 16384 + (size_t)(nb * 32) * 128, 128, kb * 64, false, scr, lane, -1.4426950408889634f); } return; } r -= 32;
    { const int b = r >> 5;
      xpose_run(a.in[3] + (size_t)b * 512 * 1024, nullptr, (bf16*)(ws + WS_VCT) + (size_t)b * 1024 * 512, 1024, 512, 32, 0, (r & 31) * 8 + wave, scr, lane); }
}
__device__ __forceinline__ void phase_p0(const Args& a, LAS unsigned char* lds, int G, int wave, int lane, int tid) {
    unsigned* ctr = (unsigned*)(a.ws + WS_CTL) + 64; volatile LAS int* qs = (volatile LAS int*)(lds + MISC_OFF + 64);
    if (tid == 0) qs[0] = (int)__hip_atomic_fetch_add(ctr, 1u, __ATOMIC_RELAXED, __HIP_MEMORY_SCOPE_AGENT);
    __syncthreads();
    int it = qs[0];
    while (it < P0_ITEMS) {
        __syncthreads();
        int nxt = 0; if (tid == 0) nxt = (int)__hip_atomic_fetch_add(ctr, 1u, __ATOMIC_RELAXED, __HIP_MEMORY_SCOPE_AGENT);
        p0_item(a, it, lds, wave, lane, tid);
        if (tid == 0) qs[0] = nxt;
        __syncthreads();
        it = qs[0];
    }
    unsigned char* ws = a.ws;
    { const f32x4* src = (const f32x4*)a.in[2]; v2u* dst = (v2u*)(ws + WS_KC);
      for (int i = blockIdx.x * NTHR + tid; i < 1048576; i += G * NTHR) { const f32x4 v = src[i]; dst[i] = (v2u){pk2(v[0], v[1]), pk2(v[2], v[3])}; } }
    { float* R = (float*)(ws + WS_ROPE);
      for (int i = blockIdx.x * NTHR + tid; i < 4096; i += G * NTHR) { const int p = i >> 6, fi = i & 63; const float fr = powf(10000.0f, -(float)fi * (1.0f / 64.0f)); const float ang = (float)p * fr;
          R[2 * i] = cosf(ang); R[2 * i + 1] = sinf(ang); } }
}
#define NORM_REQ(mm) do { if (FIRST) { const float* xr_ = (mm) < MP ? a.in[0] + (size_t)(mm) * DM : a.in[1] + (size_t)((mm) - MP) * DM; _Pragma("unroll") for (int q = 0; q < 8; ++q) nf[q] = *(const f32x4*)(xr_ + 4 * lane + 256 * q); } \
        else { const bf16* xr_ = COPY ? (const bf16*)(a.ws + WS_XB2) + (size_t)(mm) * DM : (const bf16*)a.out + (size_t)(mm) * XPITCH; _Pragma("unroll") for (int q = 0; q < 8; ++q) nh[q] = *(const v2u*)(xr_ + 4 * lane + 256 * q); } } while (0)
template <bool FIRST, bool COPY = false  >
__device__ __forceinline__ void norm_pass(const Args& a, int l, int j, int G, int wave, int lane) {
    const float* MOD = (const float*)(a.ws + WS_MOD) + (size_t)l * 9 * MODS;
    const float* gvec = a.in[12] + (size_t)(l * 3 + j) * DM;
    bf16* H = (bf16*)(a.ws + WS_H);
    const int NGW = G * NWAVES, gw = blockIdx.x * NWAVES + wave, rpw = (MT + NGW - 1) / NGW;
    int cur = -1; f32x4 ge[8], sh[8];
    const int m_end = (gw + 1) * rpw < MT ? (gw + 1) * rpw : MT;
    f32x4 nf[8]; v2u nh[8];
    if (gw * rpw < m_end) NORM_REQ(gw * rpw);
    for (int m = gw * rpw; m < m_end; ++m) {
        const int s = set_of_row(m);
        if (s != cur) { cur = s; const float* sc = MOD + (size_t)s * MODS + (3 * j + 1) * DM; const float* sf = MOD + (size_t)s * MODS + (3 * j) * DM;
#pragma unroll
            for (int q = 0; q < 8; ++q) { const int c = 4 * lane + 256 * q; const f32x4 g4 = *(const f32x4*)(gvec + c), s4 = *(const f32x4*)(sc + c); ge[q] = g4 * (s4 + 1.0f); sh[q] = *(const f32x4*)(sf + c); } }
        f32x4 v[8]; float ss = 0.f;
        if (FIRST) {
#pragma unroll
            for (int q = 0; q < 8; ++q) v[q] = nf[q]; }
        else {
#pragma unroll
            for (int q = 0; q < 8; ++q) { const v2u w = nh[q]; v[q] = (f32x4){__uint_as_float(w.x << 16), __uint_as_float(w.x & 0xffff0000u), __uint_as_float(w.y << 16), __uint_as_float(w.y & 0xffff0000u)}; } }
        if (m + 1 < m_end) NORM_REQ(m + 1);
#pragma unroll
        for (int q = 0; q < 8; ++q) ss += (v[q][0] * v[q][0] + v[q][1] * v[q][1]) + (v[q][2] * v[q][2] + v[q][3] * v[q][3]);
        const float rstd = rsqrtf(wave_sum(ss) * (1.0f / DM) + EPS);
        bf16* orow = H + (size_t)m * DM;
#pragma unroll
        for (int q = 0; q < 8; ++q) { const f32x4 o = v[q] * rstd * ge[q] + sh[q]; *(v2u*)(orow + 4 * lane + 256 * q) = (v2u){pk2(o[0], o[1]), pk2(o[2], o[3])}; }
    }
}

template <bool FIRST, bool COPY = false  >
__device__ __forceinline__ void norm_pass_dual(const Args& a, int l, int j, int G, int wave, int lane) {
    const float* MOD = (const float*)(a.ws + WS_MOD) + (size_t)l * 9 * MODS;
    const float* gvec = a.in[12] + (size_t)(l * 3 + j) * DM;
    bf16* H = (bf16*)(a.ws + WS_H);
    const int NGW = G * NWAVES, gw = blockIdx.x * NWAVES + wave, rpw = (MT + NGW - 1) / NGW;
    int cur = -1; f32x4 ge[8], sh[8];
    const int m_end = (gw + 1) * rpw < MT ? (gw + 1) * rpw : MT;
    f32x4 nf[8]; v2u nh[8];
    if (gw * rpw < m_end) NORM_REQ(gw * rpw);
    for (int m = gw * rpw; m < m_end; ++m) {
        const int s = set_of_row(m);
        if (s != cur) { cur = s; const float* sc = MOD + (size_t)s * MODS + (3 * j + 1) * DM; const float* sf = MOD + (size_t)s * MODS + (3 * j) * DM;
#pragma unroll
            for (int q = 0; q < 8; ++q) { const int c = 4 * lane + 256 * q; const f32x4 g4 = *(const f32x4*)(gvec + c), s4 = *(const f32x4*)(sc + c); ge[q] = g4 * (s4 + 1.0f); sh[q] = *(const f32x4*)(sf + c); } }
        f32x4 v[8]; float ss = 0.f;
        if (FIRST) {
#pragma unroll
            for (int q = 0; q < 8; ++q) v[q] = nf[q]; }
        else {
#pragma unroll
            for (int q = 0; q < 8; ++q) { const v2u w = nh[q]; v[q] = (f32x4){__uint_as_float(w.x << 16), __uint_as_float(w.x & 0xffff0000u), __uint_as_float(w.y << 16), __uint_as_float(w.y & 0xffff0000u)}; } }
        if (m + 1 < m_end) NORM_REQ(m + 1);
#pragma unroll
        for (int q = 0; q < 8; ++q) ss += (v[q][0] * v[q][0] + v[q][1] * v[q][1]) + (v[q][2] * v[q][2] + v[q][3] * v[q][3]);
        const float rstd = rsqrtf(wave_sum(ss) * (1.0f / DM) + EPS);
        bf16* orow = H + (size_t)m * DM;
#pragma unroll
        for (int q = 0; q < 8; ++q) { v[q] = v[q] * rstd * ge[q] + sh[q]; *(v2u*)(orow + 4 * lane + 256 * q) = (v2u){pk2(v[q][0], v[q][1]), pk2(v[q][2], v[q][3])}; }
        float am = 0.f;
#pragma unroll
        for (int q = 0; q < 8; ++q) am = fmaxf(am, fmaxf(fmaxf(fabsf(v[q][0]), fabsf(v[q][1])), fmaxf(fabsf(v[q][2]), fabsf(v[q][3]))));
        am = wave_max(am);
        const float inv = am > 0.f ? 127.0f / am : 0.f;
        unsigned char* o8 = a.ws + WS_H8M + (size_t)m * DM;
#pragma unroll
        for (int q = 0; q < 8; ++q) { const int q0 = (int)rintf(v[q][0] * inv) & 0xff, q1 = (int)rintf(v[q][1] * inv) & 0xff, q2 = (int)rintf(v[q][2] * inv) & 0xff, q3 = (int)rintf(v[q][3] * inv) & 0xff;
            *(unsigned*)(o8 + 4 * lane + 256 * q) = (unsigned)(q0 | (q1 << 8) | (q2 << 16) | (q3 << 24)); }
        if (lane == 0) ((float*)(a.ws + WS_SA))[m] = am * (1.0f / 127.0f);
    }
}

template <bool FIRST, bool COPY = false  >
__device__ __forceinline__ void norm_pass_q(const Args& a, int l, int j, int G, int wave, int lane) {
    const float* MOD = (const float*)(a.ws + WS_MOD) + (size_t)l * 9 * MODS;
    const float* gvec = a.in[12] + (size_t)(l * 3 + j) * DM;
    unsigned char* H8 = a.ws + WS_H; float* SA = (float*)(a.ws + WS_SA);
    const int NGW = G * NWAVES, gw = blockIdx.x * NWAVES + wave, rpw = (MT + NGW - 1) / NGW;
    int cur = -1; f32x4 ge[8], sh[8];
    const int m_end = (gw + 1) * rpw < MT ? (gw + 1) * rpw : MT;
    f32x4 nf[8]; v2u nh[8];
    if (gw * rpw < m_end) NORM_REQ(gw * rpw);
    for (int m = gw * rpw; m < m_end; ++m) {
        const int s = set_of_row(m);
        if (s != cur) { cur = s; const float* sc = MOD + (size_t)s * MODS + (3 * j + 1) * DM; const float* sf = MOD + (size_t)s * MODS + (3 * j) * DM;
#pragma unroll
            for (int q = 0; q < 8; ++q) { const int c = 4 * lane + 256 * q; const f32x4 g4 = *(const f32x4*)(gvec + c), s4 = *(const f32x4*)(sc + c); ge[q] = g4 * (s4 + 1.0f); sh[q] = *(const f32x4*)(sf + c); } }
        f32x4 v[8]; float ss = 0.f;
        if (FIRST) {
#pragma unroll
            for (int q = 0; q < 8; ++q) v[q] = nf[q]; }
        else {
#pragma unroll
            for (int q = 0; q < 8; ++q) { const v2u w = nh[q]; v[q] = (f32x4){__uint_as_float(w.x << 16), __uint_as_float(w.x & 0xffff0000u), __uint_as_float(w.y << 16), __uint_as_float(w.y & 0xffff0000u)}; } }
        if (m + 1 < m_end) NORM_REQ(m + 1);
#pragma unroll
        for (int q = 0; q < 8; ++q) ss += (v[q][0] * v[q][0] + v[q][1] * v[q][1]) + (v[q][2] * v[q][2] + v[q][3] * v[q][3]);
        const float rstd = rsqrtf(wave_sum(ss) * (1.0f / DM) + EPS);
        float am = 0.f;
#pragma unroll
        for (int q = 0; q < 8; ++q) { v[q] = v[q] * rstd * ge[q] + sh[q]; am = fmaxf(am, fmaxf(fmaxf(fabsf(v[q][0]), fabsf(v[q][1])), fmaxf(fabsf(v[q][2]), fabsf(v[q][3])))); }
        am = wave_max(am);
        const float inv = am > 0.f ? 127.0f / am : 0.f;
        unsigned char* orow = H8 + (size_t)m * DM;
#pragma unroll
        for (int q = 0; q < 8; ++q) { const int q0 = (int)rintf(v[q][0] * inv) & 0xff, q1 = (int)rintf(v[q][1] * inv) & 0xff, q2 = (int)rintf(v[q][2] * inv) & 0xff, q3 = (int)rintf(v[q][3] * inv) & 0xff;
            *(unsigned*)(orow + 4 * lane + 256 * q) = (unsigned)(q0 | (q1 << 8) | (q2 << 16) | (q3 << 24)); }
        if (lane == 0) SA[m] = am * (1.0f / 127.0f);
    }
}

__device__ __forceinline__ void tile_load(const bf16* src, size_t spitch, LAS bf16* tl, int lane) {
    v4u r[16];
#pragma unroll
    for (int i = 0; i < 16; ++i) { const int c = lane + 64 * i, t = c >> 4, dc = c & 15; r[i] = *(const v4u*)(src + (size_t)t * spitch + 8 * dc); }
#pragma unroll
    for (int i = 0; i < 16; ++i) { const int c = lane + 64 * i, t = c >> 4, dc = c & 15; *(LAS v4u*)(tl + t * 136 + 8 * dc) = r[i]; }
}
__device__ __forceinline__ void tile_store_rows(bf16* dst, size_t dpitch, const LAS bf16* tl, int lane) {
#pragma unroll
    for (int i = 0; i < 16; ++i) { const int c = lane + 64 * i, t = c >> 4, dc = c & 15; *(v4u*)(dst + (size_t)t * dpitch + 8 * dc) = *(const LAS v4u*)(tl + t * 136 + 8 * dc); }
}
__device__ __forceinline__ void tile_store_T(bf16* dst, size_t dpitch, const LAS bf16* tl, int lane) {
#pragma unroll 4
    for (int i = 0; i < 16; ++i) { const int c = lane + 64 * i, d = c >> 3, tc = c & 7; const LAS bf16* s = tl + (8 * tc) * 136 + d;
        v4u o; o.x = (unsigned)s[0] | ((unsigned)s[136] << 16); o.y = (unsigned)s[2 * 136] | ((unsigned)s[3 * 136] << 16); o.z = (unsigned)s[4 * 136] | ((unsigned)s[5 * 136] << 16); o.w = (unsigned)s[6 * 136] | ((unsigned)s[7 * 136] << 16);
        *(v4u*)(dst + (size_t)d * dpitch + 8 * tc) = o; }
}
__device__ __forceinline__ void ab_post_item(const Args& a, int item, LAS unsigned char* lds, int wave, int lane) {
    bf16* Z = (bf16*)(a.ws + WS_Z);
    const int R0 = item * 64;
    const bool prompt = R0 < MP;
    float* outk = a.out + 75497472; float* outv = a.out + 79691776;
    float qg[16], kg[16];
#pragma unroll
    for (int e = 0; e < 16; ++e) { qg[e] = a.in[18][16 * (lane & 7) + e]; kg[e] = a.in[19][16 * (lane & 7) + e]; }
    const int rowb = R0 + wave * 8; bf16* zb = Z + (size_t)rowb * 5120 + 16 * lane;
#pragma unroll
    for (int which = 0; which < 2; ++which) {
        v4u r0[8], r1[8];
#pragma unroll
        for (int tt = 0; tt < 8; ++tt) { const bf16* p = zb + (size_t)tt * 5120 + which * 1024; r0[tt] = *(const v4u*)p; r1[tt] = *(const v4u*)(p + 8); }
#pragma unroll
        for (int tt = 0; tt < 8; ++tt) {
            bf16* p = zb + (size_t)tt * 5120 + which * 1024;
            float x[16]; const unsigned w8[8] = {r0[tt].x, r0[tt].y, r0[tt].z, r0[tt].w, r1[tt].x, r1[tt].y, r1[tt].z, r1[tt].w};
#pragma unroll
            for (int e = 0; e < 8; ++e) { x[2 * e] = __uint_as_float(w8[e] << 16); x[2 * e + 1] = __uint_as_float(w8[e] & 0xffff0000u); }
            float ss = 0.f;
#pragma unroll
            for (int e = 0; e < 16; ++e) ss += x[e] * x[e];
            ss += __shfl_xor(ss, 1); ss += __shfl_xor(ss, 2); ss += __shfl_xor(ss, 4);
            const float rs = rsqrtf(ss * (1.0f / 128.0f) + EPS);
#pragma unroll
            for (int e = 0; e < 16; ++e) x[e] = x[e] * rs * (which ? kg[e] : qg[e]);
            v4u o0, o1; o0.x = pk2(x[0], x[1]); o0.y = pk2(x[2], x[3]); o0.z = pk2(x[4], x[5]); o0.w = pk2(x[6], x[7]); o1.x = pk2(x[8], x[9]); o1.y = pk2(x[10], x[11]); o1.z = pk2(x[12], x[13]); o1.w = pk2(x[14], x[15]);
            *(v4u*)p = o0; *(v4u*)(p + 8) = o1;
            if (which == 1 && prompt) { float* ok = outk + (size_t)(rowb + tt) * 1024 + 16 * lane;
#pragma unroll
                for (int e = 0; e < 4; ++e) *(f32x4*)(ok + 4 * e) = (f32x4){x[4 * e], x[4 * e + 1], x[4 * e + 2], x[4 * e + 3]}; }
        }
    }
    if (prompt) {
        v4u r0[8], r1[8];
#pragma unroll
        for (int tt = 0; tt < 8; ++tt) { const bf16* p = zb + (size_t)tt * 5120 + 2048; r0[tt] = *(const v4u*)p; r1[tt] = *(const v4u*)(p + 8); }
#pragma unroll
        for (int tt = 0; tt < 8; ++tt) { const unsigned w8[8] = {r0[tt].x, r0[tt].y, r0[tt].z, r0[tt].w, r1[tt].x, r1[tt].y, r1[tt].z, r1[tt].w};
            float* ov = outv + (size_t)(rowb + tt) * 1024 + 16 * lane;
#pragma unroll
            for (int e = 0; e < 4; ++e) *(f32x4*)(ov + 4 * e) = (f32x4){__uint_as_float(w8[2 * e] << 16), __uint_as_float(w8[2 * e] & 0xffff0000u), __uint_as_float(w8[2 * e + 1] << 16), __uint_as_float(w8[2 * e + 1] & 0xffff0000u)}; }
    }
    LAS bf16* tl = (LAS bf16*)(lds + wave * 17408);
    tile_load(Z + (size_t)R0 * 5120 + 2048 + wave * 128, 5120, tl, lane);
    LDS_WAIT(); asm volatile("" ::: "memory");
    bf16* dst; size_t dp;
    if (prompt) { const int b = R0 >> 8, t0 = R0 & 255; dst = (bf16*)(a.ws + WS_VTP) + ((size_t)(b * 8 + wave) * 128) * 256 + t0; dp = 256; }
    else { const int rs = R0 - MP, b = rs >> 12, t0 = rs & 4095; dst = (bf16*)(a.ws + WS_VTS) + ((size_t)(b * 8 + wave) * 128) * 4096 + t0; dp = 4096; }
    tile_store_T(dst, dp, tl, lane);
    LDS_WAIT(); asm volatile("" ::: "memory");
}
__device__ __forceinline__ float gelu_tanh(float x) { const float y = 0.7978845608028654f * (x + 0.044715f * x * x * x); const float t = 1.0f - 2.0f * __builtin_amdgcn_rcpf(1.0f + __expf(2.0f * y)); return 0.5f * x * (1.0f + t); }
template <int PASS>
__device__ __forceinline__ void lru_item(const Args& a, int cq, int hh, LAS unsigned char* lds, int wave, int lane, int tid) {
    const bf16* Z = (const bf16*)(a.ws + WS_Z); const bf16* LW = (const bf16*)(a.ws + WS_LW);
    float* SUMW = (float*)(a.ws + WS_SUMW); float* SUMB = (float*)(a.ws + WS_SUMB);
    const int fr = lane & 15, fq = lane >> 4;
    int S0, T, tseq, bs = 0, cis = 0, nchk = 1;
    if (cq < 16) { S0 = cq * 256; T = 256; tseq = 0; } else { bs = (cq - 16) >> 4; cis = (cq - 16) & 15; nchk = 16; S0 = MP + bs * 4096; T = 4096; tseq = cis * 256; }
    const int t0 = tseq + 32 * wave;
    LAS bf16* xt = (LAS bf16*)(lds + wave * 8704);
    LAS float* WS = (LAS float*)(lds + 69632);
    LAS float* HW = (LAS float*)(lds + 69632 + 16384);
    {
        const int ch = hh * 128 + 2 * lane;
        const float* cw = a.in[21]; const float* cbp = a.in[22];
        float w[4][2];
#pragma unroll
        for (int i = 0; i < 4; ++i) { w[i][0] = cw[i * 1024 + ch]; w[i][1] = cw[i * 1024 + ch + 1]; }
        const float cb0 = cbp[ch], cb1 = cbp[ch + 1];
        const bf16* xb = Z + (size_t)S0 * 5120 + 3072 + ch;
        unsigned xr[35];
#pragma unroll
        for (int i = 0; i < 35; ++i) { const int t = t0 - 1 + i; xr[i] = (t >= 0 && t < T) ? *(const unsigned*)(xb + (size_t)t * 5120) : 0u; }
#pragma unroll
        for (int t = 0; t < 32; ++t) {
            const float y0 = w[0][0] * __uint_as_float(xr[t] << 16) + w[1][0] * __uint_as_float(xr[t + 1] << 16) + w[2][0] * __uint_as_float(xr[t + 2] << 16) + w[3][0] * __uint_as_float(xr[t + 3] << 16) + cb0;
            const float y1 = w[0][1] * __uint_as_float(xr[t] & 0xffff0000u) + w[1][1] * __uint_as_float(xr[t + 1] & 0xffff0000u) + w[2][1] * __uint_as_float(xr[t + 2] & 0xffff0000u) + w[3][1] * __uint_as_float(xr[t + 3] & 0xffff0000u) + cb1;
            *(LAS unsigned*)(xt + t * 136 + 2 * lane) = pk2(y0, y1);
        }
    }
    if (PASS == 2) {
        if (tid < 256) { const int dir = tid >> 7, chl = tid & 127;
            float Hs = (cq < 16) ? 0.f : a.in[4][(size_t)(bs * 2 + dir) * 1024 + hh * 128 + chl];
            typedef float f32x2_ __attribute__((ext_vector_type(2)));
            f32x2_ sb_[15], sw_[8];
            const float* sbp = SUMB + ((size_t)((cq - cis) * 8 + hh) * 2 + dir) * 256 + 2 * chl;
#pragma unroll
            for (int i = 0; i < 15; ++i) { const int c = dir ? nchk - 1 - i : i; const bool use = dir ? c > cis : c < cis; sb_[i] = use ? *(const f32x2_*)(sbp + (size_t)c * 4096) : (f32x2_){1.f, 0.f}; }
            const float* sw = SUMW + ((size_t)(cq * 8 + hh) * 8) * 512 + dir * 256 + 2 * chl;
#pragma unroll
            for (int w = 0; w < 8; ++w) sw_[w] = *(const f32x2_*)(sw + w * 512);
#pragma unroll
            for (int i = 0; i < 15; ++i) Hs = sb_[i][0] * Hs + sb_[i][1];
            if (dir == 0) {
#pragma unroll
                for (int w = 0; w < 8; ++w) { HW[(w * 2 + 0) * 128 + chl] = Hs; Hs = sw_[w][0] * Hs + sw_[w][1]; } }
            else {
#pragma unroll
                for (int w = 7; w >= 0; --w) { HW[(w * 2 + 1) * 128 + chl] = Hs; Hs = sw_[w][0] * Hs + sw_[w][1]; } }
        }
        __syncthreads();
    }
    LDS_WAIT(); asm volatile("" ::: "memory");
    bf16x8 af[2][4];
#pragma unroll
    for (int mt = 0; mt < 2; ++mt)
#pragma unroll
        for (int kk = 0; kk < 4; ++kk) af[mt][kk] = *(const LAS bf16x8*)(xt + (16 * mt + fr) * 136 + 32 * kk + 8 * fq);
    bf16x8 bw[2][4]; float sc3[3];
#define LRU_REQ(dstw, dsts, q_) do { const int d_ = (q_) & 1, chl_ = 16 * ((q_) >> 1) + fr; const bf16* wa_ = LW + (size_t)((d_ * 8 + hh) * 2) * 16384 + chl_ * 128 + 8 * fq; \
        _Pragma("unroll") for (int kk = 0; kk < 4; ++kk) { dstw[0][kk] = *(const bf16x8*)(wa_ + 32 * kk); dstw[1][kk] = *(const bf16x8*)(wa_ + 16384 + 32 * kk); } \
        dsts[0] = a.in[24][d_ * 1024 + hh * 128 + chl_]; dsts[1] = a.in[26][d_ * 1024 + hh * 128 + chl_]; dsts[2] = a.in[27][d_ * 1024 + hh * 128 + chl_]; } while (0)
    LRU_REQ(bw, sc3, 0);
    for (int jt = 0; jt < 8; ++jt) {
        const int chl = 16 * jt + fr, ch = hh * 128 + chl;
        bf16 gbr[2][4];
        if (PASS == 2) {
#pragma unroll
            for (int mt = 0; mt < 2; ++mt)
#pragma unroll
                for (int r = 0; r < 4; ++r) gbr[mt][r] = Z[((size_t)S0 + t0 + 16 * mt + 4 * fq + r) * 5120 + 4096 + ch]; }
        float xv[2][4];
#pragma unroll
        for (int mt = 0; mt < 2; ++mt)
#pragma unroll
            for (int r = 0; r < 4; ++r) xv[mt][r] = bf2f(xt[(16 * mt + 4 * fq + r) * 136 + chl]);
        float av[2][2][4], uv[2][2][4];
#pragma unroll
        for (int dir = 0; dir < 2; ++dir) {
            f32x4 acca[2], accx[2];
            acca[0] = acca[1] = accx[0] = accx[1] = (f32x4){0.f, 0.f, 0.f, 0.f};
            bf16x8 bn[2][4]; float sn3[3];
            if (2 * jt + dir < 15) LRU_REQ(bn, sn3, 2 * jt + dir + 1);
#pragma unroll
            for (int kk = 0; kk < 4; ++kk) {
#pragma unroll
                for (int mt = 0; mt < 2; ++mt) { acca[mt] = MFMA16(af[mt][kk], bw[0][kk], acca[mt]); accx[mt] = MFMA16(af[mt][kk], bw[1][kk], accx[mt]); } }
            const float bav = sc3[0] * -1.4426950408889634f, bxv = sc3[1] * -1.4426950408889634f, lm = sc3[2];
            const float c8 = -8.0f * 1.4426950408889634f * log1pf(__expf(-lm));
#pragma unroll
            for (int mt = 0; mt < 2; ++mt)
#pragma unroll
                for (int r = 0; r < 4; ++r) { const float ra = __builtin_amdgcn_rcpf(1.0f + __builtin_amdgcn_exp2f(acca[mt][r] + bav)), ix = __builtin_amdgcn_rcpf(1.0f + __builtin_amdgcn_exp2f(accx[mt][r] + bxv)); const float la = c8 * ra;
                    const float aa = __builtin_amdgcn_exp2f(la); av[dir][mt][r] = aa; uv[dir][mt][r] = __builtin_amdgcn_sqrtf(fmaxf(1.0f - aa * aa, 0.f)) * ix * xv[mt][r]; }
            if (2 * jt + dir < 15) {
#pragma unroll
                for (int x_ = 0; x_ < 2; ++x_)
#pragma unroll
                    for (int kk = 0; kk < 4; ++kk) bw[x_][kk] = bn[x_][kk];
                sc3[0] = sn3[0]; sc3[1] = sn3[1]; sc3[2] = sn3[2]; }
        }
        float GA[2][2][4], GB[2][2][4];
#pragma unroll
        for (int dir = 0; dir < 2; ++dir)
#pragma unroll
            for (int mt = 0; mt < 2; ++mt) { float A = 1.f, B = 0.f;
#pragma unroll
                for (int rr = 0; rr < 4; ++rr) { const int r = dir ? 3 - rr : rr; A *= av[dir][mt][r]; B = av[dir][mt][r] * B + uv[dir][mt][r]; }
#pragma unroll
                for (int q = 0; q < 4; ++q) { GA[dir][mt][q] = __shfl(A, fr + 16 * q); GB[dir][mt][q] = __shfl(B, fr + 16 * q); } }
        if (PASS == 1) {
#pragma unroll
            for (int dir = 0; dir < 2; ++dir) { float A = 1.f, B = 0.f;
#pragma unroll
                for (int mm = 0; mm < 2; ++mm)
#pragma unroll
                    for (int qq = 0; qq < 4; ++qq) { const int mt = dir ? 1 - mm : mm, q = dir ? 3 - qq : qq; B = GA[dir][mt][q] * B + GB[dir][mt][q]; A *= GA[dir][mt][q]; }
                if (fq == 0) { WS[((wave * 2 + dir) * 128 + chl) * 2] = A; WS[((wave * 2 + dir) * 128 + chl) * 2 + 1] = B;
                    float* g = SUMW + ((size_t)((cq * 8 + hh) * 8 + wave)) * 512 + dir * 256 + 2 * chl; g[0] = A; g[1] = B; } }
        } else {
            float hsum[2][4] = {{0.f, 0.f, 0.f, 0.f}, {0.f, 0.f, 0.f, 0.f}};
#pragma unroll
            for (int dir = 0; dir < 2; ++dir) { float st = HW[(wave * 2 + dir) * 128 + chl]; float hin[2] = {0.f, 0.f};
#pragma unroll
                for (int mm = 0; mm < 2; ++mm)
#pragma unroll
                    for (int qq = 0; qq < 4; ++qq) { const int mt = dir ? 1 - mm : mm, q = dir ? 3 - qq : qq; if (q == fq) hin[mt] = st; st = GA[dir][mt][q] * st + GB[dir][mt][q]; }
#pragma unroll
                for (int mt = 0; mt < 2; ++mt) { float h = hin[mt];
#pragma unroll
                    for (int rr = 0; rr < 4; ++rr) { const int r = dir ? 3 - rr : rr; h = av[dir][mt][r] * h + uv[dir][mt][r]; hsum[mt][r] += h;
                        if (cq < 16) { if (dir == 0 && wave == 7 && mt == 1 && fq == 3 && r == 3) a.out[83886080 + (size_t)(cq * 2 + 0) * 1024 + ch] = h;
                                       if (dir == 1 && wave == 0 && mt == 0 && fq == 0 && r == 0) a.out[83886080 + (size_t)(cq * 2 + 1) * 1024 + ch] = h; } } } }
            bf16* Hb = (bf16*)(a.ws + WS_H);
#pragma unroll
            for (int mt = 0; mt < 2; ++mt)
#pragma unroll
                for (int r = 0; r < 4; ++r) { const size_t row = (size_t)S0 + t0 + 16 * mt + 4 * fq + r; const float gb = bf2f(gbr[mt][r]);
                    Hb[row * DM + 1024 + ch] = (bf16)f2bf(hsum[mt][r] * gelu_tanh(gb)); }
        }
    }
#undef LRU_REQ
    if (PASS == 1) {
        LDS_WAIT(); __syncthreads();
        if (tid < 256) { const int dir = tid >> 7, chl = tid & 127; float A = 1.f, B = 0.f;
            for (int ww = 0; ww < 8; ++ww) { const int w = dir ? 7 - ww : ww; const float wa_ = WS[((w * 2 + dir) * 128 + chl) * 2], wb_ = WS[((w * 2 + dir) * 128 + chl) * 2 + 1]; B = wa_ * B + wb_; A *= wa_; }
            float* g = SUMB + ((size_t)(cq * 8 + hh) * 2 + dir) * 256 + 2 * chl; g[0] = A; g[1] = B; }
    }
    __syncthreads();
}

__device__ __forceinline__ bf16x8 pack8(const float (&p)[8]) { v4u w; w.x = pk2(p[0], p[1]); w.y = pk2(p[2], p[3]); w.z = pk2(p[4], p[5]); w.w = pk2(p[6], p[7]); return __builtin_bit_cast(bf16x8, w); }
__device__ __forceinline__ void c_post_item(const Args& a, int item, LAS unsigned char* lds, int wave, int lane, int tid) {
    bf16* PL = (bf16*)(a.ws + WS_PL);
    const int R0 = item * 64; const bool prompt = R0 < MP;
    int b, tok0; size_t T, tbase;
    if (prompt) { b = R0 >> 8; tok0 = R0 & 255; T = 256; tbase = ((size_t)(b * 8 + wave) * 256) * 256; }
    else { const int rs = R0 - MP; b = rs >> 12; tok0 = rs & 4095; T = 4096; tbase = (size_t)MP * DM + ((size_t)(b * 8 + wave) * 256) * 4096; }
    LAS bf16* tl = (LAS bf16*)(lds + wave * 17408);
    const float* ROPE = (const float*)(a.ws + WS_ROPE);
    const int prow = tok0 >> 6;
    for (int pl = 0; pl < 3; ++pl)
        for (int hf = 0; hf < 2; ++hf) {
            if (pl == 0 && prompt) continue;
            bf16* src = PL + (size_t)pl * PLANE + (size_t)R0 * DM + wave * 256 + hf * 128;
            tile_load(src, DM, tl, lane);
            LDS_WAIT(); asm volatile("" ::: "memory");
            if (pl < 2) {
                const float ksc = pl == 1 ? 0.0625f : 1.0f;
                if (!prompt) {
                    float cr = 0.f, sr = 0.f; if (hf == 0) { cr = ROPE[(prow * 64 + lane) * 2]; sr = ROPE[(prow * 64 + lane) * 2 + 1]; }
#pragma unroll 4
                    for (int t = 0; t < 64; ++t) { float c = cr, s = sr; if (hf) { c = ROPE[(t * 64 + lane) * 2]; s = ROPE[(t * 64 + lane) * 2 + 1]; }
                        const float x1 = bf2f(tl[t * 136 + lane]), x2 = bf2f(tl[t * 136 + 64 + lane]);
                        tl[t * 136 + lane] = (bf16)f2bf((x1 * c - x2 * s) * ksc); tl[t * 136 + 64 + lane] = (bf16)f2bf((x1 * s + x2 * c) * ksc); }
                } else {
#pragma unroll 4
                    for (int t = 0; t < 64; ++t) { const float x1 = bf2f(tl[t * 136 + lane]), x2 = bf2f(tl[t * 136 + 64 + lane]);
                        tl[t * 136 + lane] = (bf16)f2bf(x1 * ksc); tl[t * 136 + 64 + lane] = (bf16)f2bf(x2 * ksc); }
                }
                LDS_WAIT(); asm volatile("" ::: "memory");
                tile_store_rows(src, DM, tl, lane);
            }
            if (pl >= 1) { bf16* dstT = (pl == 1 ? (bf16*)(a.ws + WS_KT) : (bf16*)(a.ws + WS_H)) + tbase + (size_t)(hf * 128) * T + tok0; tile_store_T(dstT, T, tl, lane); }
            LDS_WAIT(); asm volatile("" ::: "memory");
        }
    float* GT = (float*)(a.ws + WS_GATES);
    float gt4[4];
#pragma unroll
    for (int i = 0; i < 4; ++i) { const int idx = tid + NTHR * i; gt4[i] = GT[(size_t)(R0 + (idx >> 5)) * 32 + (idx & 31)]; }
#pragma unroll
    for (int i = 0; i < 4; ++i) { const int idx = tid + NTHR * i, rl = idx >> 5, gi = idx & 31; float* p = GT + (size_t)(R0 + rl) * 32 + gi; float v = gt4[i] + a.in[29][gi];
        if ((gi >> 3) & 1) v = fminf(v, 0.f) - log1pf(__expf(-fabsf(v)));
        *p = v; }
}
constexpr int ML_KL = 0, ML_VTL = 33792, ML_CTL = 68608, ML_ARR = 136192;
__device__ __forceinline__ void c_final_pass(const Args& a, int G, int wave, int lane) {
    const bf16* HF = (const bf16*)(a.ws + WS_PL) + 2 * PLANE; const bf16* HB = (const bf16*)(a.ws + WS_HB); const bf16* OG = (const bf16*)(a.ws + WS_PL) + 3 * PLANE;
    bf16* H = (bf16*)(a.ws + WS_H);
    float gv[32];
#pragma unroll
    for (int e = 0; e < 32; ++e) gv[e] = a.in[30][32 * lane + e];
    v4u nfv[4], nbv[4], ngv[4];
#define CF_REQ(mm) do { const size_t off_ = (size_t)(mm) * DM + 32 * lane; _Pragma("unroll") for (int q = 0; q < 4; ++q) { nfv[q] = *(const v4u*)(HF + off_ + 8 * q); nbv[q] = *(const v4u*)(HB + off_ + 8 * q); ngv[q] = *(const v4u*)(OG + off_ + 8 * q); } } while (0)
    if ((int)(blockIdx.x * NWAVES + wave) < MT) CF_REQ(blockIdx.x * NWAVES + wave);
    for (int m = blockIdx.x * NWAVES + wave; m < MT; m += G * NWAVES) {
        const size_t off = (size_t)m * DM + 32 * lane;
        v4u fv[4], bv[4], gv4[4];
#pragma unroll
        for (int q = 0; q < 4; ++q) { fv[q] = nfv[q]; bv[q] = nbv[q]; gv4[q] = ngv[q]; }
        if (m + G * NWAVES < MT) CF_REQ(m + G * NWAVES);
        float x[32]; float ss = 0.f;
#pragma unroll
        for (int q = 0; q < 4; ++q) { const unsigned fw[4] = {fv[q].x, fv[q].y, fv[q].z, fv[q].w}, bw[4] = {bv[q].x, bv[q].y, bv[q].z, bv[q].w};
#pragma unroll
            for (int e = 0; e < 4; ++e) { x[8 * q + 2 * e] = __uint_as_float(fw[e] << 16) + __uint_as_float(bw[e] << 16); x[8 * q + 2 * e + 1] = __uint_as_float(fw[e] & 0xffff0000u) + __uint_as_float(bw[e] & 0xffff0000u); } }
#pragma unroll
        for (int e = 0; e < 32; ++e) ss += x[e] * x[e];
        ss += __shfl_xor(ss, 1); ss += __shfl_xor(ss, 2); ss += __shfl_xor(ss, 4);
        const float rs = rsqrtf(ss * (1.0f / 256.0f) + EPS);
        float y[32]; float am = 0.f;
#pragma unroll
        for (int q = 0; q < 4; ++q) { const unsigned ow[4] = {gv4[q].x, gv4[q].y, gv4[q].z, gv4[q].w};
#pragma unroll
            for (int e = 0; e < 4; ++e) { y[8 * q + 2 * e] = x[8 * q + 2 * e] * rs * gv[8 * q + 2 * e] * sigmoidf_(__uint_as_float(ow[e] << 16)); y[8 * q + 2 * e + 1] = x[8 * q + 2 * e + 1] * rs * gv[8 * q + 2 * e + 1] * sigmoidf_(__uint_as_float(ow[e] & 0xffff0000u)); } }
#pragma unroll
        for (int e = 0; e < 32; ++e) am = fmaxf(am, fabsf(y[e]));
        am = wave_max(am);
        const float inv = am > 0.f ? 127.0f / am : 0.f;
        unsigned wq[8];
#pragma unroll
        for (int q = 0; q < 8; ++q) { const int q0 = (int)rintf(y[4 * q] * inv) & 0xff, q1 = (int)rintf(y[4 * q + 1] * inv) & 0xff, q2 = (int)rintf(y[4 * q + 2] * inv) & 0xff, q3 = (int)rintf(y[4 * q + 3] * inv) & 0xff; wq[q] = (unsigned)(q0 | (q1 << 8) | (q2 << 16) | (q3 << 24)); }
        unsigned char* o8 = a.ws + WS_H + (size_t)m * DM + 32 * lane;
        *(v4u*)o8 = (v4u){wq[0], wq[1], wq[2], wq[3]}; *(v4u*)(o8 + 16) = (v4u){wq[4], wq[5], wq[6], wq[7]};
        if (lane == 0) ((float*)(a.ws + WS_SA))[m] = am * (1.0f / 127.0f);
    }
#undef CF_REQ
}

#ifndef AT_DV
#define AT_DV 8
#endif
constexpr int AT_K0 = 0, AT_V0 = 34816, AT_K1 = 69632, AT_V1 = 104448, AT_RPB = 139264;
__device__ __forceinline__ void attn_block(const Args& a, int kind, int b, int h, int rp, LAS unsigned char* lds, int wave, int lane, int tid) {
    const bf16* Z = (const bf16*)(a.ws + WS_Z);
    const int fr = lane & 15, fq = lane >> 4;
    const float NINF = -__builtin_inff();
    const int rq = 2 * rp + (wave >> 2), j = kind ? (wave & 3) : 0;
    const size_t qrow = kind ? (size_t)MP + (size_t)b * 4096 + rq * 64 + 16 * j + fr : (size_t)b * 256 + 16 * (8 * rp + wave) + fr;
    bf16x8 bq[4];
    { const bf16* qp = Z + qrow * 5120 + h * 128 + 8 * fq; const float qs = 0.08838834764831845f * 1.4426950408889634f;
#pragma unroll
      for (int kk = 0; kk < 4; ++kk) { const v4u raw = *(const v4u*)(qp + 32 * kk); const unsigned rw[4] = {raw.x, raw.y, raw.z, raw.w}; v4u w;
          w.x = pk2(__uint_as_float(rw[0] << 16) * qs, __uint_as_float(rw[0] & 0xffff0000u) * qs); w.y = pk2(__uint_as_float(rw[1] << 16) * qs, __uint_as_float(rw[1] & 0xffff0000u) * qs);
          w.z = pk2(__uint_as_float(rw[2] << 16) * qs, __uint_as_float(rw[2] & 0xffff0000u) * qs); w.w = pk2(__uint_as_float(rw[3] << 16) * qs, __uint_as_float(rw[3] & 0xffff0000u) * qs);
          bq[kk] = __builtin_bit_cast(bf16x8, w); } }
    const int rlo = min(max(2 * rp - 4, 0), 56), rhi = min(max(2 * rp + 1 - 4, 0), 56) + 8;
    const int nsw = kind ? (rhi - rlo + 1) >> 1 : 0, ntile = kind ? nsw + 4 : 2;
    const int r0 = min(max(rq - 4, 0), 56), start = min(max(16 * j - 8, 0), 32);
    float m_run = NINF, l_run = 0.f;
    f32x4 o[8];
#pragma unroll
    for (int dt = 0; dt < 8; ++dt) o[dt] = (f32x4){0.f, 0.f, 0.f, 0.f};
    v4u sk[4], sv[4], sk2[4], sv2[4];
#define AT_LOAD(t, SK, SV) do { _Pragma("unroll") for (int i_ = 0; i_ < 4; ++i_) { const int id_ = tid + NTHR * i_, key_ = id_ >> 4, ch_ = id_ & 15; \
        if (kind == 0) { SK[i_] = *(const v4u*)(Z + ((size_t)b * 256 + 128 * (t) + key_) * 5120 + 1024 + h * 128 + 8 * ch_); SV[i_] = *(const v4u*)((const bf16*)(a.ws + WS_VTP) + ((size_t)(b * 8 + h) * 128 + key_) * 256 + 128 * (t) + 8 * ch_); } \
        else if ((t) < nsw) { const int rk_ = min(rlo + 2 * (t) + (key_ >> 6), rhi - 1), rv_ = min(rlo + 2 * (t) + (ch_ >> 3), rhi - 1); \
            SK[i_] = *(const v4u*)(Z + ((size_t)MP + (size_t)b * 4096 + rk_ * 64 + (key_ & 63)) * 5120 + 1024 + h * 128 + 8 * ch_); SV[i_] = *(const v4u*)((const bf16*)(a.ws + WS_VTS) + ((size_t)(b * 8 + h) * 128 + key_) * 4096 + rv_ * 64 + 8 * (ch_ & 7)); } \
        else { const int c_ = (t) - nsw; SK[i_] = *(const v4u*)((const bf16*)(a.ws + WS_KC) + ((size_t)(b * 512 + 128 * c_ + key_) * 8 + h) * 128 + 8 * ch_); SV[i_] = *(const v4u*)((const bf16*)(a.ws + WS_VCT) + ((size_t)b * 1024 + h * 128 + key_) * 512 + 128 * c_ + 8 * ch_); } } } while (0)
#define AT_STORE(buf) do { LAS bf16* kl_ = (LAS bf16*)(lds + ((buf) ? AT_K1 : AT_K0)); LAS bf16* vl_ = (LAS bf16*)(lds + ((buf) ? AT_V1 : AT_V0)); \
        _Pragma("unroll") for (int i_ = 0; i_ < 4; ++i_) { const int id_ = tid + NTHR * i_; *(LAS v4u*)(kl_ + (id_ >> 4) * 136 + 8 * (id_ & 15)) = sk[i_]; *(LAS v4u*)(vl_ + (id_ >> 4) * 136 + 8 * (id_ & 15)) = sv[i_]; } } while (0)
    __syncthreads();
    LAS float* rpbl = (LAS float*)(lds + AT_RPB);
    if (kind && tid < 465) rpbl[tid] = a.in[20][h * 465 + tid] * 1.4426950408889634f;
    AT_LOAD(0, sk, sv); AT_STORE(0);
    AT_LOAD(1, sk, sv);
    if (ntile > 2) AT_LOAD(2, sk2, sv2);
    LDS_WAIT(); __syncthreads();
    for (int t = 0; t < ntile; ++t) {
        const LAS bf16* kl = (const LAS bf16*)(lds + ((t & 1) ? AT_K1 : AT_K0)); const LAS bf16* vl = (const LAS bf16*)(lds + ((t & 1) ? AT_V1 : AT_V0));
        const bool win = kind && t < nsw;
        const int ng = win ? 2 : 4;
        for (int g = 0; g < ng; ++g) {
            const int rr = rlo + 2 * t + g;
            if (win && !(rr >= r0 && rr < r0 + 8)) continue;
            const int koff = win ? 64 * g + start : 32 * g;
            f32x4 s0 = (f32x4){0.f, 0.f, 0.f, 0.f}, s1 = (f32x4){0.f, 0.f, 0.f, 0.f};
            const LAS bf16* k0p = kl + (koff + fr) * 136 + 8 * fq;
#pragma unroll
            for (int kk = 0; kk < 4; ++kk) { const bf16x8 a0 = *(const LAS bf16x8*)(k0p + 32 * kk), a1 = *(const LAS bf16x8*)(k0p + 16 * 136 + 32 * kk); s0 = MFMA16(a0, bq[kk], s0); s1 = MFMA16(a1, bq[kk], s1); }
            const LAS bf16* vq0 = vl + fr * 136 + koff + 4 * fq;
            v2u rlo[AT_DV], rhi[AT_DV];
#pragma unroll
            for (int d = 0; d < AT_DV; ++d) { rlo[d] = *(const LAS v2u*)(vq0 + (16 * d) * 136); rhi[d] = *(const LAS v2u*)(vq0 + (16 * d) * 136 + 16); }
            __builtin_amdgcn_sched_barrier(0);
            float p[8];
#pragma unroll
            for (int e = 0; e < 4; ++e) { p[e] = s0[e]; p[4 + e] = s1[e]; }
            if (win) {
                const int qc = 16 * j + fr, c0 = min(max(qc - 8, 0), 48); const LAS float* rb = rpbl + (rr - rq + 7) * 31;
#pragma unroll
                for (int e = 0; e < 8; ++e) { const int kc = start + (e < 4 ? 4 * fq + e : 16 + 4 * fq + (e - 4)); const bool ok = kc >= c0 && kc < c0 + 16; const int dci = min(max(kc - qc + 15, 0), 30);
                    p[e] = ok ? p[e] + rb[dci] : NINF; }
            }
            float mx = fmaxf(fmaxf(fmaxf(p[0], p[1]), fmaxf(p[2], p[3])), fmaxf(fmaxf(p[4], p[5]), fmaxf(p[6], p[7])));
            mx = rows_max(mx);
            const float m_new = fmaxf(m_run, mx); const float corr = __builtin_amdgcn_exp2f(m_run - m_new);
            float rs = 0.f;
#pragma unroll
            for (int e = 0; e < 8; ++e) { p[e] = __builtin_amdgcn_exp2f(p[e] - m_new); rs += p[e]; }
            rs = rows_sum(rs);
            l_run = l_run * corr + rs; m_run = m_new;
            const bf16x8 pb = pack8(p); const bool resc = !__all(corr == 1.0f);
#pragma unroll
            for (int dt = 0; dt < 8; ++dt) {
                __builtin_amdgcn_sched_barrier(0);
                const v4u vv = (v4u){rlo[dt % AT_DV].x, rlo[dt % AT_DV].y, rhi[dt % AT_DV].x, rhi[dt % AT_DV].y}; if (resc) o[dt] = o[dt] * corr; o[dt] = MFMA16(__builtin_bit_cast(bf16x8, vv), pb, o[dt]);
                if (dt + AT_DV < 8) { rlo[dt % AT_DV] = *(const LAS v2u*)(vq0 + (16 * (dt + AT_DV)) * 136); rhi[dt % AT_DV] = *(const LAS v2u*)(vq0 + (16 * (dt + AT_DV)) * 136 + 16); }
                __builtin_amdgcn_sched_barrier(0); }
        }
        if (t + 1 < ntile) AT_STORE((t + 1) & 1);
#pragma unroll
        for (int i_ = 0; i_ < 4; ++i_) { sk[i_] = sk2[i_]; sv[i_] = sv2[i_]; }
        if (t + 3 < ntile) AT_LOAD(t + 3, sk2, sv2);
        LDS_WAIT(); __syncthreads();
    }
#undef AT_LOAD
#undef AT_STORE
    const float inv = 1.0f / l_run;
    bf16* op = (bf16*)(a.ws + WS_H) + qrow * DM + h * 128 + 4 * fq;
#pragma unroll
    for (int dt = 0; dt < 8; ++dt) *(v2u*)(op + 16 * dt) = (v2u){pk2(o[dt][0] * inv, o[dt][1] * inv), pk2(o[dt][2] * inv, o[dt][3] * inv)};
}

#ifndef ML_DA
#define ML_DA 4
#endif
#ifndef ML_DB
#define ML_DB 3
#endif
#ifndef ML_DV
#define ML_DV 3
#endif
#ifndef ML_DC
#define ML_DC 2
#endif
constexpr int ML2_ARR0 = 136192, ML2_ARR1 = 138784, ML2_NV = 141376;
__device__ __forceinline__ void ml2_scan(LAS float* arr, float ii0, float ff0, float ii1, float ff1, float m_prev, int dir, int lane) {
    const int p0 = 2 * lane, p1 = 2 * lane + 1, i0 = dir ? 127 - p0 : p0, i1 = dir ? 127 - p1 : p1;
    const float s1 = ff0 + ff1; float inc = s1;
#pragma unroll
    for (int o = 1; o < 64; o <<= 1) { const float t = __shfl_up(inc, o); if (lane >= o) inc += t; }
    const float exc = inc - s1, bc0 = exc + ff0, bc1 = inc;
    const float a0 = ii0 - bc0, a1 = ii1 - bc1;
    float im = fmaxf(a0, a1);
#pragma unroll
    for (int o = 1; o < 64; o <<= 1) { const float t = __shfl_up(im, o); if (lane >= o) im = fmaxf(im, t); }
    float em = __shfl_up(im, 1); if (lane == 0) em = -__builtin_inff();
    const float mm0 = fmaxf(m_prev, fmaxf(em, a0)), mm1 = fmaxf(m_prev, im);
    const float mml = fmaxf(m_prev, __shfl(im, 63)), bk = __shfl(inc, 63);
    arr[i0] = a0; arr[i1] = a1; arr[128 + i0] = mm0; arr[128 + i1] = mm1; arr[256 + i0] = __expf(m_prev - mm0); arr[256 + i1] = __expf(m_prev - mm1);
    arr[384 + i0] = __expf(-(bc0 + mm0)); arr[384 + i1] = __expf(-(bc1 + mm1)); arr[512 + i0] = __expf(a0 - mml); arr[512 + i1] = __expf(a1 - mml);
    if (lane == 0) { arr[640] = __expf(m_prev - mml); arr[641] = bk + mml; }
}
__device__ __forceinline__ void mlstm_unit2(const Args& a, int kind, int b, int hh, int dir, int dvh, LAS unsigned char* lds, int wave, int lane0, int tid0) {
    asm volatile("" : "+v"(lane0), "+v"(tid0));
    int lane = lane0, tid = tid0;
    const int fr0 = lane0 & 15, fq0 = lane0 >> 4; int fr = fr0, fq = fq0;
    const int T = kind ? 4096 : 256, nch = T >> 7;
    const size_t row0 = kind ? (size_t)MP + (size_t)b * 4096 : (size_t)b * 256;
    const size_t tb = kind ? (size_t)MP * DM + ((size_t)(b * 8 + hh) * 256) * 4096 : ((size_t)(b * 8 + hh) * 256) * 256;
    const bf16* Qp = (const bf16*)(a.ws + WS_PL); const bf16* Kp = Qp + PLANE;
    const bf16* KT = (const bf16*)(a.ws + WS_KT) + tb; const bf16* VT = (const bf16*)(a.ws + WS_H) + tb + (size_t)(dvh * 128) * T;
    bf16* HO = dir ? (bf16*)(a.ws + WS_HB) : (bf16*)(a.ws + WS_PL) + 2 * PLANE;
    const float* GT = (const float*)(a.ws + WS_GATES);
    LAS bf16* KL = (LAS bf16*)(lds + ML_KL); LAS bf16* VTL = (LAS bf16*)(lds + ML_VTL); LAS bf16* CTL = (LAS bf16*)(lds + ML_CTL);
    LAS float* NV = (LAS float*)(lds + ML2_NV);
    const int scan_wave = dir ? 7 : 0, scan_half = dir ? 0 : 1;
    const int gi_off = (dir ? 16 : 0) + hh, gf_off = (dir ? 24 : 8) + hh;
    f32x4 C[2][8];
    float m0 = 0.f;
    __syncthreads();
    if (kind) {
        const float* c0 = a.in[5] + ((size_t)((b * 2 + dir) * 8 + hh) * 256) * 256 + dvh * 128;
#pragma unroll
        for (int mt = 0; mt < 2; ++mt)
#pragma unroll
            for (int nt = 0; nt < 8; ++nt)
#pragma unroll
                for (int e = 0; e < 4; ++e) C[mt][nt][e] = c0[(unsigned)((32 * wave + 16 * mt + 4 * fq + e) * 256 + 16 * nt + fr)];
        if (tid < 256) NV[tid] = a.in[6][(size_t)((b * 2 + dir) * 8 + hh) * 256 + tid];
        m0 = a.in[7][(b * 2 + dir) * 8 + hh];
    } else {
#pragma unroll
        for (int mt = 0; mt < 2; ++mt)
#pragma unroll
            for (int nt = 0; nt < 8; ++nt) C[mt][nt] = (f32x4){0.f, 0.f, 0.f, 0.f};
        if (tid < 256) NV[tid] = 0.f;
    }
#pragma unroll
    for (int mt = 0; mt < 2; ++mt)
#pragma unroll
        for (int nt = 0; nt < 8; ++nt) *(LAS v2u*)(CTL + (16 * nt + fr) * 264 + 32 * wave + 16 * mt + 4 * fq) = (v2u){pk2(C[mt][nt][0], C[mt][nt][1]), pk2(C[mt][nt][2], C[mt][nt][3])};
    v4u vtn[4], k0n[4]; bf16x8 qf[8];
    {
        const int c = dir ? nch - 1 : 0; const size_t rb = row0 + (size_t)c * 128;
        if (wave == scan_wave) { const int i0 = dir ? 127 - 2 * lane : 2 * lane, i1 = dir ? 126 - 2 * lane : 2 * lane + 1;
            ml2_scan((LAS float*)(lds + ML2_ARR0), GT[(rb + i0) * 32 + gi_off], GT[(rb + i0) * 32 + gf_off], GT[(rb + i1) * 32 + gi_off], GT[(rb + i1) * 32 + gf_off], m0, dir, lane); }
#pragma unroll
        for (int i = 0; i < 4; ++i) { vtn[i] = *(const v4u*)(VT + c * 128 + (unsigned)(((tid >> 4) + 32 * i) * T + 8 * (tid & 15))); k0n[i] = *(const v4u*)(Kp + rb * DM + hh * 256 + (unsigned)(((tid >> 5) + 16 * i) * DM + 8 * (tid & 31))); }
        const bf16* qp = Qp + (rb + 16 * wave) * DM + hh * 256 + (unsigned)(fr * DM + 8 * fq);
#pragma unroll
        for (int kk = 0; kk < 8; ++kk) qf[kk] = *(const bf16x8*)(qp + 32 * kk);
    }
    for (int step = 0; step < nch; ++step) {
        const int c = dir ? nch - 1 - step : step; const int tok0 = c * 128; const size_t rb = row0 + tok0;
        const bool has_next = step + 1 < nch; const int cn = dir ? c - 1 : c + 1; const size_t rbn = row0 + (size_t)cn * 128;
        fr = fr0; fq = fq0; lane = lane0; tid = tid0; asm volatile("" : "+v"(fr), "+v"(fq), "+v"(lane), "+v"(tid));
        LAS float* arr = (LAS float*)(lds + ((step & 1) ? ML2_ARR1 : ML2_ARR0)); LAS float* arn = (LAS float*)(lds + ((step & 1) ? ML2_ARR0 : ML2_ARR1));
        LAS float* A_ = arr; LAS float* MM = arr + 128; LAS float* G_ = arr + 256; LAS float* EMT = arr + 384; LAS float* WE = arr + 512;
        if (step > 0) {
#pragma unroll
            for (int i = 0; i < 4; ++i) { vtn[i] = *(const v4u*)(VT + c * 128 + (unsigned)(((tid >> 4) + 32 * i) * T + 8 * (tid & 15))); k0n[i] = *(const v4u*)(Kp + rb * DM + hh * 256 + (unsigned)(((tid >> 5) + 16 * i) * DM + 8 * (tid & 31))); }
        }
        __syncthreads();
#pragma unroll
        for (int i = 0; i < 4; ++i) { const int cc = tid + NTHR * i; *(LAS v4u*)(VTL + (cc >> 4) * 136 + 8 * (cc & 15)) = vtn[i]; *(LAS v4u*)(KL + (cc >> 5) * 264 + 8 * (cc & 31)) = k0n[i]; }
        v4u k1r[4], akr[2][4];
        if (step > 0) { const bf16* qp = Qp + (rb + 16 * wave) * DM + hh * 256 + (unsigned)(fr * DM + 8 * fq);
#pragma unroll
            for (int kk = 0; kk < 8; ++kk) qf[kk] = *(const bf16x8*)(qp + 32 * kk); }
        float gn[4] = {0.f, 0.f, 0.f, 0.f};
        if (wave == scan_wave && has_next) { const int i0 = dir ? 127 - 2 * lane : 2 * lane, i1 = dir ? 126 - 2 * lane : 2 * lane + 1;
            gn[0] = GT[(rbn + i0) * 32 + gi_off]; gn[1] = GT[(rbn + i0) * 32 + gf_off]; gn[2] = GT[(rbn + i1) * 32 + gi_off]; gn[3] = GT[(rbn + i1) * 32 + gf_off]; }
        LDS_WAIT(); __syncthreads();
        const int tl_ = 16 * wave + fr;
        const float mm_t = MM[tl_], g_t = G_[tl_], emt = EMT[tl_];
        f32x4 o[8];
        {
            const LAS bf16* cb = CTL + fr * 264 + 8 * fq; bf16x8 ring[ML_DA]; const f32x4 zero4 = (f32x4){0.f, 0.f, 0.f, 0.f};
#define ML_A_RD(i_) (*(const LAS bf16x8*)(cb + (16 * (2 * ((i_) >> 4) + ((i_) & 1))) * 264 + 32 * (((i_) >> 1) & 7)))
#pragma unroll
            for (int d = 0; d < ML_DA; ++d) ring[d] = ML_A_RD(d);
#pragma unroll
            for (int i = 0; i < 64; ++i) { const int nt = 2 * (i >> 4) + (i & 1), kk = (i >> 1) & 7;
                __builtin_amdgcn_sched_barrier(0);
                const f32x4 oin = kk == 0 ? zero4 : o[nt]; o[nt] = MFMA16(ring[i % ML_DA], qf[kk], oin);
                if (kk == 7) o[nt] = o[nt] * g_t;
                if (i + ML_DA < 64) ring[i % ML_DA] = ML_A_RD(i + ML_DA);
                __builtin_amdgcn_sched_barrier(0); }
#undef ML_A_RD
        }
        float qn = 0.f;
#pragma unroll
        for (int kk = 0; kk < 8; ++kk) { const f32x4 n0 = *(const LAS f32x4*)(NV + 32 * kk + 8 * fq), n1 = *(const LAS f32x4*)(NV + 32 * kk + 8 * fq + 4);
#pragma unroll
            for (int jj = 0; jj < 4; ++jj) { qn += bf2f((unsigned short)qf[kk][jj]) * n0[jj]; qn += bf2f((unsigned short)qf[kk][4 + jj]) * n1[jj]; } }
        qn = rows_sum(qn);
        __builtin_amdgcn_sched_barrier(0);
#pragma unroll
        for (int i = 0; i < 4; ++i) k1r[i] = *(const v4u*)(Kp + (rb + 64) * DM + hh * 256 + (unsigned)(((tid >> 5) + 16 * i) * DM + 8 * (tid & 31)));
        float rsum = 0.f;
#pragma unroll
        for (int half = 0; half < 2; ++half) {
            if (half == 1) {
                __syncthreads();
#pragma unroll
                for (int i = 0; i < 4; ++i) { const int cc = tid + NTHR * i; *(LAS v4u*)(KL + (cc >> 5) * 264 + 8 * (cc & 31)) = k1r[i]; }
                LDS_WAIT(); __syncthreads();
            }
            if (half == scan_half && wave == scan_wave && has_next) ml2_scan(arn, gn[0], gn[1], gn[2], gn[3], arr[641], dir, lane);
#pragma unroll
            for (int pp = 0; pp < 2; ++pp) {
                const int p = 2 * half + pp, ta = 2 * p, tbb = 2 * p + 1;
                const bool na = dir ? ta >= wave : ta <= wave, nb = dir ? tbb >= wave : tbb <= wave;
                if (!na && !nb) continue;
                float pv[8];
#pragma unroll
                for (int which = 0; which < 2; ++which) {
                    const int st = which ? tbb : ta; const bool need = which ? nb : na;
                    f32x4 s4 = (f32x4){0.f, 0.f, 0.f, 0.f};
                    if (need) {
                        const LAS bf16* kb = KL + ((st & 3) * 16 + fr) * 264 + 8 * fq; bf16x8 ring[ML_DB];
#pragma unroll
                        for (int d = 0; d < ML_DB; ++d) ring[d] = *(const LAS bf16x8*)(kb + 32 * d);
#pragma unroll
                        for (int kk = 0; kk < 8; ++kk) {
                            __builtin_amdgcn_sched_barrier(0);
                            s4 = MFMA16(ring[kk % ML_DB], qf[kk], s4);
                            if (kk + ML_DB < 8) ring[kk % ML_DB] = *(const LAS bf16x8*)(kb + 32 * (kk + ML_DB));
                            __builtin_amdgcn_sched_barrier(0); }
                    }
                    if (need) {
                        const f32x4 a4 = *(const LAS f32x4*)(A_ + 16 * st + 4 * fq);
                        const int sgn = dir ? 1 : -1, d0 = sgn * (16 * st + 4 * fq - tl_), dlim = st == wave ? 0 : -(1 << 20);
#pragma unroll
                        for (int e = 0; e < 4; ++e) { float w = __expf(a4[e] - mm_t); w = (d0 + sgn * e >= dlim) ? w : 0.f;
                            pv[4 * which + e] = s4[e] * w; rsum += pv[4 * which + e]; }
                    } else {
#pragma unroll
                        for (int e = 0; e < 4; ++e) pv[4 * which + e] = 0.f; }
                }
                const bf16x8 pb = pack8(pv);
                {   const LAS bf16* vq = VTL + fr * 136 + 32 * p + 4 * fq; v2u rlo[ML_DV], rhi[ML_DV];
#pragma unroll
                    for (int d = 0; d < ML_DV; ++d) { rlo[d] = *(const LAS v2u*)(vq + (16 * d) * 136); rhi[d] = *(const LAS v2u*)(vq + (16 * d) * 136 + 16); }
#pragma unroll
                    for (int nt = 0; nt < 8; ++nt) {
                        __builtin_amdgcn_sched_barrier(0);
                        const v4u vv = (v4u){rlo[nt % ML_DV].x, rlo[nt % ML_DV].y, rhi[nt % ML_DV].x, rhi[nt % ML_DV].y}; o[nt] = MFMA16(__builtin_bit_cast(bf16x8, vv), pb, o[nt]);
                        if (nt + ML_DV < 8) { rlo[nt % ML_DV] = *(const LAS v2u*)(vq + (16 * (nt + ML_DV)) * 136); rhi[nt % ML_DV] = *(const LAS v2u*)(vq + (16 * (nt + ML_DV)) * 136 + 16); }
                        __builtin_amdgcn_sched_barrier(0); } }
            }
        }
        __builtin_amdgcn_sched_barrier(0);
#pragma unroll
        for (int mt = 0; mt < 2; ++mt) { const bf16* kp = KT + (size_t)(32 * wave + 16 * mt) * T + tok0 + (unsigned)(fr * T + 8 * fq);
#pragma unroll
            for (int kk = 0; kk < 4; ++kk) akr[mt][kk] = *(const v4u*)(kp + 32 * kk); }
        rsum = rows_sum(rsum);
        { const float den = rsum + g_t * qn; const float inv = 1.0f / fmaxf(fabsf(den), emt);
          bf16* op = HO + (rb + 16 * wave) * DM + hh * 256 + dvh * 128 + (unsigned)(fr * DM + 4 * fq);
#pragma unroll
          for (int nt = 0; nt < 8; ++nt) *(v2u*)(op + 16 * nt) = (v2u){pk2(o[nt][0] * inv, o[nt][1] * inv), pk2(o[nt][2] * inv, o[nt][3] * inv)}; }
        const float ge = arr[640];
        float nsum[2]; bf16x8 ak[2][4];
#pragma unroll
        for (int mt = 0; mt < 2; ++mt) { float ns = 0.f;
#pragma unroll
            for (int kk = 0; kk < 4; ++kk) { const v4u raw = akr[mt][kk]; const f32x4 w0 = *(const LAS f32x4*)(WE + 32 * kk + 8 * fq), w1 = *(const LAS f32x4*)(WE + 32 * kk + 8 * fq + 4);
                const unsigned rw[4] = {raw.x, raw.y, raw.z, raw.w}; float f[8];
#pragma unroll
                for (int e = 0; e < 4; ++e) { f[2 * e] = __uint_as_float(rw[e] << 16); f[2 * e + 1] = __uint_as_float(rw[e] & 0xffff0000u); }
                f[0] *= w0[0]; f[1] *= w0[1]; f[2] *= w0[2]; f[3] *= w0[3]; f[4] *= w1[0]; f[5] *= w1[1]; f[6] *= w1[2]; f[7] *= w1[3];
#pragma unroll
                for (int e = 0; e < 8; ++e) ns += f[e];
                ak[mt][kk] = pack8(f); }
            nsum[mt] = rows_sum(ns); }
        {   const LAS bf16* vb = VTL + fr * 136 + 8 * fq; bf16x8 ring[ML_DC];
#define ML_C_RD(i_) (*(const LAS bf16x8*)(vb + (16 * ((i_) >> 2)) * 136 + 32 * ((i_) & 3)))
#pragma unroll
            for (int d = 0; d < ML_DC; ++d) ring[d] = ML_C_RD(d);
#pragma unroll
            for (int i = 0; i < 32; ++i) { const int nt = i >> 2, kk = i & 3;
                __builtin_amdgcn_sched_barrier(0);
                if (kk == 0) { C[0][nt] = C[0][nt] * ge; C[1][nt] = C[1][nt] * ge; }
                C[0][nt] = MFMA16(ak[0][kk], ring[i % ML_DC], C[0][nt]); C[1][nt] = MFMA16(ak[1][kk], ring[i % ML_DC], C[1][nt]);
                if (i + ML_DC < 32) ring[i % ML_DC] = ML_C_RD(i + ML_DC);
                __builtin_amdgcn_sched_barrier(0); }
#undef ML_C_RD
        }
#pragma unroll
        for (int mt = 0; mt < 2; ++mt) {
#pragma unroll
            for (int nt = 0; nt < 8; ++nt) *(LAS v2u*)(CTL + (16 * nt + fr) * 264 + 32 * wave + 16 * mt + 4 * fq) = (v2u){pk2(C[mt][nt][0], C[mt][nt][1]), pk2(C[mt][nt][2], C[mt][nt][3])};
            if (fq == 0) { const int dk = 32 * wave + 16 * mt + fr; NV[dk] = ge * NV[dk] + nsum[mt]; }
        }
    }
    if (kind == 0) {
        float* oc = a.out + 83918848 + ((size_t)((b * 2 + dir) * 8 + hh) * 256) * 256 + dvh * 128;
#pragma unroll
        for (int mt = 0; mt < 2; ++mt)
#pragma unroll
            for (int nt = 0; nt < 8; ++nt)
#pragma unroll
                for (int e = 0; e < 4; ++e) oc[(unsigned)((32 * wave + 16 * mt + 4 * fq + e) * 256 + 16 * nt + fr)] = C[mt][nt][e];
        if (dvh == 0) { LDS_WAIT(); __syncthreads();
            if (tid < 256) a.out[100696064 + (size_t)((b * 2 + dir) * 8 + hh) * 256 + tid] = NV[tid];
            if (tid == 0) a.out[100761600 + (b * 2 + dir) * 8 + hh] = ((LAS float*)(lds + (((nch - 1) & 1) ? ML2_ARR1 : ML2_ARR0)))[641]; }
    }
}

#ifndef WGM_G1
#define WGM_G1 4
#endif
#ifndef WGM_N8
#define WGM_N8 4
#endif
template <int L, int F, bool FIRST>
__device__ __forceinline__ void ffn_gemm1(const Args& a, LAS unsigned char* lds, int G) {
    pg8::Gemm g{(const bf16*)(a.ws + WS_H), (const bf16*)(a.ws + (F == 0 ? WS_W1A : WS_W1B)), MT, 2 * DFF, DM / 2}; pg8::StaticOrder S; S.init(MT, 2 * DFF, G, (int)blockIdx.x, WGM_G1);
    pg8::EpiGluQ E{a.ws + WS_ACT, (const float*)(a.ws + WS_SA), (const float*)(a.ws + WS_SB1) + (F == 0 ? 0 : 11264)};
    pg8::gemm_phase<pg8::EpiGluQ, pg8::StaticOrder, PG8_ALIGN, PG8_SP2, 1>(lds, g, S, E);
}
template <int L, int F, bool FIRST>
__device__ __forceinline__ void ffn_gemm2(const Args& a, LAS unsigned char* lds, int G) {
    pg8::Gemm g{(const bf16*)(a.ws + WS_ACT), (const bf16*)(a.ws + (F == 0 ? WS_W2A : WS_W2B)), MT, DM, DFF / 2}; pg8::StaticOrder S; S.init(MT, DM, G, (int)blockIdx.x, WGM_N8);
    const float* modg = (const float*)(a.ws + WS_MOD) + (size_t)L * 9 * MODS + (size_t)(F == 0 ? 2 : 8) * DM;
    constexpr bool LAST = (L == 1 && F == 1);
    typedef pg8::EpiRes2<FIRST, LAST, true> EpiT;
    EpiT E{FIRST ? (const void*)a.in[0] : (LAST ? (const void*)(a.ws + WS_XB2) : (const void*)a.out), FIRST ? (const void*)(a.in[1] - (size_t)MP * DM) : nullptr, a.out, modg, (const float*)(a.ws + WS_SB2) + (F == 0 ? 0 : 2048), nullptr, LAST ? DM : XPITCH, XPITCH, 0.5f};
    pg8::gemm_phase<EpiT, pg8::StaticOrder, PG8_ALIGN, PG8_SP2, 2>(lds, g, S, E);
}
#define FFN_NORM norm_pass_q
#define FFN_CONV_ITEMS 416
#define FFN_CONV(l, f, slot, it) ffn_quant_item(a, l, f, slot, it, lds, wave, lane, tid)
__global__ void __launch_bounds__(NTHR, 2) fwd_kernel(Args a) {
    extern __shared__ __attribute__((aligned(16))) unsigned char lds_raw[];
    LAS unsigned char* lds = (LAS unsigned char*)lds_raw;
    const int tid = threadIdx.x, lane = tid & 63, wave = __builtin_amdgcn_readfirstlane(tid >> 6);
    const int G = gridDim.x;
    volatile LAS unsigned* MISC = (volatile LAS unsigned*)(lds + MISC_OFF);
    if (tid < 64) MISC[tid] = 0u;
    __syncthreads();
#if MK_ONE_LAUNCH
    XcdBarrier bar = xcd_barrier_post((unsigned*)(a.ws + WS_CTL) + CW_BAR, MISC + 8);
#define GRID_BAR() xcd_barrier(bar)
#else
#define GRID_BAR() do { } while (0)
#endif
    const int lo = a.ph_lo, hi = a.ph_hi;
#define IN(k) (lo <= (k) && (k) < hi)
#define SEAM(k) do { if (IN(k) && IN((k) + 1)) GRID_BAR(); } while (0)
    const int NGW = G * NWAVES, gw = blockIdx.x * NWAVES + wave;

    if (IN(0)) { phase_p0(a, lds, G, wave, lane, tid); } SEAM(0);
    if (IN(1)) { FFN_NORM<true>(a, 0, 0, G, wave, lane); } SEAM(1);
    if (IN(2)) { ffn_gemm1<0, 0, true>(a, lds, G); } SEAM(2);
    if (IN(3)) { ffn_gemm2<0, 0, true>(a, lds, G); } SEAM(3);
    if (IN(4)) { norm_pass<false>(a, 0, 1, G, wave, lane);
        for (int it = blockIdx.x; it < FFN_CONV_ITEMS; it += G) FFN_CONV(1, 0, 0, it); }
    if (IN(5)) { pg8::Gemm g{(const bf16*)(a.ws + WS_H), (const bf16*)(a.ws + WS_WINAB), MT, 5120, DM}; pg8::StaticOrder S; S.init(MT, 5120, G, (int)blockIdx.x);
        pg8::EpiBf16<0> E{(bf16*)(a.ws + WS_Z), 5120, nullptr, 0, 0, 1.f};
        pg8::gemm_phase<pg8::EpiBf16<0>, pg8::StaticOrder, PG8_ALIGN, PG8_SP2>(lds, g, S, E); } SEAM(5);
    if (IN(6)) { for (int it = blockIdx.x; it < 1152; it += G) lru_item<1>(a, it >> 3, it & 7, lds, wave, lane, tid);
        { int ib, ni; tail_ids(1152, G, ib, ni); if (ib >= 0) for (int it = ib; it < 576; it += ni) ab_post_item(a, it, lds, wave, lane); } } SEAM(6);
    if (IN(7)) { { for (int it = blockIdx.x; it < 1152; it += G) lru_item<2>(a, it >> 3, it & 7, lds, wave, lane, tid); }
        { const int xu = (G % 8 == 0) ? ((int)blockIdx.x % 8) * (G / 8) + (int)blockIdx.x / 8 : (int)blockIdx.x;
          for (int u = xu; u < 2048; u += G) attn_block(a, 1, u >> 8, (u >> 5) & 7, u & 31, lds, wave, lane, tid);
        { int ib, ni; tail_ids(1152, G, ib, ni); if (ib >= 0) for (int u = ib; u < 256; u += ni) attn_block(a, 0, u >> 4, (u >> 1) & 7, u & 1, lds, wave, lane, tid); } } } SEAM(7);
    if (IN(8)) { pg8::Gemm g{(const bf16*)(a.ws + WS_H), (const bf16*)(a.ws + WS_WOUTAB), MT, DM, DM}; pg8::StaticOrder S; S.init(MT, DM, G, (int)blockIdx.x, WGM_N8);
        typedef pg8::EpiRes2<false, false, false> EpiT; EpiT E{a.out, nullptr, a.out, (const float*)(a.ws + WS_MOD) + 5 * DM, nullptr, nullptr, XPITCH, XPITCH, 1.0f};
        pg8::gemm_phase<EpiT, pg8::StaticOrder, PG8_ALIGN, PG8_SP2>(lds, g, S, E); } SEAM(8);
    if (IN(9)) { FFN_NORM<false>(a, 0, 2, G, wave, lane); } SEAM(9);
    if (IN(10)) { ffn_gemm1<0, 1, false>(a, lds, G); } SEAM(10);
    if (IN(11)) { ffn_gemm2<0, 1, false>(a, lds, G); } SEAM(11);
    if (IN(12)) { FFN_NORM<false>(a, 1, 0, G, wave, lane);
        for (int it = blockIdx.x; it < FFN_CONV_ITEMS; it += G) FFN_CONV(1, 1, 1, it); }
    if (IN(13)) { ffn_gemm1<1, 0, false>(a, lds, G); } SEAM(13);
    if (IN(14)) { ffn_gemm2<1, 0, false>(a, lds, G); } SEAM(14);
    if (IN(15)) { norm_pass_dual<false>(a, 1, 1, G, wave, lane); } SEAM(15);
    if (IN(16)) {
        { pg8::Gemm g{(const bf16*)(a.ws + WS_H), (const bf16*)(a.ws + WS_WINC), MT, 4352, DM}; pg8::StaticOrder S; S.init(MT, 4352, G, (int)blockIdx.x);
          typedef pg8::EpiProj<false, 1> EpiT; EpiT E{(bf16*)(a.ws + WS_PL), (float*)(a.ws + WS_GATES), nullptr, nullptr};
          pg8::gemm_phase<EpiT, pg8::StaticOrder, PG8_ALIGN, PG8_SP2>(lds, g, S, E); }
        { pg8::Gemm g{(const bf16*)(a.ws + WS_H8M), (const bf16*)(a.ws + WS_WQC), MT, 4096, DM / 2}; pg8::StaticOrder S; S.init(MT, 4096, G, G - 1 - (int)blockIdx.x);
          typedef pg8::EpiProj<true, 1> EpiT; EpiT E{(bf16*)(a.ws + WS_PL), nullptr, (const float*)(a.ws + WS_SA), (const float*)(a.ws + WS_SBQC)};
          pg8::gemm_phase<EpiT, pg8::StaticOrder, PG8_ALIGN, PG8_SP2, 1>(lds, g, S, E); } } SEAM(16);
    if (IN(17)) { for (int it = blockIdx.x; it < 576; it += G) c_post_item(a, it, lds, wave, lane, tid); } SEAM(17);
    if (IN(18)) {
        const int xu = (G % 8 == 0) ? ((int)blockIdx.x % 8) * (G / 8) + (int)blockIdx.x / 8 : (int)blockIdx.x;
        for (int u = xu; u < 256; u += G) mlstm_unit2(a, 1, u >> 5, (u >> 2) & 7, (u >> 1) & 1, u & 1, lds, wave, lane, tid);
        for (int u = xu; u < 512; u += G) mlstm_unit2(a, 0, u >> 5, (u >> 2) & 7, (u >> 1) & 1, u & 1, lds, wave, lane, tid); } SEAM(18);
    if (IN(19)) { c_final_pass(a, G, wave, lane); } SEAM(19);
    if (IN(20)) { pg8::Gemm g{(const bf16*)(a.ws + WS_H), (const bf16*)(a.ws + WS_WQOC), MT, DM, DM / 2}; pg8::StaticOrder S; S.init(MT, DM, G, (int)blockIdx.x, WGM_N8);
        typedef pg8::EpiRes2<false, false, true, true> EpiT; EpiT E{a.out, nullptr, a.ws + WS_XB2, (const float*)(a.ws + WS_MOD) + (size_t)9 * MODS + 5 * DM, (const float*)(a.ws + WS_SBOC), (const float*)(a.ws + WS_SA), XPITCH, DM, 1.0f};
        pg8::gemm_phase<EpiT, pg8::StaticOrder, PG8_ALIGN, PG8_SP2, 1>(lds, g, S, E); } SEAM(20);
    if (IN(21)) { FFN_NORM<false, true>(a, 1, 2, G, wave, lane); } SEAM(21);
    if (IN(22)) { ffn_gemm1<1, 1, false>(a, lds, G); } SEAM(22);
    if (IN(23)) { ffn_gemm2<1, 1, false>(a, lds, G); }
#undef IN
#undef SEAM
}

extern "C" void kernel_launch(void* const* d_in, const int* in_sizes, int n_in, void* d_out, int out_size, void* d_ws, size_t ws_size, hipStream_t stream) {
    static int grid = 0;
    if (grid == 0) {
        if (n_in != 32 || out_size != 100761856 || ws_size < WS_END) { fprintf(stderr, "kernel_launch: unexpected problem (n_in %d, out %d, ws %zu < %zu)\n", n_in, out_size, ws_size, (size_t)WS_END); grid = -1; return; }
        int dev = 0, cus = 0, per_cu = 0;
        if (hipGetDevice(&dev) != hipSuccess || hipDeviceGetAttribute(&cus, hipDeviceAttributeMultiprocessorCount, dev) != hipSuccess) { grid = -1; return; }
        if (hipFuncSetAttribute((const void*)fwd_kernel, hipFuncAttributeMaxDynamicSharedMemorySize, LDS_BYTES) != hipSuccess) { fprintf(stderr, "kernel_launch: hipFuncSetAttribute failed\n"); grid = -1; return; }
        if (hipOccupancyMaxActiveBlocksPerMultiprocessor(&per_cu, (const void*)fwd_kernel, NTHR, LDS_BYTES) != hipSuccess || per_cu < 1) fprintf(stderr, "kernel_launch: occupancy query says %d\n", per_cu);
        (void)hipGetLastError();
        grid = cus;
    }
    if (grid < 0) return;
    (void)hipMemsetAsync((char*)d_ws + WS_CTL, 0, CTL_ZERO_BYTES, stream);
    Args a{};
    for (int i = 0; i < 32; ++i) a.in[i] = (const float*)d_in[i];
    a.out = (float*)d_out; a.ws = (unsigned char*)d_ws;
#if MK_ONE_LAUNCH
    a.ph_lo = 0; a.ph_hi = N_PHASES;
    hipLaunchKernelGGL(fwd_kernel, dim3(grid), dim3(NTHR), LDS_BYTES, stream, a);
#else
    for (int p = 0; p < N_PHASES; ++p) { a.ph_lo = p; a.ph_hi = p + 1; hipLaunchKernelGGL(fwd_kernel, dim3(grid), dim3(NTHR), LDS_BYTES, stream, a); }
#endif
}
```

```cpp
#include <hip/hip_runtime.h>
#include <cstdio>
#include <cstdint>
#define MK_ONE_LAUNCH 1

namespace pg8 {
#define PG8_LAS __attribute__((address_space(3)))
typedef unsigned short bf16_t;
typedef short bf16x8 __attribute__((ext_vector_type(8)));
typedef float f32x4 __attribute__((ext_vector_type(4)));
typedef unsigned u32x4 __attribute__((ext_vector_type(4)));
typedef int i32x4 __attribute__((ext_vector_type(4)));
typedef int i32x8 __attribute__((ext_vector_type(8)));
constexpr int BM = 256, BK = 64, HALF = 128, HTB = HALF * BK * 2  , STAGE_BYTES = 8 * HTB, NXCD = 8, WGM = 4;

__host__ __device__ __forceinline__ int lds_byte(int r, int c) { const int st = (r >> 4) * 2 + (c >> 5), rr = r & 15, cc = c & 31, ob = rr * 64 + cc * 2; return st * 1024 + (ob ^ (((ob >> 9) & 1) << 5)); }
__host__ __device__ __forceinline__ void stage_rc(int b, int& R, int& C) { const int st = b / 1024, sb = b % 1024, swz = sb ^ (((sb >> 9) & 1) << 5); R = (st >> 1) * 16 + swz / 64; C = (st & 1) * 32 + (swz % 64) / 2; }
__host__ __device__ __forceinline__ int perm32(int rho) { const int n = rho >> 4, i = rho & 15; return 8 * (i >> 2) + 4 * n + (i & 3); }

struct Unit { int pm, pn; };
struct Gemm { const bf16_t* A; const bf16_t* Bt; int M, N, K; };

struct StaticOrder {
    int nM, nN, nwg, G, c, wgm;
    __host__ __device__ void init(int M, int N, int G_, int c_, int wgm_ = WGM) { nM = M / BM; nN = N / BM; nwg = nM * nN; G = G_; c = c_; wgm = wgm_; }
    __host__ __device__ bool next(int i, Unit& u) const {
        const long L = (long)i * G + c; if (L >= nwg) return false;
        int wgid = (int)L; { const int q = nwg / NXCD, r = nwg % NXCD, xcd = wgid % NXCD, off = wgid / NXCD; wgid = (xcd < r ? xcd * (q + 1) : r * (q + 1) + (xcd - r) * q) + off; }
        const int nig = wgm * nN, gid = wgid / nig, fm = gid * wgm, gsz = (nM - fm) < wgm ? (nM - fm) : wgm;
        u.pm = fm + ((wgid % nig) % gsz); u.pn = (wgid % nig) / gsz; return true;
    }
    __device__ __forceinline__ void a_ready(const Unit&) const {}
    __device__ __forceinline__ void done(const Unit&) const {}
};

__device__ __forceinline__ unsigned cvt_pk_bf16(float lo, float hi) { unsigned r; asm volatile("v_cvt_pk_bf16_f32 %0, %1, %2" : "=v"(r) : "v"(lo), "v"(hi)); return r; }
typedef float f32x2 __attribute__((ext_vector_type(2)));
__device__ __forceinline__ f32x2 gelu_pk(f32x2 v) {
    const f32x2 av = __builtin_elementwise_abs(v), d = av * 0.2316418882f + 1.0f;
    f32x2 t; t.x = __builtin_amdgcn_rcpf(d.x); t.y = __builtin_amdgcn_rcpf(d.y);
    f32x2 q = t * 0.5307027145f + (-0.7265760135f); q = q * t + 0.7107068705f; q = q * t + (-0.142248368f); q = q * t + 0.127414796f; q = q * t;
    const f32x2 s = (v * v) * (-0.72134752044f);
    f32x2 e; e.x = __builtin_amdgcn_exp2f(s.x); e.y = __builtin_amdgcn_exp2f(s.y);
    const f32x2 m = v * (q * e), r = v - m;
    f32x2 o; o.x = v.x < 0.f ? m.x : r.x; o.y = v.y < 0.f ? m.y : r.y; return o;
}

template <int ACT  > struct EpiBf16 {
    static constexpr bool PERM = true, AFTER_DRAIN = false; static_assert(ACT == 0 || ACT == 1, "EpiBf16: ACT is 0 (none) or 1 (gelu_pk)");
    bf16_t* O; int ldc; const float* bias; int split_cols; size_t split_stride; float scale0;
    __device__ __forceinline__ void operator()(const f32x4 (&acc)[2][2][4][2], const Unit& u, int wr, int wc, int fr, int fq) const {
        const int row0 = u.pm * BM + wr * 64 + fr; int colt = u.pn * BM; bf16_t* base = O;
        float sc = 1.f; if (split_cols) { const int t = colt / split_cols; base += (size_t)t * split_stride; colt -= t * split_cols; if (t == 0) sc = scale0; }
        const int col0 = colt + wc * 32 + 8 * fq, bcol0 = u.pn * BM + wc * 32 + 8 * fq;
        f32x4 bv[2][2];
#pragma unroll
        for (int bj = 0; bj < 2; ++bj)
#pragma unroll
            for (int n = 0; n < 2; ++n) bv[bj][n] = bias ? *(const f32x4*)(bias + bcol0 + bj * HALF + 4 * n) : (f32x4){0.f, 0.f, 0.f, 0.f};
#pragma unroll
        for (int ai = 0; ai < 2; ++ai)
#pragma unroll
            for (int m = 0; m < 4; ++m) { bf16_t* rowp = base + (size_t)(row0 + ai * HALF + m * 16) * ldc + col0;
#pragma unroll
                for (int bj = 0; bj < 2; ++bj) { f32x4 v0 = acc[ai][bj][m][0] + bv[bj][0], v1 = acc[ai][bj][m][1] + bv[bj][1];
                    if (ACT == 1) { f32x2 a = gelu_pk((f32x2){v0[0], v0[1]}), b = gelu_pk((f32x2){v0[2], v0[3]}), c = gelu_pk((f32x2){v1[0], v1[1]}), d = gelu_pk((f32x2){v1[2], v1[3]});
                        v0 = (f32x4){a.x, a.y, b.x, b.y}; v1 = (f32x4){c.x, c.y, d.x, d.y}; }
                    v0 = v0 * sc; v1 = v1 * sc; u32x4 w; w.x = cvt_pk_bf16(v0[0], v0[1]); w.y = cvt_pk_bf16(v0[2], v0[3]); w.z = cvt_pk_bf16(v1[0], v1[1]); w.w = cvt_pk_bf16(v1[2], v1[3]);
                    *(u32x4*)(rowp + bj * HALF) = w; } }
    }
};

constexpr int EP_M = 36864, EP_D = 2048, EP_FF = 5632, EP_MODS = 9 * 2048;
__device__ __forceinline__ int set_of_pm(int pm) { return pm < 16 ? 0 : 1 + ((pm - 16) >> 4); }
__device__ __forceinline__ unsigned pk4_fp8(float a, float b, float c, float d) { int w = 0; w = __builtin_amdgcn_cvt_pk_fp8_f32(a, b, w, false); w = __builtin_amdgcn_cvt_pk_fp8_f32(c, d, w, true); return (unsigned)w; }
struct EpiGluQ {
    static constexpr bool PERM = true, AFTER_DRAIN = false;
    unsigned char* O; const float* sa; const float* sb;
    __device__ __forceinline__ void operator()(const f32x4 (&acc)[2][2][4][2], const Unit& u, int wr, int wc, int fr, int fq) const {
        const int row0 = u.pm * BM + wr * 64 + fr, col0 = u.pn * HALF + wc * 32 + 8 * fq, brow = u.pn * BM + wc * 32 + 8 * fq;
        float sr[2][4];
#pragma unroll
        for (int ai = 0; ai < 2; ++ai)
#pragma unroll
            for (int m = 0; m < 4; ++m) sr[ai][m] = sa[row0 + ai * HALF + m * 16];
        const f32x4 sg0 = *(const f32x4*)(sb + brow), sg1 = *(const f32x4*)(sb + brow + 4), su0 = *(const f32x4*)(sb + brow + HALF), su1 = *(const f32x4*)(sb + brow + HALF + 4);
#pragma unroll
        for (int ai = 0; ai < 2; ++ai)
#pragma unroll
            for (int m = 0; m < 4; ++m) { const int row = row0 + ai * HALF + m * 16; const float s = sr[ai][m];
                float v[8];
#pragma unroll
                for (int n = 0; n < 2; ++n) { const i32x4 gi = __builtin_bit_cast(i32x4, acc[ai][0][m][n]), ui = __builtin_bit_cast(i32x4, acc[ai][1][m][n]);
#pragma unroll
                    for (int j = 0; j < 4; ++j) { const float g = (float)gi[j] * s * (n ? sg1[j] : sg0[j]), up = (float)ui[j] * s * (n ? su1[j] : su0[j]); v[4 * n + j] = g * up * __builtin_amdgcn_rcpf(1.0f + __expf(-g)); } }
                typedef unsigned u32x2 __attribute__((ext_vector_type(2)));
                *(u32x2*)(O + (size_t)row * EP_FF + col0) = (u32x2){pk4_fp8(v[0], v[1], v[2], v[3]), pk4_fp8(v[4], v[5], v[6], v[7])}; }
    }
};

template <bool F32> struct ResRaw { typedef f32x4 T; };
template <> struct ResRaw<false> { typedef unsigned T __attribute__((ext_vector_type(2))); };
template <bool BASE_F32, bool OUT_F32, bool QS, bool I8A = false> struct EpiRes2 {
    static constexpr bool PERM = false, AFTER_DRAIN = false;
    const void* base_p; const void* base_s; void* out; const float* modg; const float* sb; const float* sa; int bpitch, opitch; float coef;
    __device__ __forceinline__ void operator()(const f32x4 (&acc)[2][2][4][2], const Unit& u, int wr, int wc, int fr, int fq) const {
        typedef unsigned u32x2_ __attribute__((ext_vector_type(2)));
        typedef typename ResRaw<BASE_F32>::T RawT;
        constexpr int NB = 8, D = BASE_F32 ? 2 : 4;
        const int row0 = u.pm * BM + wr * 64 + fr, col0 = u.pn * BM + wc * 32 + 4 * fq;
        const float* gp = modg + (size_t)set_of_pm(u.pm) * EP_MODS + col0;
        const float* bf = (const float*)(u.pm < 16 ? base_p : base_s); const bf16_t* bh = (const bf16_t*)base_p;
        float rsv[NB];
        if (I8A) {
#pragma unroll
            for (int k = 0; k < NB; ++k) rsv[k] = sa[row0 + (k >> 2) * HALF + (k & 3) * 16]; }
        f32x4 gv[2][2], sv[2][2];
#pragma unroll
        for (int bj = 0; bj < 2; ++bj)
#pragma unroll
            for (int n = 0; n < 2; ++n) { gv[bj][n] = *(const f32x4*)(gp + bj * HALF + n * 16); if (QS) sv[bj][n] = *(const f32x4*)(sb + col0 + bj * HALF + n * 16); }
        typedef unsigned u32x4_ __attribute__((ext_vector_type(4)));
        const int wcol = col0 + ((fq & 1) ? 12 : 0);
#pragma unroll
        for (int g = 0; g < NB / D; ++g) {
            RawT raw[D][2][2]; u32x4_ raww[D][2];
#pragma unroll
            for (int d = 0; d < D; ++d) { const int k = g * D + d, row = row0 + (k >> 2) * HALF + (k & 3) * 16;
#pragma unroll
                for (int bj = 0; bj < 2; ++bj) {
                    if constexpr (BASE_F32) {
#pragma unroll
                        for (int n = 0; n < 2; ++n) raw[d][bj][n] = *(const RawT*)(bf + (size_t)row * EP_D + col0 + bj * HALF + n * 16); }
                    else raww[d][bj] = *(const u32x4_*)(bh + (size_t)row * bpitch + wcol + bj * HALF); } }
            if (g == 0) {
#pragma unroll
                for (int bj = 0; bj < 2; ++bj)
#pragma unroll
                    for (int n = 0; n < 2; ++n) { gv[bj][n] = gv[bj][n] * coef; if (QS) gv[bj][n] = gv[bj][n] * sv[bj][n]; } }
#pragma unroll
            for (int d = 0; d < D; ++d) { const int k = g * D + d, ai = k >> 2, m = k & 3, row = row0 + ai * HALF + m * 16; const float rs = I8A ? rsv[k] : 1.0f;
#pragma unroll
                for (int bj = 0; bj < 2; ++bj) {
                    u32x2_ bw[2];
                    if constexpr (!BASE_F32) { const auto sx = __builtin_amdgcn_permlane16_swap(raww[d][bj].x, raww[d][bj].z, false, false), sy = __builtin_amdgcn_permlane16_swap(raww[d][bj].y, raww[d][bj].w, false, false);
                        bw[0] = (u32x2_){sx[0], sy[0]}; bw[1] = (u32x2_){sx[1], sy[1]}; }
                    u32x2_ pk[2];
#pragma unroll
                    for (int n = 0; n < 2; ++n) { const int col = col0 + bj * HALF + n * 16; f32x4 b;
                        if constexpr (BASE_F32) b = raw[d][bj][n];
                        else { const u32x2_ w = bw[n]; b = (f32x4){__uint_as_float(w.x << 16), __uint_as_float(w.x & 0xffff0000u), __uint_as_float(w.y << 16), __uint_as_float(w.y & 0xffff0000u)}; }
                        f32x4 av = acc[ai][bj][m][n];
                        if (I8A) { const i32x4 iv = __builtin_bit_cast(i32x4, av); av = (f32x4){(float)iv[0], (float)iv[1], (float)iv[2], (float)iv[3]} * rs; }
                        f32x4 o = b + gv[bj][n] * av;
#ifdef PROBE_YSCALE
                        if (OUT_F32) o = o * PROBE_YSCALE;
#endif
                        if (OUT_F32) *(f32x4*)((float*)out + (size_t)row * EP_D + col) = o;
                        else pk[n] = (u32x2_){cvt_pk_bf16(o[0], o[1]), cvt_pk_bf16(o[2], o[3])}; }
                    if constexpr (!OUT_F32) { const auto sx = __builtin_amdgcn_permlane16_swap(pk[0].x, pk[1].x, false, false), sy = __builtin_amdgcn_permlane16_swap(pk[0].y, pk[1].y, false, false);
                        *(u32x4_*)((bf16_t*)out + (size_t)row * opitch + wcol + bj * HALF) = (u32x4_){sx[0], sy[0], sx[1], sy[1]}; } } }
        }
    }
};
template <bool I8, int WHICH> struct EpiProj {
    static constexpr bool PERM = true, AFTER_DRAIN = false;
    bf16_t* dst; float* gates; const float* sa; const float* sb;
    __device__ __forceinline__ void operator()(const f32x4 (&acc)[2][2][4][2], const Unit& u, int wr, int wc, int fr, int fq) const {
        const int row0 = u.pm * BM + wr * 64 + fr;
        if (!I8 && WHICH == 1 && u.pn == 16) {
            if (wc == 0) {
#pragma unroll
                for (int ai = 0; ai < 2; ++ai)
#pragma unroll
                    for (int m = 0; m < 4; ++m) { float* gp = gates + (size_t)(row0 + ai * HALF + m * 16) * 32 + 8 * fq; *(f32x4*)gp = acc[ai][0][m][0]; *(f32x4*)(gp + 4) = acc[ai][0][m][1]; }
            }
            return;
        }
        bf16_t* base; int pitch;
        if (WHICH == 0) { pitch = 5120; base = dst + (I8 ? (u.pn < 4 ? 256 * u.pn : 3072 + 256 * (u.pn - 4)) : 1024 + 256 * u.pn); }
        else { pitch = EP_D; base = dst + (size_t)(I8 ? (u.pn < 8 ? 0 : 3) : 1 + (u.pn >> 3)) * ((size_t)EP_M * EP_D) + 256 * (u.pn & 7); }
        const int col0 = wc * 32 + 8 * fq, brow = u.pn * BM + wc * 32 + 8 * fq;
        f32x4 sc[2][2]; float sr[2][4];
        if (I8) {
#pragma unroll
            for (int ai = 0; ai < 2; ++ai)
#pragma unroll
                for (int m = 0; m < 4; ++m) sr[ai][m] = sa[row0 + ai * HALF + m * 16];
#pragma unroll
            for (int bj = 0; bj < 2; ++bj) { sc[bj][0] = *(const f32x4*)(sb + brow + bj * HALF); sc[bj][1] = *(const f32x4*)(sb + brow + bj * HALF + 4); } }
#pragma unroll
        for (int ai = 0; ai < 2; ++ai)
#pragma unroll
            for (int m = 0; m < 4; ++m) { const int row = row0 + ai * HALF + m * 16; bf16_t* rowp = base + (size_t)row * pitch + col0; const float s = I8 ? sr[ai][m] : 1.0f;
#pragma unroll
                for (int bj = 0; bj < 2; ++bj) { f32x4 v0, v1;
                    if (I8) { const i32x4 i0 = __builtin_bit_cast(i32x4, acc[ai][bj][m][0]), i1 = __builtin_bit_cast(i32x4, acc[ai][bj][m][1]);
                        v0 = (f32x4){(float)i0[0], (float)i0[1], (float)i0[2], (float)i0[3]} * sc[bj][0] * s; v1 = (f32x4){(float)i1[0], (float)i1[1], (float)i1[2], (float)i1[3]} * sc[bj][1] * s; }
                    else { v0 = acc[ai][bj][m][0]; v1 = acc[ai][bj][m][1]; }
                    u32x4 w; w.x = cvt_pk_bf16(v0[0], v0[1]); w.y = cvt_pk_bf16(v0[2], v0[3]); w.z = cvt_pk_bf16(v1[0], v1[1]); w.w = cvt_pk_bf16(v1[2], v1[3]);
                    *(u32x4*)(rowp + bj * HALF) = w; } }
    }
};

template <class Epi, class Sched, bool ALIGN_EPI = false, bool SP2 = false, int MODE = 0  >
__device__ __forceinline__ void gemm_phase(PG8_LAS unsigned char* lds, const Gemm g, const Sched& S, const Epi& E) {
    int tid_ = threadIdx.x; asm volatile("" : "+v"(tid_));
    const int tid = tid_, wid = __builtin_amdgcn_readfirstlane(tid >> 6), lane = tid & 63, wr = wid >> 2, wc = wid & 3, fr = lane & 15, fq = lane >> 4;
    const int K = g.K, nt = K / BK;
    unsigned voffA[2], voffB[2];
#pragma unroll
    for (int i = 0; i < 2; ++i) { int R, C; stage_rc(tid * 16 + i * 8192, R, C); const int Rb = Epi::PERM ? ((R & ~31) + perm32(R & 31)) : R;
        voffA[i] = (unsigned)(R * K + C) * 2u; voffB[i] = (unsigned)(Rb * K + C) * 2u; }
    const size_t kstep = (size_t)(BK * 2);
    const size_t hstep = (size_t)HALF * K * 2;
    const size_t tstep = 2 * hstep;
    const unsigned ldsw = (unsigned)wid * 1024u;
    const int aoff = lds_byte(wr * 64 + fr, fq * 8), boff = lds_byte(wc * 32 + fr, fq * 8);
#define PG8_SA(b, h) (((b) * 2 + (h)) * HTB)
#define PG8_SB(b, h) ((4 + (b) * 2 + (h)) * HTB)
#define PG8_STAGE(bufoff, gbase, voff) do { _Pragma("unroll") for (int _i = 0; _i < 2; ++_i) \
        __builtin_amdgcn_global_load_lds((const unsigned*)((const char*)(gbase) + (voff)[_i]), (PG8_LAS unsigned*)(lds + (bufoff) + ldsw + _i * 8192), 16, 0, 0); } while (0)
#define PG8_LDA(dst, b, h) do { if constexpr (MODE == 2) { _Pragma("unroll") for (int m = 0; m < 4; ++m) { const i32x4 lo_ = *(const PG8_LAS i32x4*)(lds + PG8_SA(b, h) + aoff + m * 2048), hi_ = *(const PG8_LAS i32x4*)(lds + PG8_SA(b, h) + aoff + m * 2048 + 1024); dst##8[m] = __builtin_shufflevector(lo_, hi_, 0, 1, 2, 3, 4, 5, 6, 7); } } \
        else { _Pragma("unroll") for (int m = 0; m < 4; ++m) _Pragma("unroll") for (int k = 0; k < 2; ++k) dst[m][k] = *(const PG8_LAS bf16x8*)(lds + PG8_SA(b, h) + aoff + m * 2048 + k * 1024); } } while (0)
#define PG8_LDB(dst, b, h) do { if constexpr (MODE == 2) { _Pragma("unroll") for (int n = 0; n < 2; ++n) { const i32x4 lo_ = *(const PG8_LAS i32x4*)(lds + PG8_SB(b, h) + boff + n * 2048), hi_ = *(const PG8_LAS i32x4*)(lds + PG8_SB(b, h) + boff + n * 2048 + 1024); dst##8[n] = __builtin_shufflevector(lo_, hi_, 0, 1, 2, 3, 4, 5, 6, 7); } } \
        else { _Pragma("unroll") for (int n = 0; n < 2; ++n) _Pragma("unroll") for (int k = 0; k < 2; ++k) dst[n][k] = *(const PG8_LAS bf16x8*)(lds + PG8_SB(b, h) + boff + n * 2048 + k * 1024); } } while (0)
#define PG8_MMA(ai, bj, At, Bt) do { __builtin_amdgcn_s_setprio(1); _Pragma("unroll") for (int m = 0; m < 4; ++m) _Pragma("unroll") for (int n = 0; n < 2; ++n) { \
        if constexpr (MODE == 0) { _Pragma("unroll") for (int k = 0; k < 2; ++k) acc[ai][bj][m][n] = __builtin_amdgcn_mfma_f32_16x16x32_bf16(Bt[n][k], At[m][k], acc[ai][bj][m][n], 0, 0, 0); } \
        else if constexpr (MODE == 1) { _Pragma("unroll") for (int k = 0; k < 2; ++k) acc[ai][bj][m][n] = __builtin_bit_cast(f32x4, __builtin_amdgcn_mfma_i32_16x16x64_i8(__builtin_bit_cast(i32x4, Bt[n][k]), __builtin_bit_cast(i32x4, At[m][k]), __builtin_bit_cast(i32x4, acc[ai][bj][m][n]), 0, 0, 0)); } \
        else { asm volatile("v_mfma_f32_16x16x128_f8f6f4 %0, %1, %2, %0" : "+v"(acc[ai][bj][m][n]) : "v"(Bt##8[n]), "v"(At##8[m])); } } \
        __builtin_amdgcn_s_setprio(0); } while (0)
#define PG8_WAIT_V(n) asm volatile("s_waitcnt vmcnt(" #n ")" ::: "memory")
#define PG8_WAIT_L(n) asm volatile("s_waitcnt lgkmcnt(" #n ")" ::: "memory")
#define PG8_BAR __builtin_amdgcn_s_barrier()
#define PG8_SCHED __builtin_amdgcn_sched_barrier(0)
    Unit cur, nxt; int ui = 0;
    if (!S.next(0, cur)) return;
    f32x4 acc[2][2][4][2];
#pragma unroll
    for (int a = 0; a < 2; ++a)
#pragma unroll
        for (int b = 0; b < 2; ++b)
#pragma unroll
            for (int m = 0; m < 4; ++m)
#pragma unroll
                for (int n = 0; n < 2; ++n) acc[a][b][m][n] = (f32x4){0.f, 0.f, 0.f, 0.f};
    bf16x8 At[4][2], B0[2][2], B1[2][2]; i32x8 At8[4], B08[2], B18[2];
    const char* cA = (const char*)g.A + (size_t)cur.pm * tstep; const char* cB = (const char*)g.Bt + (size_t)cur.pn * tstep;
    S.a_ready(cur);
    if constexpr (SP2) {
        PG8_STAGE(PG8_SB(0, 0), cB, voffB); PG8_STAGE(PG8_SB(0, 1), cB + hstep, voffB); PG8_STAGE(PG8_SA(0, 0), cA, voffA); PG8_STAGE(PG8_SA(0, 1), cA + hstep, voffA);
        if (wr == 1) PG8_BAR;
        PG8_WAIT_V(2); PG8_BAR;
        PG8_STAGE(PG8_SB(1, 0), cB + kstep, voffB); PG8_STAGE(PG8_SA(1, 0), cA + kstep, voffA); PG8_STAGE(PG8_SB(1, 1), cB + hstep + kstep, voffB);
        PG8_WAIT_V(6); PG8_BAR;
    } else {
        PG8_STAGE(PG8_SB(0, 0), cB, voffB); PG8_STAGE(PG8_SA(0, 0), cA, voffA); PG8_STAGE(PG8_SB(0, 1), cB + hstep, voffB); PG8_STAGE(PG8_SA(0, 1), cA + hstep, voffA);
        if (wr == 1) PG8_BAR;
        PG8_WAIT_V(4); PG8_BAR;
        PG8_STAGE(PG8_SB(1, 0), cB + kstep, voffB); PG8_STAGE(PG8_SA(1, 0), cA + kstep, voffA); PG8_STAGE(PG8_SB(1, 1), cB + hstep + kstep, voffB);
        PG8_WAIT_V(6); PG8_BAR;
    }
    for (;;) {
        const bool has_next = S.next(ui + 1, nxt);
        const char* nA = has_next ? (const char*)g.A + (size_t)nxt.pm * tstep : cA; const char* nB = has_next ? (const char*)g.Bt + (size_t)nxt.pn * tstep : cB;
        for (int t = 0; t < nt; t += 2) {
            const bool last = (t == nt - 2);
            const char* a1 = cA + (size_t)(t + 1) * kstep;
            const char* a2 = last ? nA : cA + (size_t)(t + 2) * kstep; const char* b2 = last ? nB : cB + (size_t)(t + 2) * kstep;
            const char* a3 = a2 + kstep; const char* b3 = b2 + kstep;
            if (last && has_next) S.a_ready(nxt);
            if constexpr (SP2) {
            PG8_LDB(B0, 0, 0); PG8_LDB(B1, 0, 1); PG8_SCHED; PG8_LDA(At, 0, 0); PG8_STAGE(PG8_SA(1, 1), a1 + hstep, voffA);
            PG8_WAIT_V(8); PG8_WAIT_L(0); PG8_BAR; PG8_MMA(0, 0, At, B0); PG8_MMA(0, 1, At, B1); PG8_BAR; PG8_SCHED;
            PG8_LDA(At, 0, 1); PG8_STAGE(PG8_SB(0, 0), b2, voffB); PG8_STAGE(PG8_SB(0, 1), b2 + hstep, voffB); PG8_STAGE(PG8_SA(0, 0), a2, voffA);
            PG8_WAIT_V(8); PG8_WAIT_L(0); PG8_BAR; PG8_MMA(1, 0, At, B0); PG8_MMA(1, 1, At, B1); PG8_BAR; PG8_SCHED;
            PG8_LDB(B0, 1, 0); PG8_LDB(B1, 1, 1); PG8_SCHED; PG8_LDA(At, 1, 0); PG8_STAGE(PG8_SA(0, 1), a2 + hstep, voffA);
            PG8_WAIT_V(8); PG8_WAIT_L(0); PG8_BAR; PG8_MMA(0, 0, At, B0); PG8_MMA(0, 1, At, B1); PG8_BAR; PG8_SCHED;
            PG8_LDA(At, 1, 1); PG8_STAGE(PG8_SB(1, 0), b3, voffB); PG8_STAGE(PG8_SB(1, 1), b3 + hstep, voffB); PG8_STAGE(PG8_SA(1, 0), a3, voffA);
            PG8_WAIT_V(8); PG8_WAIT_L(0); PG8_BAR; PG8_MMA(1, 0, At, B0); PG8_MMA(1, 1, At, B1); PG8_BAR; PG8_SCHED;
            } else {
            PG8_LDB(B0, 0, 0); PG8_SCHED; PG8_LDA(At, 0, 0); PG8_STAGE(PG8_SA(1, 1), a1 + hstep, voffA);
            PG8_WAIT_L(8); PG8_BAR; PG8_WAIT_L(0); PG8_MMA(0, 0, At, B0); PG8_BAR; PG8_SCHED;
            PG8_LDB(B1, 0, 1); PG8_STAGE(PG8_SB(0, 0), b2, voffB);
            PG8_BAR; PG8_WAIT_L(0); PG8_MMA(0, 1, At, B1); PG8_BAR;
            PG8_LDA(At, 0, 1); PG8_STAGE(PG8_SA(0, 0), a2, voffA);
            PG8_BAR; PG8_WAIT_L(0); PG8_MMA(1, 0, At, B0); PG8_BAR; PG8_SCHED;
            PG8_STAGE(PG8_SB(0, 1), b2 + hstep, voffB);
            PG8_WAIT_V(6); PG8_BAR; PG8_MMA(1, 1, At, B1); PG8_BAR;
            PG8_LDB(B0, 1, 0); PG8_SCHED; PG8_LDA(At, 1, 0); PG8_STAGE(PG8_SA(0, 1), a2 + hstep, voffA);
            PG8_WAIT_L(8); PG8_BAR; PG8_WAIT_L(0); PG8_MMA(0, 0, At, B0); PG8_BAR; PG8_SCHED;
            PG8_LDB(B1, 1, 1); PG8_STAGE(PG8_SB(1, 0), b3, voffB);
            PG8_BAR; PG8_WAIT_L(0); PG8_MMA(0, 1, At, B1); PG8_BAR;
            PG8_LDA(At, 1, 1); PG8_STAGE(PG8_SA(1, 0), a3, voffA);
            PG8_BAR; PG8_WAIT_L(0); PG8_MMA(1, 0, At, B0); PG8_BAR; PG8_SCHED;
            PG8_STAGE(PG8_SB(1, 1), b3 + hstep, voffB);
            PG8_WAIT_V(6); PG8_BAR; PG8_MMA(1, 1, At, B1); PG8_BAR;
            }
        }
        if constexpr (MODE == 2) asm volatile("s_nop 15\n\ts_nop 15" ::: "memory");
        if constexpr (ALIGN_EPI) { if (wr == 0) PG8_BAR; }
        if constexpr (!Epi::AFTER_DRAIN) { E(acc, cur, wr, wc, fr, fq); S.done(cur); }
        if (!has_next) break;
#pragma unroll
        for (int a = 0; a < 2; ++a)
#pragma unroll
            for (int b = 0; b < 2; ++b)
#pragma unroll
                for (int m = 0; m < 4; ++m)
#pragma unroll
                    for (int n = 0; n < 2; ++n) acc[a][b][m][n] = (f32x4){0.f, 0.f, 0.f, 0.f};
        cur = nxt; cA = nA; cB = nB; ++ui;
        if constexpr (ALIGN_EPI) { if (wr == 1) PG8_BAR; }
    }
    PG8_WAIT_V(0);
    if constexpr (!ALIGN_EPI) { if (wr == 0) PG8_BAR; }
    PG8_BAR;
    if constexpr (Epi::AFTER_DRAIN) { E.fused(acc, cur, wr, wc, fr, fq, lds, wid, lane); S.done(cur); }
#undef PG8_SA
#undef PG8_SB
#undef PG8_STAGE
#undef PG8_LDA
#undef PG8_LDB
#undef PG8_MMA
#undef PG8_WAIT_V
#undef PG8_WAIT_L
#undef PG8_BAR
#undef PG8_SCHED
}
}

#ifndef PG8_SP2
#define PG8_SP2 true
#endif
#ifndef PG8_ALIGN
#define PG8_ALIGN true
#endif
#define GAS __attribute__((address_space(1)))
#define LAS __attribute__((address_space(3)))
typedef unsigned short bf16;
typedef unsigned v4u __attribute__((ext_vector_type(4)));
typedef unsigned v2u __attribute__((ext_vector_type(2)));
typedef float f32x4 __attribute__((ext_vector_type(4)));
typedef short bf16x8 __attribute__((ext_vector_type(8)));
#define LDS_WAIT() asm volatile("s_waitcnt lgkmcnt(0)" ::: "memory")
#define VM_WAIT() asm volatile("s_waitcnt vmcnt(0)" ::: "memory")
#define MFMA16(a, b, c) __builtin_amdgcn_mfma_f32_16x16x32_bf16((a), (b), (c), 0, 0, 0)

constexpr int NWAVES = 8, NTHR = 512;
constexpr int DM = 2048, MP = 4096, MS = 32768, MT = 36864, DFF = 5632, MODS = 9 * 2048;
constexpr float EPS = 1e-6f;
constexpr int N_PHASES = 24;
#ifndef MK_ONE_LAUNCH
#define MK_ONE_LAUNCH 1
#endif
constexpr size_t MiB = 1u << 20;
constexpr size_t WS_CTL = 0, CTL_ZERO_BYTES = 32768;
constexpr size_t WS_MOD = 1 * MiB, WS_ROPE = 3 * MiB, WS_LW = 4 * MiB, WS_KC = 5 * MiB, WS_VCT = 13 * MiB, WS_SUMW = 21 * MiB, WS_SUMB = 39 * MiB, WS_GATES = 42 * MiB;
constexpr size_t WS_W1A = 48 * MiB, WS_W2A = 92 * MiB, WS_W1B = 114 * MiB, WS_W2B = 158 * MiB, WS_WINAB = 180 * MiB, WS_WOUTAB = 200 * MiB, WS_WINC = 208 * MiB, WS_WOUTC = 241 * MiB;
constexpr size_t WS_H = 256 * MiB, WS_BIG = 400 * MiB;
constexpr size_t WS_ACT = WS_BIG;
constexpr size_t WS_Z = WS_BIG, WS_VTS = 760 * MiB, WS_VTP = 824 * MiB;
constexpr size_t WS_PL = WS_BIG, WS_KT = 976 * MiB, WS_HB = 1120 * MiB;
constexpr size_t WS_END = 1264 * MiB;
constexpr size_t WS_XB2 = 656 * MiB;
constexpr int XPITCH = 4096;
constexpr size_t WS_SA = 3 * MiB + 65536, WS_SB1 = 3 * MiB + 262144, WS_SB2 = 3 * MiB + 393216;
constexpr size_t WS_H8M = 1120 * MiB;
constexpr size_t WS_WQAB = 70 * MiB, WS_WQC = 76 * MiB;
constexpr size_t WS_SBQAB = 3 * MiB + 458752, WS_SBQC = 3 * MiB + 475136, WS_SBOC = 3 * MiB + 491520;
constexpr size_t WS_WQOC = 84 * MiB;
constexpr size_t PLANE = (size_t)MT * DM;
constexpr int CW_BAR = 4096;
constexpr int SCR_BYTES = 147456, MISC_OFF = SCR_BYTES, LDS_BYTES = SCR_BYTES + 256;

__device__ __forceinline__ float bf2f(unsigned short b) { return __uint_as_float(((unsigned)b) << 16); }
__device__ __forceinline__ unsigned f2bf(float f) { unsigned u = __float_as_uint(f); return (u + 0x7fffu + ((u >> 16) & 1u)) >> 16; }
typedef float f32x2c_t __attribute__((ext_vector_type(2))); typedef __bf16 bf16x2c_t __attribute__((ext_vector_type(2)));
__device__ __forceinline__ unsigned pk2(float lo, float hi) { const f32x2c_t v = {lo, hi}; return __builtin_bit_cast(unsigned, __builtin_convertvector(v, bf16x2c_t)); }
typedef unsigned u32x2s __attribute__((ext_vector_type(2)));
__device__ __forceinline__ float rows_max(float v) { u32x2s r = __builtin_amdgcn_permlane16_swap(__float_as_uint(v), __float_as_uint(v), false, false); v = fmaxf(__uint_as_float(r.x), __uint_as_float(r.y));
    r = __builtin_amdgcn_permlane32_swap(__float_as_uint(v), __float_as_uint(v), false, false); return fmaxf(__uint_as_float(r.x), __uint_as_float(r.y)); }
__device__ __forceinline__ float rows_sum(float v) { u32x2s r = __builtin_amdgcn_permlane16_swap(__float_as_uint(v), __float_as_uint(v), false, false); v = __uint_as_float(r.x) + __uint_as_float(r.y);
    r = __builtin_amdgcn_permlane32_swap(__float_as_uint(v), __float_as_uint(v), false, false); return __uint_as_float(r.x) + __uint_as_float(r.y); }
#define DPP_MOV(v, ctrl) __builtin_bit_cast(float, __builtin_amdgcn_update_dpp(0, __builtin_bit_cast(int, (v)), (ctrl), 0xf, 0xf, true))
__device__ __forceinline__ float wave_sum(float v) { v += DPP_MOV(v, 0xB1); v += DPP_MOV(v, 0x4E); v += DPP_MOV(v, 0x141); v += DPP_MOV(v, 0x140); return rows_sum(v); }
__device__ __forceinline__ float wave_max(float v) { v = fmaxf(v, DPP_MOV(v, 0xB1)); v = fmaxf(v, DPP_MOV(v, 0x4E)); v = fmaxf(v, DPP_MOV(v, 0x141)); v = fmaxf(v, DPP_MOV(v, 0x140)); return rows_max(v); }
__device__ __forceinline__ int set_of_row(int m) { return m < MP ? 0 : 1 + ((m - MP) >> 12); }
__device__ __forceinline__ float sigmoidf_(float x) { return __builtin_amdgcn_rcpf(1.0f + __expf(-x)); }

#define XB_TMO      128
#define XB_XCNT(j)  (256  + 64 * (j))
#define XB_XSUB(j)  (1280 + 64 * (j))
#define XB_XGEN(j)  (2304 + 64 * (j))
#define XB_TOP      3328
#define XB_TOPGEN   3392
#define XCD_BAR_WORDS 3456
#define XB_SPIN_CAP (1u << 18)

__device__ __forceinline__ unsigned xb_ld(unsigned* p)              { return __hip_atomic_load(p, __ATOMIC_RELAXED, __HIP_MEMORY_SCOPE_AGENT); }
__device__ __forceinline__ unsigned xb_add(unsigned* p, unsigned v) { return __hip_atomic_fetch_add(p, v, __ATOMIC_RELAXED, __HIP_MEMORY_SCOPE_AGENT); }
__device__ __forceinline__ unsigned xb_xcc_id() { return (unsigned)__builtin_amdgcn_s_getreg((3 << 11) | 20) & 0xFu; }
#define XB_SPIN(cond, bar) do { unsigned _sp = 0; while (cond) { __builtin_amdgcn_s_sleep(1); \
    if ((++_sp & 255u) == 0u) { if (xb_ld(&(bar)[XB_TMO])) break; if (_sp > XB_SPIN_CAP) { atomicAdd(&(bar)[XB_TMO], 1u); break; } } } } while (0)

struct XcdBarrier {
    unsigned* bar; unsigned x;
    volatile LAS unsigned* st;
};

__device__ __forceinline__ XcdBarrier xcd_barrier_post(unsigned* bar, volatile LAS unsigned* st) {
    XcdBarrier b; b.bar = bar; b.x = xb_xcc_id(); b.st = st;
    if (threadIdx.x == 0) (void)xb_add(&bar[XB_XCNT(b.x)], 1u);
    return b;
}
__device__ __forceinline__ void xcd_barrier_complete(unsigned* bar, unsigned x, unsigned& nloc, unsigned& nx) {
    const unsigned G = gridDim.x * gridDim.y * gridDim.z;
    unsigned sum, cnt, mine, sp = 0u;
    for (;;) {
        sum = 0u; cnt = 0u; mine = 0u;
#pragma unroll
        for (unsigned j = 0; j < 16; ++j) { const unsigned c = xb_ld(&bar[XB_XCNT(j)]); sum += c; cnt += (c > 0u) ? 1u : 0u; mine = (j == x) ? c : mine; }
        if (sum == G) break;
        __builtin_amdgcn_s_sleep(1);
        if ((++sp & 255u) == 0u) { if (xb_ld(&bar[XB_TMO])) break; if (sp > XB_SPIN_CAP) { atomicAdd(&bar[XB_TMO], 1u); break; } }
    }
    nloc = mine > 0u ? mine : 1u; nx = cnt > 0u ? cnt : 1u;
}

__device__ __forceinline__ void xcd_barrier(const XcdBarrier& b) {
    asm volatile("s_waitcnt vmcnt(0)" ::: "memory");
    __syncthreads();
    if (threadIdx.x == 0) {
        unsigned* bar = b.bar;
        __builtin_amdgcn_s_waitcnt(0);
        unsigned nloc = b.st[0], nx = b.st[1];
        if (nloc == 0u) { xcd_barrier_complete(bar, b.x, nloc, nx); b.st[0] = nloc; b.st[1] = nx; }
        const unsigned old = xb_add(&bar[XB_XSUB(b.x)], 1u);
        const unsigned gen = old / nloc;
        if (old + 1u == (gen + 1u) * nloc) {
            __builtin_amdgcn_fence(__ATOMIC_RELEASE, "agent");
            asm volatile("s_waitcnt vmcnt(0)" ::: "memory");
            const unsigned og = xb_add(&bar[XB_TOP], 1u);
            const unsigned tg = og / nx;
            if (og + 1u == (tg + 1u) * nx) xb_add(&bar[XB_TOPGEN], 1u);
            else XB_SPIN(xb_ld(&bar[XB_TOPGEN]) == tg, bar);
            __builtin_amdgcn_fence(__ATOMIC_ACQUIRE, "agent");
            xb_add(&bar[XB_XGEN(b.x)], 1u);
            asm volatile("s_waitcnt vmcnt(0)" ::: "memory");
        } else {
            XB_SPIN(xb_ld(&bar[XB_XGEN(b.x)]) == gen, bar);
            __builtin_amdgcn_fence(__ATOMIC_ACQUIRE, "agent");
            asm volatile("s_waitcnt vmcnt(0)" ::: "memory");
        }
    }
    __syncthreads();
}


struct Args { const float* in[32]; float* out; unsigned char* ws; int ph_lo, ph_hi; };

__device__ __forceinline__ void xpose_sub(const float* src, int ldw, bf16* dst, int K, int k0, bool zero, LAS float* scr, int lane, float wsc = 1.0f) {
    const int c = lane & 7;
    if (zero) {
#pragma unroll
        for (int j = 0; j < 4; ++j) { const int n = (lane >> 3) + 8 * j; *(v4u*)(dst + (size_t)n * K + k0 + 8 * c) = (v4u){0u, 0u, 0u, 0u}; }
        return;
    }
    { float t32[32]; const float* p = src + (size_t)(k0 + (lane >> 5)) * ldw + (lane & 31);
#pragma unroll
      for (int i = 0; i < 32; ++i) t32[i] = p[(size_t)(2 * i) * ldw];
#pragma unroll
      for (int i = 0; i < 32; ++i) scr[(2 * i + (lane >> 5)) * 33 + (lane & 31)] = t32[i]; }
    LDS_WAIT(); asm volatile("" ::: "memory");
#pragma unroll
    for (int j = 0; j < 4; ++j) { const int n = (lane >> 3) + 8 * j; const LAS float* s = scr + (8 * c) * 33 + n;
        v4u o; o.x = pk2(s[0 * 33] * wsc, s[1 * 33] * wsc); o.y = pk2(s[2 * 33] * wsc, s[3 * 33] * wsc); o.z = pk2(s[4 * 33] * wsc, s[5 * 33] * wsc); o.w = pk2(s[6 * 33] * wsc, s[7 * 33] * wsc);
        *(v4u*)(dst + (size_t)n * K + k0 + 8 * c) = o; }
    LDS_WAIT(); asm volatile("" ::: "memory");
}
__device__ __forceinline__ void xpose_run(const float* s0, const float* s1, bf16* dst, int ldw, int K, int nblk, int mode, int sub, LAS float* scr, int lane) {
    const int kb = sub / nblk, nb = sub - kb * nblk, n0 = nb * 32;
    const float* sp; bool zero = false;
    if (mode == 1) { const int pn = n0 >> 8, r = n0 & 255; sp = (r < 128 ? s0 : s1) + pn * 128 + (r & 127); }
    else { sp = s0 + n0; if (mode == 2 && n0 >= 8224) zero = true; }
    xpose_sub(sp, ldw, dst + (size_t)n0 * K, K, kb * 64, zero, scr, lane);
}
template <int FMT>
__device__ __forceinline__ void quant_item(const float* sp, int ldw, int K, unsigned char* dst  , float* sbv  , LAS unsigned char* lds, int wave, int lane, int tid) {
    LAS float* scr = (LAS float*)(lds + wave * 8448); LAS float* pm = (LAS float*)(lds + 67584);
    const int kper = K >> 3, nsub = kper >> 6, kbase = wave * kper;
    const float QMAX = FMT == 1 ? 127.0f : 240.0f;
    float mx = 0.f;
    for (int st = 0; st < nsub; ++st) { const float* p = sp + (size_t)(kbase + 64 * st + (lane >> 5)) * ldw + (lane & 31);
        float t32[32];
#pragma unroll
        for (int i = 0; i < 32; ++i) t32[i] = p[(size_t)(2 * i) * ldw];
#pragma unroll
        for (int i = 0; i < 32; ++i) mx = fmaxf(mx, fabsf(t32[i])); }
    mx = fmaxf(mx, __shfl_xor(mx, 32));
    if (lane < 32) pm[wave * 32 + lane] = mx;
    __syncthreads();
    float inv[4];
#pragma unroll
    for (int j = 0; j < 4; ++j) { const int n = (lane >> 3) + 8 * j; float m = pm[n];
#pragma unroll
        for (int w = 1; w < 8; ++w) m = fmaxf(m, pm[w * 32 + n]);
        inv[j] = m > 0.f ? QMAX / m : 0.f; }
    if (tid < 32) { float m = pm[tid];
#pragma unroll
        for (int w = 1; w < 8; ++w) m = fmaxf(m, pm[w * 32 + tid]);
        sbv[tid] = m / QMAX; }
    const int c = lane & 7;
    for (int st = 0; st < nsub; ++st) { const int k0 = kbase + 64 * st;
        { float t32[32]; const float* p = sp + (size_t)(k0 + (lane >> 5)) * ldw + (lane & 31);
#pragma unroll
          for (int i = 0; i < 32; ++i) t32[i] = p[(size_t)(2 * i) * ldw];
#pragma unroll
          for (int i = 0; i < 32; ++i) scr[(2 * i + (lane >> 5)) * 33 + (lane & 31)] = t32[i]; }
        LDS_WAIT(); asm volatile("" ::: "memory");
#pragma unroll
        for (int j = 0; j < 4; ++j) { const int n = (lane >> 3) + 8 * j; const LAS float* s = scr + (8 * c) * 33 + n; float v[8];
#pragma unroll
            for (int e = 0; e < 8; ++e) v[e] = s[e * 33] * inv[j];
            v2u o;
            if (FMT == 1) { int q[8];
#pragma unroll
                for (int e = 0; e < 8; ++e) q[e] = (int)rintf(v[e]) & 0xff;
                o.x = (unsigned)(q[0] | (q[1] << 8) | (q[2] << 16) | (q[3] << 24)); o.y = (unsigned)(q[4] | (q[5] << 8) | (q[6] << 16) | (q[7] << 24)); }
            else { o.x = pg8::pk4_fp8(v[0], v[1], v[2], v[3]); o.y = pg8::pk4_fp8(v[4], v[5], v[6], v[7]); }
            *(v2u*)(dst + (size_t)n * K + k0 + 8 * c) = o; }
        LDS_WAIT(); asm volatile("" ::: "memory"); }
    __syncthreads();
}
__device__ __forceinline__ void ffn_quant_item(const Args& a, int l, int f, int slot, int item, LAS unsigned char* lds, int wave, int lane, int tid) {
    const size_t wo = (size_t)(l * 2 + f) * DM * DFF;
    if (item < 352) { const int n0 = 32 * item, pn = n0 >> 8, r = n0 & 255; const float* sp = (r < 128 ? a.in[13] : a.in[14]) + wo + pn * 128 + (r & 127);
        quant_item<1>(sp, DFF, DM, a.ws + (slot ? WS_W1B : WS_W1A) + (size_t)n0 * DM, (float*)(a.ws + WS_SB1) + slot * 11264 + n0, lds, wave, lane, tid); }
    else { const int n0 = 32 * (item - 352);
        quant_item<2>(a.in[15] + wo + n0, DM, DFF, a.ws + (slot ? WS_W2B : WS_W2A) + (size_t)n0 * DFF, (float*)(a.ws + WS_SB2) + slot * 2048 + n0, lds, wave, lane, tid); }
}
__device__ __forceinline__ void mod_item(const Args& a, int item, float* MOD, LAS unsigned char* lds, int wave, int lane, int tid) {
    const int l = item / 144, cb = item % 144;
    LAS float* sil = (LAS float*)(lds + wave * 9216);
    LAS float* part = (LAS float*)(lds + 73728);
    const float* cvec = a.in[8]; const float* cctx = a.in[9];
    for (int i = lane; i < 9 * 256; i += 64) { const int s = i >> 8, kk = i & 255, k = wave * 256 + kk; const float c = s == 0 ? cctx[k] : cvec[(s - 1) * DM + k]; sil[i] = c * sigmoidf_(c); }
    LDS_WAIT(); asm volatile("" ::: "memory");
    typedef float f32x2 __attribute__((ext_vector_type(2)));
    f32x2 acc[9];
#pragma unroll
    for (int s = 0; s < 9; ++s) acc[s] = (f32x2){0.f, 0.f};
    const float* wp = a.in[10] + ((size_t)l * DM + wave * 256) * (9 * DM) + cb * 128 + 2 * lane;
    for (int k16 = 0; k16 < 16; ++k16) {
        f32x2 w[16];
#pragma unroll
        for (int j = 0; j < 16; ++j) w[j] = *(const f32x2*)(wp + (size_t)(16 * k16 + j) * (9 * DM));
#pragma unroll
        for (int s = 0; s < 9; ++s) {
#pragma unroll
            for (int q = 0; q < 4; ++q) { const f32x4 c = *(const LAS f32x4*)(sil + s * 256 + 16 * k16 + 4 * q);
                acc[s] += w[4 * q] * c[0]; acc[s] += w[4 * q + 1] * c[1]; acc[s] += w[4 * q + 2] * c[2]; acc[s] += w[4 * q + 3] * c[3]; } }
    }
#pragma unroll
    for (int s = 0; s < 9; ++s) *(LAS f32x2*)(part + (wave * 9 + s) * 128 + 2 * lane) = acc[s];
    __syncthreads();
    for (int i = tid; i < 9 * 128; i += NTHR) { const int s = i >> 7, col = i & 127; float v = a.in[11][l * (9 * DM) + cb * 128 + col];
#pragma unroll
        for (int w = 0; w < 8; ++w) v += part[(w * 9 + s) * 128 + col];
        MOD[((size_t)l * 9 + s) * MODS + cb * 128 + col] = v; }
    __syncthreads();
}
__device__ __forceinline__ void tail_ids(int nwg, int G, int& ib, int& nidle) { const int rem = nwg % G, c = (int)blockIdx.x; if (rem == 0) { ib = c; nidle = G; } else if (c >= rem) { ib = c - rem; nidle = G - rem; } else { ib = -1; nidle = G - rem; } }
constexpr int P0_ITEMS = 3040;
__device__ __forceinline__ void p0_item(const Args& a, int it, LAS unsigned char* lds, int wave, int lane, int tid) {
    unsigned char* ws = a.ws; LAS float* scr = (LAS float*)(lds + wave * 8448);
    int r = it;
    if (r < 128) { ffn_quant_item(a, 0, r >> 6, r >> 6, 352 + (r & 63), lds, wave, lane, tid); return; } r -= 128;
    if (r < 288) { mod_item(a, r, (float*)(ws + WS_MOD), lds, wave, lane, tid); return; } r -= 288;
    if (r < 704) { const int f = r >= 352 ? 1 : 0; ffn_quant_item(a, 0, f, f, r - 352 * f, lds, wave, lane, tid); return; } r -= 704;
    if (r < 128) { const int n0 = 32 * r; const int col = n0 < 2048 ? n0 : 6144 + (n0 - 2048);
        quant_item<1>(a.in[28] + col, 8224, DM, ws + WS_WQC + (size_t)n0 * DM, (float*)(ws + WS_SBQC) + n0, lds, wave, lane, tid); return; } r -= 128;
    if (r < 64) { const int n0 = 32 * r; quant_item<1>(a.in[31] + n0, DM, DM, ws + WS_WQOC + (size_t)n0 * DM, (float*)(ws + WS_SBOC) + n0, lds, wave, lane, tid); return; } r -= 64;
    if (r < 640) { xpose_run(a.in[16], nullptr, (bf16*)(ws + WS_WINAB), 5120, DM, 160, 0, r * 8 + wave, scr, lane); return; } r -= 640;
    if (r < 256) { xpose_run(a.in[17], nullptr, (bf16*)(ws + WS_WOUTAB), DM, DM, 64, 0, r * 8 + wave, scr, lane); return; } r -= 256;
    if (r < 544) {
        const int sub = r * 8 + wave, kb = sub / 136, nb = sub - kb * 136, n0 = nb * 32; const int col = n0 < 4096 ? 2048 + n0 : 8192 + (n0 - 4096);
        xpose_sub(a.in[28] + col, 8224, (bf16*)(ws + WS_WINC) + (size_t)n0 * DM, DM, kb * 64, col >= 8224, scr, lane); return; } r -= 544;
    if (r < 32) { const int which = r >> 4, dh = r & 15;
        { const int sub = wave, kb = sub >> 2, nb = sub & 3;
          xpose_sub(a.in[which ? 25 : 23] + (size_t)dh * 16384 + nb * 32, 128, (bf16*)(ws + WS_LW) + (size_t)(dh * 2 + which) * 16384 + (size_t)(nb * 32) * 128, 128, kb * 64, false, scr, lane, -1.4426950408889634f); } return; } r -= 32;
    { const int b = r >> 5;
      xpose_run(a.in[3] + (size_t)b * 512 * 1024, nullptr, (bf16*)(ws + WS_VCT) + (size_t)b * 1024 * 512, 1024, 512, 32, 0, (r & 31) * 8 + wave, scr, lane); }
}
__device__ __forceinline__ void phase_p0(const Args& a, LAS unsigned char* lds, int G, int wave, int lane, int tid) {
    unsigned* ctr = (unsigned*)(a.ws + WS_CTL) + 64; volatile LAS int* qs = (volatile LAS int*)(lds + MISC_OFF + 64);
    if (tid == 0) qs[0] = (int)__hip_atomic_fetch_add(ctr, 1u, __ATOMIC_RELAXED, __HIP_MEMORY_SCOPE_AGENT);
    __syncthreads();
    int it = qs[0];
    while (it < P0_ITEMS) {
        __syncthreads();
        int nxt = 0; if (tid == 0) nxt = (int)__hip_atomic_fetch_add(ctr, 1u, __ATOMIC_RELAXED, __HIP_MEMORY_SCOPE_AGENT);
        p0_item(a, it, lds, wave, lane, tid);
        if (tid == 0) qs[0] = nxt;
        __syncthreads();
        it = qs[0];
    }
    unsigned char* ws = a.ws;
    { const f32x4* src = (const f32x4*)a.in[2]; v2u* dst = (v2u*)(ws + WS_KC);
      for (int i = blockIdx.x * NTHR + tid; i < 1048576; i += G * NTHR) { const f32x4 v = src[i]; dst[i] = (v2u){pk2(v[0], v[1]), pk2(v[2], v[3])}; } }
    { float* R = (float*)(ws + WS_ROPE);
      for (int i = blockIdx.x * NTHR + tid; i < 4096; i += G * NTHR) { const int p = i >> 6, fi = i & 63; const float fr = powf(10000.0f, -(float)fi * (1.0f / 64.0f)); const float ang = (float)p * fr;
          R[2 * i] = cosf(ang); R[2 * i + 1] = sinf(ang); } }
}
#define NORM_REQ(mm) do { if (FIRST) { const float* xr_ = (mm) < MP ? a.in[0] + (size_t)(mm) * DM : a.in[1] + (size_t)((mm) - MP) * DM; _Pragma("unroll") for (int q = 0; q < 8; ++q) nf[q] = *(const f32x4*)(xr_ + 4 * lane + 256 * q); } \
        else { const bf16* xr_ = COPY ? (const bf16*)(a.ws + WS_XB2) + (size_t)(mm) * DM : (const bf16*)a.out + (size_t)(mm) * XPITCH; _Pragma("unroll") for (int q = 0; q < 8; ++q) nh[q] = *(const v2u*)(xr_ + 4 * lane + 256 * q); } } while (0)
template <bool FIRST, bool COPY = false  >
__device__ __forceinline__ void norm_pass(const Args& a, int l, int j, int G, int wave, int lane) {
    const float* MOD = (const float*)(a.ws + WS_MOD) + (size_t)l * 9 * MODS;
    const float* gvec = a.in[12] + (size_t)(l * 3 + j) * DM;
    bf16* H = (bf16*)(a.ws + WS_H);
    const int NGW = G * NWAVES, gw = blockIdx.x * NWAVES + wave, rpw = (MT + NGW - 1) / NGW;
    int cur = -1; f32x4 ge[8], sh[8];
    const int m_end = (gw + 1) * rpw < MT ? (gw + 1) * rpw : MT;
    f32x4 nf[8]; v2u nh[8];
    if (gw * rpw < m_end) NORM_REQ(gw * rpw);
    for (int m = gw * rpw; m < m_end; ++m) {
        const int s = set_of_row(m);
        if (s != cur) { cur = s; const float* sc = MOD + (size_t)s * MODS + (3 * j + 1) * DM; const float* sf = MOD + (size_t)s * MODS + (3 * j) * DM;
#pragma unroll
            for (int q = 0; q < 8; ++q) { const int c = 4 * lane + 256 * q; const f32x4 g4 = *(const f32x4*)(gvec + c), s4 = *(const f32x4*)(sc + c); ge[q] = g4 * (s4 + 1.0f); sh[q] = *(const f32x4*)(sf + c); } }
        f32x4 v[8]; float ss = 0.f;
        if (FIRST) {
#pragma unroll
            for (int q = 0; q < 8; ++q) v[q] = nf[q]; }
        else {
#pragma unroll
            for (int q = 0; q < 8; ++q) { const v2u w = nh[q]; v[q] = (f32x4){__uint_as_float(w.x << 16), __uint_as_float(w.x & 0xffff0000u), __uint_as_float(w.y << 16), __uint_as_float(w.y & 0xffff0000u)}; } }
        if (m + 1 < m_end) NORM_REQ(m + 1);
#pragma unroll
        for (int q = 0; q < 8; ++q) ss += (v[q][0] * v[q][0] + v[q][1] * v[q][1]) + (v[q][2] * v[q][2] + v[q][3] * v[q][3]);
        const float rstd = rsqrtf(wave_sum(ss) * (1.0f / DM) + EPS);
        bf16* orow = H + (size_t)m * DM;
#pragma unroll
        for (int q = 0; q < 8; ++q) { const f32x4 o = v[q] * rstd * ge[q] + sh[q]; *(v2u*)(orow + 4 * lane + 256 * q) = (v2u){pk2(o[0], o[1]), pk2(o[2], o[3])}; }
    }
}

template <bool FIRST, bool COPY = false  >
__device__ __forceinline__ void norm_pass_dual(const Args& a, int l, int j, int G, int wave, int lane) {
    const float* MOD = (const float*)(a.ws + WS_MOD) + (size_t)l * 9 * MODS;
    const float* gvec = a.in[12] + (size_t)(l * 3 + j) * DM;
    bf16* H = (bf16*)(a.ws + WS_H);
    const int NGW = G * NWAVES, gw = blockIdx.x * NWAVES + wave, rpw = (MT + NGW - 1) / NGW;
    int cur = -1; f32x4 ge[8], sh[8];
    const int m_end = (gw + 1) * rpw < MT ? (gw + 1) * rpw : MT;
    f32x4 nf[8]; v2u nh[8];
    if (gw * rpw < m_end) NORM_REQ(gw * rpw);
    for (int m = gw * rpw; m < m_end; ++m) {
        const int s = set_of_row(m);
        if (s != cur) { cur = s; const float* sc = MOD + (size_t)s * MODS + (3 * j + 1) * DM; const float* sf = MOD + (size_t)s * MODS + (3 * j) * DM;
#pragma unroll
            for (int q = 0; q < 8; ++q) { const int c = 4 * lane + 256 * q; const f32x4 g4 = *(const f32x4*)(gvec + c), s4 = *(const f32x4*)(sc + c); ge[q] = g4 * (s4 + 1.0f); sh[q] = *(const f32x4*)(sf + c); } }
        f32x4 v[8]; float ss = 0.f;
        if (FIRST) {
#pragma unroll
            for (int q = 0; q < 8; ++q) v[q] = nf[q]; }
        else {
#pragma unroll
            for (int q = 0; q < 8; ++q) { const v2u w = nh[q]; v[q] = (f32x4){__uint_as_float(w.x << 16), __uint_as_float(w.x & 0xffff0000u), __uint_as_float(w.y << 16), __uint_as_float(w.y & 0xffff0000u)}; } }
        if (m + 1 < m_end) NORM_REQ(m + 1);
#pragma unroll
        for (int q = 0; q < 8; ++q) ss += (v[q][0] * v[q][0] + v[q][1] * v[q][1]) + (v[q][2] * v[q][2] + v[q][3] * v[q][3]);
        const float rstd = rsqrtf(wave_sum(ss) * (1.0f / DM) + EPS);
        bf16* orow = H + (size_t)m * DM;
#pragma unroll
        for (int q = 0; q < 8; ++q) { v[q] = v[q] * rstd * ge[q] + sh[q]; *(v2u*)(orow + 4 * lane + 256 * q) = (v2u){pk2(v[q][0], v[q][1]), pk2(v[q][2], v[q][3])}; }
        float am = 0.f;
#pragma unroll
        for (int q = 0; q < 8; ++q) am = fmaxf(am, fmaxf(fmaxf(fabsf(v[q][0]), fabsf(v[q][1])), fmaxf(fabsf(v[q][2]), fabsf(v[q][3]))));
        am = wave_max(am);
        const float inv = am > 0.f ? 127.0f / am : 0.f;
        unsigned char* o8 = a.ws + WS_H8M + (size_t)m * DM;
#pragma unroll
        for (int q = 0; q < 8; ++q) { const int q0 = (int)rintf(v[q][0] * inv) & 0xff, q1 = (int)rintf(v[q][1] * inv) & 0xff, q2 = (int)rintf(v[q][2] * inv) & 0xff, q3 = (int)rintf(v[q][3] * inv) & 0xff;
            *(unsigned*)(o8 + 4 * lane + 256 * q) = (unsigned)(q0 | (q1 << 8) | (q2 << 16) | (q3 << 24)); }
        if (lane == 0) ((float*)(a.ws + WS_SA))[m] = am * (1.0f / 127.0f);
    }
}

template <bool FIRST, bool COPY = false  >
__device__ __forceinline__ void norm_pass_q(const Args& a, int l, int j, int G, int wave, int lane) {
    const float* MOD = (const float*)(a.ws + WS_MOD) + (size_t)l * 9 * MODS;
    const float* gvec = a.in[12] + (size_t)(l * 3 + j) * DM;
    unsigned char* H8 = a.ws + WS_H; float* SA = (float*)(a.ws + WS_SA);
    const int NGW = G * NWAVES, gw = blockIdx.x * NWAVES + wave, rpw = (MT + NGW - 1) / NGW;
    int cur = -1; f32x4 ge[8], sh[8];
    const int m_end = (gw + 1) * rpw < MT ? (gw + 1) * rpw : MT;
    f32x4 nf[8]; v2u nh[8];
    if (gw * rpw < m_end) NORM_REQ(gw * rpw);
    for (int m = gw * rpw; m < m_end; ++m) {
        const int s = set_of_row(m);
        if (s != cur) { cur = s; const float* sc = MOD + (size_t)s * MODS + (3 * j + 1) * DM; const float* sf = MOD + (size_t)s * MODS + (3 * j) * DM;
#pragma unroll
            for (int q = 0; q < 8; ++q) { const int c = 4 * lane + 256 * q; const f32x4 g4 = *(const f32x4*)(gvec + c), s4 = *(const f32x4*)(sc + c); ge[q] = g4 * (s4 + 1.0f); sh[q] = *(const f32x4*)(sf + c); } }
        f32x4 v[8]; float ss = 0.f;
        if (FIRST) {
#pragma unroll
            for (int q = 0; q < 8; ++q) v[q] = nf[q]; }
        else {
#pragma unroll
            for (int q = 0; q < 8; ++q) { const v2u w = nh[q]; v[q] = (f32x4){__uint_as_float(w.x << 16), __uint_as_float(w.x & 0xffff0000u), __uint_as_float(w.y << 16), __uint_as_float(w.y & 0xffff0000u)}; } }
        if (m + 1 < m_end) NORM_REQ(m + 1);
#pragma unroll
        for (int q = 0; q < 8; ++q) ss += (v[q][0] * v[q][0] + v[q][1] * v[q][1]) + (v[q][2] * v[q][2] + v[q][3] * v[q][3]);
        const float rstd = rsqrtf(wave_sum(ss) * (1.0f / DM) + EPS);
        float am = 0.f;
#pragma unroll
        for (int q = 0; q < 8; ++q) { v[q] = v[q] * rstd * ge[q] + sh[q]; am = fmaxf(am, fmaxf(fmaxf(fabsf(v[q][0]), fabsf(v[q][1])), fmaxf(fabsf(v[q][2]), fabsf(v[q][3])))); }
        am = wave_max(am);
        const float inv = am > 0.f ? 127.0f / am : 0.f;
        unsigned char* orow = H8 + (size_t)m * DM;
#pragma unroll
        for (int q = 0; q < 8; ++q) { const int q0 = (int)rintf(v[q][0] * inv) & 0xff, q1 = (int)rintf(v[q][1] * inv) & 0xff, q2 = (int)rintf(v[q][2] * inv) & 0xff, q3 = (int)rintf(v[q][3] * inv) & 0xff;
            *(unsigned*)(orow + 4 * lane + 256 * q) = (unsigned)(q0 | (q1 << 8) | (q2 << 16) | (q3 << 24)); }
        if (lane == 0) SA[m] = am * (1.0f / 127.0f);
    }
}

__device__ __forceinline__ void tile_load(const bf16* src, size_t spitch, LAS bf16* tl, int lane) {
    v4u r[16];
#pragma unroll
    for (int i = 0; i < 16; ++i) { const int c = lane + 64 * i, t = c >> 4, dc = c & 15; r[i] = *(const v4u*)(src + (size_t)t * spitch + 8 * dc); }
#pragma unroll
    for (int i = 0; i < 16; ++i) { const int c = lane + 64 * i, t = c >> 4, dc = c & 15; *(LAS v4u*)(tl + t * 136 + 8 * dc) = r[i]; }
}
__device__ __forceinline__ void tile_store_rows(bf16* dst, size_t dpitch, const LAS bf16* tl, int lane) {
#pragma unroll
    for (int i = 0; i < 16; ++i) { const int c = lane + 64 * i, t = c >> 4, dc = c & 15; *(v4u*)(dst + (size_t)t * dpitch + 8 * dc) = *(const LAS v4u*)(tl + t * 136 + 8 * dc); }
}
__device__ __forceinline__ void tile_store_T(bf16* dst, size_t dpitch, const LAS bf16* tl, int lane) {
#pragma unroll 4
    for (int i = 0; i < 16; ++i) { const int c = lane + 64 * i, d = c >> 3, tc = c & 7; const LAS bf16* s = tl + (8 * tc) * 136 + d;
        v4u o; o.x = (unsigned)s[0] | ((unsigned)s[136] << 16); o.y = (unsigned)s[2 * 136] | ((unsigned)s[3 * 136] << 16); o.z = (unsigned)s[4 * 136] | ((unsigned)s[5 * 136] << 16); o.w = (unsigned)s[6 * 136] | ((unsigned)s[7 * 136] << 16);
        *(v4u*)(dst + (size_t)d * dpitch + 8 * tc) = o; }
}
__device__ __forceinline__ void ab_post_item(const Args& a, int item, LAS unsigned char* lds, int wave, int lane) {
    bf16* Z = (bf16*)(a.ws + WS_Z);
    const int R0 = item * 64;
    const bool prompt = R0 < MP;
    float* outk = a.out + 75497472; float* outv = a.out + 79691776;
    float qg[16], kg[16];
#pragma unroll
    for (int e = 0; e < 16; ++e) { qg[e] = a.in[18][16 * (lane & 7) + e]; kg[e] = a.in[19][16 * (lane & 7) + e]; }
    const int rowb = R0 + wave * 8; bf16* zb = Z + (size_t)rowb * 5120 + 16 * lane;
#pragma unroll
    for (int which = 0; which < 2; ++which) {
        v4u r0[8], r1[8];
#pragma unroll
        for (int tt = 0; tt < 8; ++tt) { const bf16* p = zb + (size_t)tt * 5120 + which * 1024; r0[tt] = *(const v4u*)p; r1[tt] = *(const v4u*)(p + 8); }
#pragma unroll
        for (int tt = 0; tt < 8; ++tt) {
            bf16* p = zb + (size_t)tt * 5120 + which * 1024;
            float x[16]; const unsigned w8[8] = {r0[tt].x, r0[tt].y, r0[tt].z, r0[tt].w, r1[tt].x, r1[tt].y, r1[tt].z, r1[tt].w};
#pragma unroll
            for (int e = 0; e < 8; ++e) { x[2 * e] = __uint_as_float(w8[e] << 16); x[2 * e + 1] = __uint_as_float(w8[e] & 0xffff0000u); }
            float ss = 0.f;
#pragma unroll
            for (int e = 0; e < 16; ++e) ss += x[e] * x[e];
            ss += __shfl_xor(ss, 1); ss += __shfl_xor(ss, 2); ss += __shfl_xor(ss, 4);
            const float rs = rsqrtf(ss * (1.0f / 128.0f) + EPS);
#pragma unroll
            for (int e = 0; e < 16; ++e) x[e] = x[e] * rs * (which ? kg[e] : qg[e]);
            v4u o0, o1; o0.x = pk2(x[0], x[1]); o0.y = pk2(x[2], x[3]); o0.z = pk2(x[4], x[5]); o0.w = pk2(x[6], x[7]); o1.x = pk2(x[8], x[9]); o1.y = pk2(x[10], x[11]); o1.z = pk2(x[12], x[13]); o1.w = pk2(x[14], x[15]);
            *(v4u*)p = o0; *(v4u*)(p + 8) = o1;
            if (which == 1 && prompt) { float* ok = outk + (size_t)(rowb + tt) * 1024 + 16 * lane;
#pragma unroll
                for (int e = 0; e < 4; ++e) *(f32x4*)(ok + 4 * e) = (f32x4){x[4 * e], x[4 * e + 1], x[4 * e + 2], x[4 * e + 3]}; }
        }
    }
    if (prompt) {
        v4u r0[8], r1[8];
#pragma unroll
        for (int tt = 0; tt < 8; ++tt) { const bf16* p = zb + (size_t)tt * 5120 + 2048; r0[tt] = *(const v4u*)p; r1[tt] = *(const v4u*)(p + 8); }
#pragma unroll
        for (int tt = 0; tt < 8; ++tt) { const unsigned w8[8] = {r0[tt].x, r0[tt].y, r0[tt].z, r0[tt].w, r1[tt].x, r1[tt].y, r1[tt].z, r1[tt].w};
            float* ov = outv + (size_t)(rowb + tt) * 1024 + 16 * lane;
#pragma unroll
            for (int e = 0; e < 4; ++e) *(f32x4*)(ov + 4 * e) = (f32x4){__uint_as_float(w8[2 * e] << 16), __uint_as_float(w8[2 * e] & 0xffff0000u), __uint_as_float(w8[2 * e + 1] << 16), __uint_as_float(w8[2 * e + 1] & 0xffff0000u)}; }
    }
    LAS bf16* tl = (LAS bf16*)(lds + wave * 17408);
    tile_load(Z + (size_t)R0 * 5120 + 2048 + wave * 128, 5120, tl, lane);
    LDS_WAIT(); asm volatile("" ::: "memory");
    bf16* dst; size_t dp;
    if (prompt) { const int b = R0 >> 8, t0 = R0 & 255; dst = (bf16*)(a.ws + WS_VTP) + ((size_t)(b * 8 + wave) * 128) * 256 + t0; dp = 256; }
    else { const int rs = R0 - MP, b = rs >> 12, t0 = rs & 4095; dst = (bf16*)(a.ws + WS_VTS) + ((size_t)(b * 8 + wave) * 128) * 4096 + t0; dp = 4096; }
    tile_store_T(dst, dp, tl, lane);
    LDS_WAIT(); asm volatile("" ::: "memory");
}
__device__ __forceinline__ float gelu_tanh(float x) { const float y = 0.7978845608028654f * (x + 0.044715f * x * x * x); const float t = 1.0f - 2.0f * __builtin_amdgcn_rcpf(1.0f + __expf(2.0f * y)); return 0.5f * x * (1.0f + t); }
template <int PASS>
__device__ __forceinline__ void lru_item(const Args& a, int cq, int hh, LAS unsigned char* lds, int wave, int lane, int tid) {
    const bf16* Z = (const bf16*)(a.ws + WS_Z); const bf16* LW = (const bf16*)(a.ws + WS_LW);
    float* SUMW = (float*)(a.ws + WS_SUMW); float* SUMB = (float*)(a.ws + WS_SUMB);
    const int fr = lane & 15, fq = lane >> 4;
    int S0, T, tseq, bs = 0, cis = 0, nchk = 1;
    if (cq < 16) { S0 = cq * 256; T = 256; tseq = 0; } else { bs = (cq - 16) >> 4; cis = (cq - 16) & 15; nchk = 16; S0 = MP + bs * 4096; T = 4096; tseq = cis * 256; }
    const int t0 = tseq + 32 * wave;
    LAS bf16* xt = (LAS bf16*)(lds + wave * 8704);
    LAS float* WS = (LAS float*)(lds + 69632);
    LAS float* HW = (LAS float*)(lds + 69632 + 16384);
    {
        const int ch = hh * 128 + 2 * lane;
        const float* cw = a.in[21]; const float* cbp = a.in[22];
        float w[4][2];
#pragma unroll
        for (int i = 0; i < 4; ++i) { w[i][0] = cw[i * 1024 + ch]; w[i][1] = cw[i * 1024 + ch + 1]; }
        const float cb0 = cbp[ch], cb1 = cbp[ch + 1];
        const bf16* xb = Z + (size_t)S0 * 5120 + 3072 + ch;
        unsigned xr[35];
#pragma unroll
        for (int i = 0; i < 35; ++i) { const int t = t0 - 1 + i; xr[i] = (t >= 0 && t < T) ? *(const unsigned*)(xb + (size_t)t * 5120) : 0u; }
#pragma unroll
        for (int t = 0; t < 32; ++t) {
            const float y0 = w[0][0] * __uint_as_float(xr[t] << 16) + w[1][0] * __uint_as_float(xr[t + 1] << 16) + w[2][0] * __uint_as_float(xr[t + 2] << 16) + w[3][0] * __uint_as_float(xr[t + 3] << 16) + cb0;
            const float y1 = w[0][1] * __uint_as_float(xr[t] & 0xffff0000u) + w[1][1] * __uint_as_float(xr[t + 1] & 0xffff0000u) + w[2][1] * __uint_as_float(xr[t + 2] & 0xffff0000u) + w[3][1] * __uint_as_float(xr[t + 3] & 0xffff0000u) + cb1;
            *(LAS unsigned*)(xt + t * 136 + 2 * lane) = pk2(y0, y1);
        }
    }
    if (PASS == 2) {
        if (tid < 256) { const int dir = tid >> 7, chl = tid & 127;
            float Hs = (cq < 16) ? 0.f : a.in[4][(size_t)(bs * 2 + dir) * 1024 + hh * 128 + chl];
            typedef float f32x2_ __attribute__((ext_vector_type(2)));
            f32x2_ sb_[15], sw_[8];
            const float* sbp = SUMB + ((size_t)((cq - cis) * 8 + hh) * 2 + dir) * 256 + 2 * chl;
#pragma unroll
            for (int i = 0; i < 15; ++i) { const int c = dir ? nchk - 1 - i : i; const bool use = dir ? c > cis : c < cis; sb_[i] = use ? *(const f32x2_*)(sbp + (size_t)c * 4096) : (f32x2_){1.f, 0.f}; }
            const float* sw = SUMW + ((size_t)(cq * 8 + hh) * 8) * 512 + dir * 256 + 2 * chl;
#pragma unroll
            for (int w = 0; w < 8; ++w) sw_[w] = *(const f32x2_*)(sw + w * 512);
#pragma unroll
            for (int i = 0; i < 15; ++i) Hs = sb_[i][0] * Hs + sb_[i][1];
            if (dir == 0) {
#pragma unroll
                for (int w = 0; w < 8; ++w) { HW[(w * 2 + 0) * 128 + chl] = Hs; Hs = sw_[w][0] * Hs + sw_[w][1]; } }
            else {
#pragma unroll
                for (int w = 7; w >= 0; --w) { HW[(w * 2 + 1) * 128 + chl] = Hs; Hs = sw_[w][0] * Hs + sw_[w][1]; } }
        }
        __syncthreads();
    }
    LDS_WAIT(); asm volatile("" ::: "memory");
    bf16x8 af[2][4];
#pragma unroll
    for (int mt = 0; mt < 2; ++mt)
#pragma unroll
        for (int kk = 0; kk < 4; ++kk) af[mt][kk] = *(const LAS bf16x8*)(xt + (16 * mt + fr) * 136 + 32 * kk + 8 * fq);
    bf16x8 bw[2][4]; float sc3[3];
#define LRU_REQ(dstw, dsts, q_) do { const int d_ = (q_) & 1, chl_ = 16 * ((q_) >> 1) + fr; const bf16* wa_ = LW + (size_t)((d_ * 8 + hh) * 2) * 16384 + chl_ * 128 + 8 * fq; \
        _Pragma("unroll") for (int kk = 0; kk < 4; ++kk) { dstw[0][kk] = *(const bf16x8*)(wa_ + 32 * kk); dstw[1][kk] = *(const bf16x8*)(wa_ + 16384 + 32 * kk); } \
        dsts[0] = a.in[24][d_ * 1024 + hh * 128 + chl_]; dsts[1] = a.in[26][d_ * 1024 + hh * 128 + chl_]; dsts[2] = a.in[27][d_ * 1024 + hh * 128 + chl_]; } while (0)
    LRU_REQ(bw, sc3, 0);
    for (int jt = 0; jt < 8; ++jt) {
        const int chl = 16 * jt + fr, ch = hh * 128 + chl;
        bf16 gbr[2][4];
        if (PASS == 2) {
#pragma unroll
            for (int mt = 0; mt < 2; ++mt)
#pragma unroll
                for (int r = 0; r < 4; ++r) gbr[mt][r] = Z[((size_t)S0 + t0 + 16 * mt + 4 * fq + r) * 5120 + 4096 + ch]; }
        float xv[2][4];
#pragma unroll
        for (int mt = 0; mt < 2; ++mt)
#pragma unroll
            for (int r = 0; r < 4; ++r) xv[mt][r] = bf2f(xt[(16 * mt + 4 * fq + r) * 136 + chl]);
        float av[2][2][4], uv[2][2][4];
#pragma unroll
        for (int dir = 0; dir < 2; ++dir) {
            f32x4 acca[2], accx[2];
            acca[0] = acca[1] = accx[0] = accx[1] = (f32x4){0.f, 0.f, 0.f, 0.f};
            bf16x8 bn[2][4]; float sn3[3];
            if (2 * jt + dir < 15) LRU_REQ(bn, sn3, 2 * jt + dir + 1);
#pragma unroll
            for (int kk = 0; kk < 4; ++kk) {
#pragma unroll
                for (int mt = 0; mt < 2; ++mt) { acca[mt] = MFMA16(af[mt][kk], bw[0][kk], acca[mt]); accx[mt] = MFMA16(af[mt][kk], bw[1][kk], accx[mt]); } }
            const float bav = sc3[0] * -1.4426950408889634f, bxv = sc3[1] * -1.4426950408889634f, lm = sc3[2];
            const float c8 = -8.0f * 1.4426950408889634f * log1pf(__expf(-lm));
#pragma unroll
            for (int mt = 0; mt < 2; ++mt)
#pragma unroll
                for (int r = 0; r < 4; ++r) { const float ra = __builtin_amdgcn_rcpf(1.0f + __builtin_amdgcn_exp2f(acca[mt][r] + bav)), ix = __builtin_amdgcn_rcpf(1.0f + __builtin_amdgcn_exp2f(accx[mt][r] + bxv)); const float la = c8 * ra;
                    const float aa = __builtin_amdgcn_exp2f(la); av[dir][mt][r] = aa; uv[dir][mt][r] = __builtin_amdgcn_sqrtf(fmaxf(1.0f - aa * aa, 0.f)) * ix * xv[mt][r]; }
            if (2 * jt + dir < 15) {
#pragma unroll
                for (int x_ = 0; x_ < 2; ++x_)
#pragma unroll
                    for (int kk = 0; kk < 4; ++kk) bw[x_][kk] = bn[x_][kk];
                sc3[0] = sn3[0]; sc3[1] = sn3[1]; sc3[2] = sn3[2]; }
        }
        float GA[2][2][4], GB[2][2][4];
#pragma unroll
        for (int dir = 0; dir < 2; ++dir)
#pragma unroll
            for (int mt = 0; mt < 2; ++mt) { float A = 1.f, B = 0.f;
#pragma unroll
                for (int rr = 0; rr < 4; ++rr) { const int r = dir ? 3 - rr : rr; A *= av[dir][mt][r]; B = av[dir][mt][r] * B + uv[dir][mt][r]; }
#pragma unroll
                for (int q = 0; q < 4; ++q) { GA[dir][mt][q] = __shfl(A, fr + 16 * q); GB[dir][mt][q] = __shfl(B, fr + 16 * q); } }
        if (PASS == 1) {
#pragma unroll
            for (int dir = 0; dir < 2; ++dir) { float A = 1.f, B = 0.f;
#pragma unroll
                for (int mm = 0; mm < 2; ++mm)
#pragma unroll
                    for (int qq = 0; qq < 4; ++qq) { const int mt = dir ? 1 - mm : mm, q = dir ? 3 - qq : qq; B = GA[dir][mt][q] * B + GB[dir][mt][q]; A *= GA[dir][mt][q]; }
                if (fq == 0) { WS[((wave * 2 + dir) * 128 + chl) * 2] = A; WS[((wave * 2 + dir) * 128 + chl) * 2 + 1] = B;
                    float* g = SUMW + ((size_t)((cq * 8 + hh) * 8 + wave)) * 512 + dir * 256 + 2 * chl; g[0] = A; g[1] = B; } }
        } else {
            float hsum[2][4] = {{0.f, 0.f, 0.f, 0.f}, {0.f, 0.f, 0.f, 0.f}};
#pragma unroll
            for (int dir = 0; dir < 2; ++dir) { float st = HW[(wave * 2 + dir) * 128 + chl]; float hin[2] = {0.f, 0.f};
#pragma unroll
                for (int mm = 0; mm < 2; ++mm)
#pragma unroll
                    for (int qq = 0; qq < 4; ++qq) { const int mt = dir ? 1 - mm : mm, q = dir ? 3 - qq : qq; if (q == fq) hin[mt] = st; st = GA[dir][mt][q] * st + GB[dir][mt][q]; }
#pragma unroll
                for (int mt = 0; mt < 2; ++mt) { float h = hin[mt];
#pragma unroll
                    for (int rr = 0; rr < 4; ++rr) { const int r = dir ? 3 - rr : rr; h = av[dir][mt][r] * h + uv[dir][mt][r]; hsum[mt][r] += h;
                        if (cq < 16) { if (dir == 0 && wave == 7 && mt == 1 && fq == 3 && r == 3) a.out[83886080 + (size_t)(cq * 2 + 0) * 1024 + ch] = h;
                                       if (dir == 1 && wave == 0 && mt == 0 && fq == 0 && r == 0) a.out[83886080 + (size_t)(cq * 2 + 1) * 1024 + ch] = h; } } } }
            bf16* Hb = (bf16*)(a.ws + WS_H);
#pragma unroll
            for (int mt = 0; mt < 2; ++mt)
#pragma unroll
                for (int r = 0; r < 4; ++r) { const size_t row = (size_t)S0 + t0 + 16 * mt + 4 * fq + r; const float gb = bf2f(gbr[mt][r]);
                    Hb[row * DM + 1024 + ch] = (bf16)f2bf(hsum[mt][r] * gelu_tanh(gb)); }
        }
    }
#undef LRU_REQ
    if (PASS == 1) {
        LDS_WAIT(); __syncthreads();
        if (tid < 256) { const int dir = tid >> 7, chl = tid & 127; float A = 1.f, B = 0.f;
            for (int ww = 0; ww < 8; ++ww) { const int w = dir ? 7 - ww : ww; const float wa_ = WS[((w * 2 + dir) * 128 + chl) * 2], wb_ = WS[((w * 2 + dir) * 128 + chl) * 2 + 1]; B = wa_ * B + wb_; A *= wa_; }
            float* g = SUMB + ((size_t)(cq * 8 + hh) * 2 + dir) * 256 + 2 * chl; g[0] = A; g[1] = B; }
    }
    __syncthreads();
}

__device__ __forceinline__ bf16x8 pack8(const float (&p)[8]) { v4u w; w.x = pk2(p[0], p[1]); w.y = pk2(p[2], p[3]); w.z = pk2(p[4], p[5]); w.w = pk2(p[6], p[7]); return __builtin_bit_cast(bf16x8, w); }
__device__ __forceinline__ void c_post_item(const Args& a, int item, LAS unsigned char* lds, int wave, int lane, int tid) {
    bf16* PL = (bf16*)(a.ws + WS_PL);
    const int R0 = item * 64; const bool prompt = R0 < MP;
    int b, tok0; size_t T, tbase;
    if (prompt) { b = R0 >> 8; tok0 = R0 & 255; T = 256; tbase = ((size_t)(b * 8 + wave) * 256) * 256; }
    else { const int rs = R0 - MP; b = rs >> 12; tok0 = rs & 4095; T = 4096; tbase = (size_t)MP * DM + ((size_t)(b * 8 + wave) * 256) * 4096; }
    LAS bf16* tl = (LAS bf16*)(lds + wave * 17408);
    const float* ROPE = (const float*)(a.ws + WS_ROPE);
    const int prow = tok0 >> 6;
    for (int pl = 0; pl < 3; ++pl)
        for (int hf = 0; hf < 2; ++hf) {
            if (pl == 0 && prompt) continue;
            bf16* src = PL + (size_t)pl * PLANE + (size_t)R0 * DM + wave * 256 + hf * 128;
            tile_load(src, DM, tl, lane);
            LDS_WAIT(); asm volatile("" ::: "memory");
            if (pl < 2) {
                const float ksc = pl == 1 ? 0.0625f : 1.0f;
                if (!prompt) {
                    float cr = 0.f, sr = 0.f; if (hf == 0) { cr = ROPE[(prow * 64 + lane) * 2]; sr = ROPE[(prow * 64 + lane) * 2 + 1]; }
#pragma unroll 4
                    for (int t = 0; t < 64; ++t) { float c = cr, s = sr; if (hf) { c = ROPE[(t * 64 + lane) * 2]; s = ROPE[(t * 64 + lane) * 2 + 1]; }
                        const float x1 = bf2f(tl[t * 136 + lane]), x2 = bf2f(tl[t * 136 + 64 + lane]);
                        tl[t * 136 + lane] = (bf16)f2bf((x1 * c - x2 * s) * ksc); tl[t * 136 + 64 + lane] = (bf16)f2bf((x1 * s + x2 * c) * ksc); }
                } else {
#pragma unroll 4
                    for (int t = 0; t < 64; ++t) { const float x1 = bf2f(tl[t * 136 + lane]), x2 = bf2f(tl[t * 136 + 64 + lane]);
                        tl[t * 136 + lane] = (bf16)f2bf(x1 * ksc); tl[t * 136 + 64 + lane] = (bf16)f2bf(x2 * ksc); }
                }
                LDS_WAIT(); asm volatile("" ::: "memory");
                tile_store_rows(src, DM, tl, lane);
            }
            if (pl >= 1) { bf16* dstT = (pl == 1 ? (bf16*)(a.ws + WS_KT) : (bf16*)(a.ws + WS_H)) + tbase + (size_t)(hf * 128) * T + tok0; tile_store_T(dstT, T, tl, lane); }
            LDS_WAIT(); asm volatile("" ::: "memory");
        }
    float* GT = (float*)(a.ws + WS_GATES);
    float gt4[4];
#pragma unroll
    for (int i = 0; i < 4; ++i) { const int idx = tid + NTHR * i; gt4[i] = GT[(size_t)(R0 + (idx >> 5)) * 32 + (idx & 31)]; }
#pragma unroll
    for (int i = 0; i < 4; ++i) { const int idx = tid + NTHR * i, rl = idx >> 5, gi = idx & 31; float* p = GT + (size_t)(R0 + rl) * 32 + gi; float v = gt4[i] + a.in[29][gi];
        if ((gi >> 3) & 1) v = fminf(v, 0.f) - log1pf(__expf(-fabsf(v)));
        *p = v; }
}
constexpr int ML_KL = 0, ML_VTL = 33792, ML_CTL = 68608, ML_ARR = 136192;
__device__ __forceinline__ void c_final_pass(const Args& a, int G, int wave, int lane) {
    const bf16* HF = (const bf16*)(a.ws + WS_PL) + 2 * PLANE; const bf16* HB = (const bf16*)(a.ws + WS_HB); const bf16* OG = (const bf16*)(a.ws + WS_PL) + 3 * PLANE;
    bf16* H = (bf16*)(a.ws + WS_H);
    float gv[32];
#pragma unroll
    for (int e = 0; e < 32; ++e) gv[e] = a.in[30][32 * lane + e];
    v4u nfv[4], nbv[4], ngv[4];
#define CF_REQ(mm) do { const size_t off_ = (size_t)(mm) * DM + 32 * lane; _Pragma("unroll") for (int q = 0; q < 4; ++q) { nfv[q] = *(const v4u*)(HF + off_ + 8 * q); nbv[q] = *(const v4u*)(HB + off_ + 8 * q); ngv[q] = *(const v4u*)(OG + off_ + 8 * q); } } while (0)
    if ((int)(blockIdx.x * NWAVES + wave) < MT) CF_REQ(blockIdx.x * NWAVES + wave);
    for (int m = blockIdx.x * NWAVES + wave; m < MT; m += G * NWAVES) {
        const size_t off = (size_t)m * DM + 32 * lane;
        v4u fv[4], bv[4], gv4[4];
#pragma unroll
        for (int q = 0; q < 4; ++q) { fv[q] = nfv[q]; bv[q] = nbv[q]; gv4[q] = ngv[q]; }
        if (m + G * NWAVES < MT) CF_REQ(m + G * NWAVES);
        float x[32]; float ss = 0.f;
#pragma unroll
        for (int q = 0; q < 4; ++q) { const unsigned fw[4] = {fv[q].x, fv[q].y, fv[q].z, fv[q].w}, bw[4] = {bv[q].x, bv[q].y, bv[q].z, bv[q].w};
#pragma unroll
            for (int e = 0; e < 4; ++e) { x[8 * q + 2 * e] = __uint_as_float(fw[e] << 16) + __uint_as_float(bw[e] << 16); x[8 * q + 2 * e + 1] = __uint_as_float(fw[e] & 0xffff0000u) + __uint_as_float(bw[e] & 0xffff0000u); } }
#pragma unroll
        for (int e = 0; e < 32; ++e) ss += x[e] * x[e];
        ss += __shfl_xor(ss, 1); ss += __shfl_xor(ss, 2); ss += __shfl_xor(ss, 4);
        const float rs = rsqrtf(ss * (1.0f / 256.0f) + EPS);
        float y[32]; float am = 0.f;
#pragma unroll
        for (int q = 0; q < 4; ++q) { const unsigned ow[4] = {gv4[q].x, gv4[q].y, gv4[q].z, gv4[q].w};
#pragma unroll
            for (int e = 0; e < 4; ++e) { y[8 * q + 2 * e] = x[8 * q + 2 * e] * rs * gv[8 * q + 2 * e] * sigmoidf_(__uint_as_float(ow[e] << 16)); y[8 * q + 2 * e + 1] = x[8 * q + 2 * e + 1] * rs * gv[8 * q + 2 * e + 1] * sigmoidf_(__uint_as_float(ow[e] & 0xffff0000u)); } }
#pragma unroll
        for (int e = 0; e < 32; ++e) am = fmaxf(am, fabsf(y[e]));
        am = wave_max(am);
        const float inv = am > 0.f ? 127.0f / am : 0.f;
        unsigned wq[8];
#pragma unroll
        for (int q = 0; q < 8; ++q) { const int q0 = (int)rintf(y[4 * q] * inv) & 0xff, q1 = (int)rintf(y[4 * q + 1] * inv) & 0xff, q2 = (int)rintf(y[4 * q + 2] * inv) & 0xff, q3 = (int)rintf(y[4 * q + 3] * inv) & 0xff; wq[q] = (unsigned)(q0 | (q1 << 8) | (q2 << 16) | (q3 << 24)); }
        unsigned char* o8 = a.ws + WS_H + (size_t)m * DM + 32 * lane;
        *(v4u*)o8 = (v4u){wq[0], wq[1], wq[2], wq[3]}; *(v4u*)(o8 + 16) = (v4u){wq[4], wq[5], wq[6], wq[7]};
        if (lane == 0) ((float*)(a.ws + WS_SA))[m] = am * (1.0f / 127.0f);
    }
#undef CF_REQ
}

#ifndef AT_DV
#define AT_DV 4
#endif
constexpr int AT_K0 = 0, AT_V0 = 34816, AT_K1 = 69632, AT_V1 = 104448, AT_RPB = 139264;
__device__ __forceinline__ void attn_block(const Args& a, int kind, int b, int h, int rp, LAS unsigned char* lds, int wave, int lane, int tid) {
    const bf16* Z = (const bf16*)(a.ws + WS_Z);
    const int fr = lane & 15, fq = lane >> 4;
    const float NINF = -__builtin_inff();
    const int rq = 2 * rp + (wave >> 2), j = kind ? (wave & 3) : 0;
    const size_t qrow = kind ? (size_t)MP + (size_t)b * 4096 + rq * 64 + 16 * j + fr : (size_t)b * 256 + 16 * (8 * rp + wave) + fr;
    bf16x8 bq[4];
    { const bf16* qp = Z + qrow * 5120 + h * 128 + 8 * fq; const float qs = 0.08838834764831845f * 1.4426950408889634f;
#pragma unroll
      for (int kk = 0; kk < 4; ++kk) { const v4u raw = *(const v4u*)(qp + 32 * kk); const unsigned rw[4] = {raw.x, raw.y, raw.z, raw.w}; v4u w;
          w.x = pk2(__uint_as_float(rw[0] << 16) * qs, __uint_as_float(rw[0] & 0xffff0000u) * qs); w.y = pk2(__uint_as_float(rw[1] << 16) * qs, __uint_as_float(rw[1] & 0xffff0000u) * qs);
          w.z = pk2(__uint_as_float(rw[2] << 16) * qs, __uint_as_float(rw[2] & 0xffff0000u) * qs); w.w = pk2(__uint_as_float(rw[3] << 16) * qs, __uint_as_float(rw[3] & 0xffff0000u) * qs);
          bq[kk] = __builtin_bit_cast(bf16x8, w); } }
    const int rlo = min(max(2 * rp - 4, 0), 56), rhi = min(max(2 * rp + 1 - 4, 0), 56) + 8;
    const int nsw = kind ? (rhi - rlo + 1) >> 1 : 0, ntile = kind ? nsw + 4 : 2;
    const int r0 = min(max(rq - 4, 0), 56), start = min(max(16 * j - 8, 0), 32);
    float m_run = NINF, l_run = 0.f;
    f32x4 o[8];
#pragma unroll
    for (int dt = 0; dt < 8; ++dt) o[dt] = (f32x4){0.f, 0.f, 0.f, 0.f};
    v4u sk[4], sv[4], sk2[4], sv2[4];
#define AT_LOAD(t, SK, SV) do { _Pragma("unroll") for (int i_ = 0; i_ < 4; ++i_) { const int id_ = tid + NTHR * i_, key_ = id_ >> 4, ch_ = id_ & 15; \
        if (kind == 0) { SK[i_] = *(const v4u*)(Z + ((size_t)b * 256 + 128 * (t) + key_) * 5120 + 1024 + h * 128 + 8 * ch_); SV[i_] = *(const v4u*)((const bf16*)(a.ws + WS_VTP) + ((size_t)(b * 8 + h) * 128 + key_) * 256 + 128 * (t) + 8 * ch_); } \
        else if ((t) < nsw) { const int rk_ = min(rlo + 2 * (t) + (key_ >> 6), rhi - 1), rv_ = min(rlo + 2 * (t) + (ch_ >> 3), rhi - 1); \
            SK[i_] = *(const v4u*)(Z + ((size_t)MP + (size_t)b * 4096 + rk_ * 64 + (key_ & 63)) * 5120 + 1024 + h * 128 + 8 * ch_); SV[i_] = *(const v4u*)((const bf16*)(a.ws + WS_VTS) + ((size_t)(b * 8 + h) * 128 + key_) * 4096 + rv_ * 64 + 8 * (ch_ & 7)); } \
        else { const int c_ = (t) - nsw; SK[i_] = *(const v4u*)((const bf16*)(a.ws + WS_KC) + ((size_t)(b * 512 + 128 * c_ + key_) * 8 + h) * 128 + 8 * ch_); SV[i_] = *(const v4u*)((const bf16*)(a.ws + WS_VCT) + ((size_t)b * 1024 + h * 128 + key_) * 512 + 128 * c_ + 8 * ch_); } } } while (0)
#define AT_STORE(buf) do { LAS bf16* kl_ = (LAS bf16*)(lds + ((buf) ? AT_K1 : AT_K0)); LAS bf16* vl_ = (LAS bf16*)(lds + ((buf) ? AT_V1 : AT_V0)); \
        _Pragma("unroll") for (int i_ = 0; i_ < 4; ++i_) { const int id_ = tid + NTHR * i_; *(LAS v4u*)(kl_ + (id_ >> 4) * 136 + 8 * (id_ & 15)) = sk[i_]; *(LAS v4u*)(vl_ + (id_ >> 4) * 136 + 8 * (id_ & 15)) = sv[i_]; } } while (0)
    __syncthreads();
    LAS float* rpbl = (LAS float*)(lds + AT_RPB);
    if (kind && tid < 465) rpbl[tid] = a.in[20][h * 465 + tid] * 1.4426950408889634f;
    AT_LOAD(0, sk, sv); AT_STORE(0);
    AT_LOAD(1, sk, sv);
    if (ntile > 2) AT_LOAD(2, sk2, sv2);
    LDS_WAIT(); __syncthreads();
    for (int t = 0; t < ntile; ++t) {
        const LAS bf16* kl = (const LAS bf16*)(lds + ((t & 1) ? AT_K1 : AT_K0)); const LAS bf16* vl = (const LAS bf16*)(lds + ((t & 1) ? AT_V1 : AT_V0));
        const bool win = kind && t < nsw;
        const int ng = win ? 2 : 4;
        for (int g = 0; g < ng; ++g) {
            const int rr = rlo + 2 * t + g;
            if (win && !(rr >= r0 && rr < r0 + 8)) continue;
            const int koff = win ? 64 * g + start : 32 * g;
            f32x4 s0 = (f32x4){0.f, 0.f, 0.f, 0.f}, s1 = (f32x4){0.f, 0.f, 0.f, 0.f};
            const LAS bf16* k0p = kl + (koff + fr) * 136 + 8 * fq;
#pragma unroll
            for (int kk = 0; kk < 4; ++kk) { const bf16x8 a0 = *(const LAS bf16x8*)(k0p + 32 * kk), a1 = *(const LAS bf16x8*)(k0p + 16 * 136 + 32 * kk); s0 = MFMA16(a0, bq[kk], s0); s1 = MFMA16(a1, bq[kk], s1); }
            const LAS bf16* vq0 = vl + fr * 136 + koff + 4 * fq;
            v2u rlo[AT_DV], rhi[AT_DV];
#pragma unroll
            for (int d = 0; d < AT_DV; ++d) { rlo[d] = *(const LAS v2u*)(vq0 + (16 * d) * 136); rhi[d] = *(const LAS v2u*)(vq0 + (16 * d) * 136 + 16); }
            __builtin_amdgcn_sched_barrier(0);
            float p[8];
#pragma unroll
            for (int e = 0; e < 4; ++e) { p[e] = s0[e]; p[4 + e] = s1[e]; }
            if (win) {
                const int qc = 16 * j + fr, c0 = min(max(qc - 8, 0), 48); const LAS float* rb = rpbl + (rr - rq + 7) * 31;
#pragma unroll
                for (int e = 0; e < 8; ++e) { const int kc = start + (e < 4 ? 4 * fq + e : 16 + 4 * fq + (e - 4)); const bool ok = kc >= c0 && kc < c0 + 16; const int dci = min(max(kc - qc + 15, 0), 30);
                    p[e] = ok ? p[e] + rb[dci] : NINF; }
            }
            float mx = fmaxf(fmaxf(fmaxf(p[0], p[1]), fmaxf(p[2], p[3])), fmaxf(fmaxf(p[4], p[5]), fmaxf(p[6], p[7])));
            mx = rows_max(mx);
            const float m_new = fmaxf(m_run, mx); const float corr = __builtin_amdgcn_exp2f(m_run - m_new);
            float rs = 0.f;
#pragma unroll
            for (int e = 0; e < 8; ++e) { p[e] = __builtin_amdgcn_exp2f(p[e] - m_new); rs += p[e]; }
            rs = rows_sum(rs);
            l_run = l_run * corr + rs; m_run = m_new;
            const bf16x8 pb = pack8(p); const bool resc = !__all(corr == 1.0f);
#pragma unroll
            for (int dt = 0; dt < 8; ++dt) {
                __builtin_amdgcn_sched_barrier(0);
                const v4u vv = (v4u){rlo[dt % AT_DV].x, rlo[dt % AT_DV].y, rhi[dt % AT_DV].x, rhi[dt % AT_DV].y}; if (resc) o[dt] = o[dt] * corr; o[dt] = MFMA16(__builtin_bit_cast(bf16x8, vv), pb, o[dt]);
                if (dt + AT_DV < 8) { rlo[dt % AT_DV] = *(const LAS v2u*)(vq0 + (16 * (dt + AT_DV)) * 136); rhi[dt % AT_DV] = *(const LAS v2u*)(vq0 + (16 * (dt + AT_DV)) * 136 + 16); }
                __builtin_amdgcn_sched_barrier(0); }
        }
        if (t + 1 < ntile) AT_STORE((t + 1) & 1);
#pragma unroll
        for (int i_ = 0; i_ < 4; ++i_) { sk[i_] = sk2[i_]; sv[i_] = sv2[i_]; }
        if (t + 3 < ntile) AT_LOAD(t + 3, sk2, sv2);
        LDS_WAIT(); __syncthreads();
    }
#undef AT_LOAD
#undef AT_STORE
    const float inv = 1.0f / l_run;
    bf16* op = (bf16*)(a.ws + WS_H) + qrow * DM + h * 128 + 4 * fq;
#pragma unroll
    for (int dt = 0; dt < 8; ++dt) *(v2u*)(op + 16 * dt) = (v2u){pk2(o[dt][0] * inv, o[dt][1] * inv), pk2(o[dt][2] * inv, o[dt][3] * inv)};
}

#ifndef ML_DA
#define ML_DA 4
#endif
#ifndef ML_DB
#define ML_DB 3
#endif
#ifndef ML_DV
#define ML_DV 3
#endif
#ifndef ML_DC
#define ML_DC 2
#endif
constexpr int ML2_ARR0 = 136192, ML2_ARR1 = 138784, ML2_NV = 141376;
__device__ __forceinline__ void ml2_scan(LAS float* arr, float ii0, float ff0, float ii1, float ff1, float m_prev, int dir, int lane) {
    const int p0 = 2 * lane, p1 = 2 * lane + 1, i0 = dir ? 127 - p0 : p0, i1 = dir ? 127 - p1 : p1;
    const float s1 = ff0 + ff1; float inc = s1;
#pragma unroll
    for (int o = 1; o < 64; o <<= 1) { const float t = __shfl_up(inc, o); if (lane >= o) inc += t; }
    const float exc = inc - s1, bc0 = exc + ff0, bc1 = inc;
    const float a0 = ii0 - bc0, a1 = ii1 - bc1;
    float im = fmaxf(a0, a1);
#pragma unroll
    for (int o = 1; o < 64; o <<= 1) { const float t = __shfl_up(im, o); if (lane >= o) im = fmaxf(im, t); }
    float em = __shfl_up(im, 1); if (lane == 0) em = -__builtin_inff();
    const float mm0 = fmaxf(m_prev, fmaxf(em, a0)), mm1 = fmaxf(m_prev, im);
    const float mml = fmaxf(m_prev, __shfl(im, 63)), bk = __shfl(inc, 63);
    arr[i0] = a0; arr[i1] = a1; arr[128 + i0] = mm0; arr[128 + i1] = mm1; arr[256 + i0] = __expf(m_prev - mm0); arr[256 + i1] = __expf(m_prev - mm1);
    arr[384 + i0] = __expf(-(bc0 + mm0)); arr[384 + i1] = __expf(-(bc1 + mm1)); arr[512 + i0] = __expf(a0 - mml); arr[512 + i1] = __expf(a1 - mml);
    if (lane == 0) { arr[640] = __expf(m_prev - mml); arr[641] = bk + mml; }
}
__device__ __forceinline__ void mlstm_unit2(const Args& a, int kind, int b, int hh, int dir, int dvh, LAS unsigned char* lds, int wave, int lane0, int tid0) {
    asm volatile("" : "+v"(lane0), "+v"(tid0));
    int lane = lane0, tid = tid0;
    const int fr0 = lane0 & 15, fq0 = lane0 >> 4; int fr = fr0, fq = fq0;
    const int T = kind ? 4096 : 256, nch = T >> 7;
    const size_t row0 = kind ? (size_t)MP + (size_t)b * 4096 : (size_t)b * 256;
    const size_t tb = kind ? (size_t)MP * DM + ((size_t)(b * 8 + hh) * 256) * 4096 : ((size_t)(b * 8 + hh) * 256) * 256;
    const bf16* Qp = (const bf16*)(a.ws + WS_PL); const bf16* Kp = Qp + PLANE;
    const bf16* KT = (const bf16*)(a.ws + WS_KT) + tb; const bf16* VT = (const bf16*)(a.ws + WS_H) + tb + (size_t)(dvh * 128) * T;
    bf16* HO = dir ? (bf16*)(a.ws + WS_HB) : (bf16*)(a.ws + WS_PL) + 2 * PLANE;
    const float* GT = (const float*)(a.ws + WS_GATES);
    LAS bf16* KL = (LAS bf16*)(lds + ML_KL); LAS bf16* VTL = (LAS bf16*)(lds + ML_VTL); LAS bf16* CTL = (LAS bf16*)(lds + ML_CTL);
    LAS float* NV = (LAS float*)(lds + ML2_NV);
    const int scan_wave = dir ? 7 : 0, scan_half = dir ? 0 : 1;
    const int gi_off = (dir ? 16 : 0) + hh, gf_off = (dir ? 24 : 8) + hh;
    f32x4 C[2][8];
    float m0 = 0.f;
    __syncthreads();
    if (kind) {
        const float* c0 = a.in[5] + ((size_t)((b * 2 + dir) * 8 + hh) * 256) * 256 + dvh * 128;
#pragma unroll
        for (int mt = 0; mt < 2; ++mt)
#pragma unroll
            for (int nt = 0; nt < 8; ++nt)
#pragma unroll
                for (int e = 0; e < 4; ++e) C[mt][nt][e] = c0[(unsigned)((32 * wave + 16 * mt + 4 * fq + e) * 256 + 16 * nt + fr)];
        if (tid < 256) NV[tid] = a.in[6][(size_t)((b * 2 + dir) * 8 + hh) * 256 + tid];
        m0 = a.in[7][(b * 2 + dir) * 8 + hh];
    } else {
#pragma unroll
        for (int mt = 0; mt < 2; ++mt)
#pragma unroll
            for (int nt = 0; nt < 8; ++nt) C[mt][nt] = (f32x4){0.f, 0.f, 0.f, 0.f};
        if (tid < 256) NV[tid] = 0.f;
    }
#pragma unroll
    for (int mt = 0; mt < 2; ++mt)
#pragma unroll
        for (int nt = 0; nt < 8; ++nt) *(LAS v2u*)(CTL + (16 * nt + fr) * 264 + 32 * wave + 16 * mt + 4 * fq) = (v2u){pk2(C[mt][nt][0], C[mt][nt][1]), pk2(C[mt][nt][2], C[mt][nt][3])};
    v4u vtn[4], k0n[4]; bf16x8 qf[8];
    {
        const int c = dir ? nch - 1 : 0; const size_t rb = row0 + (size_t)c * 128;
        if (wave == scan_wave) { const int i0 = dir ? 127 - 2 * lane : 2 * lane, i1 = dir ? 126 - 2 * lane : 2 * lane + 1;
            ml2_scan((LAS float*)(lds + ML2_ARR0), GT[(rb + i0) * 32 + gi_off], GT[(rb + i0) * 32 + gf_off], GT[(rb + i1) * 32 + gi_off], GT[(rb + i1) * 32 + gf_off], m0, dir, lane); }
#pragma unroll
        for (int i = 0; i < 4; ++i) { vtn[i] = *(const v4u*)(VT + c * 128 + (unsigned)(((tid >> 4) + 32 * i) * T + 8 * (tid & 15))); k0n[i] = *(const v4u*)(Kp + rb * DM + hh * 256 + (unsigned)(((tid >> 5) + 16 * i) * DM + 8 * (tid & 31))); }
        const bf16* qp = Qp + (rb + 16 * wave) * DM + hh * 256 + (unsigned)(fr * DM + 8 * fq);
#pragma unroll
        for (int kk = 0; kk < 8; ++kk) qf[kk] = *(const bf16x8*)(qp + 32 * kk);
    }
    for (int step = 0; step < nch; ++step) {
        const int c = dir ? nch - 1 - step : step; const int tok0 = c * 128; const size_t rb = row0 + tok0;
        const bool has_next = step + 1 < nch; const int cn = dir ? c - 1 : c + 1; const size_t rbn = row0 + (size_t)cn * 128;
        fr = fr0; fq = fq0; lane = lane0; tid = tid0; asm volatile("" : "+v"(fr), "+v"(fq), "+v"(lane), "+v"(tid));
        LAS float* arr = (LAS float*)(lds + ((step & 1) ? ML2_ARR1 : ML2_ARR0)); LAS float* arn = (LAS float*)(lds + ((step & 1) ? ML2_ARR0 : ML2_ARR1));
        LAS float* A_ = arr; LAS float* MM = arr + 128; LAS float* G_ = arr + 256; LAS float* EMT = arr + 384; LAS float* WE = arr + 512;
        if (step > 0) {
#pragma unroll
            for (int i = 0; i < 4; ++i) { vtn[i] = *(const v4u*)(VT + c * 128 + (unsigned)(((tid >> 4) + 32 * i) * T + 8 * (tid & 15))); k0n[i] = *(const v4u*)(Kp + rb * DM + hh * 256 + (unsigned)(((tid >> 5) + 16 * i) * DM + 8 * (tid & 31))); }
        }
        __syncthreads();
#pragma unroll
        for (int i = 0; i < 4; ++i) { const int cc = tid + NTHR * i; *(LAS v4u*)(VTL + (cc >> 4) * 136 + 8 * (cc & 15)) = vtn[i]; *(LAS v4u*)(KL + (cc >> 5) * 264 + 8 * (cc & 31)) = k0n[i]; }
        v4u k1r[4], akr[2][4];
        if (step > 0) { const bf16* qp = Qp + (rb + 16 * wave) * DM + hh * 256 + (unsigned)(fr * DM + 8 * fq);
#pragma unroll
            for (int kk = 0; kk < 8; ++kk) qf[kk] = *(const bf16x8*)(qp + 32 * kk); }
        float gn[4] = {0.f, 0.f, 0.f, 0.f};
        if (wave == scan_wave && has_next) { const int i0 = dir ? 127 - 2 * lane : 2 * lane, i1 = dir ? 126 - 2 * lane : 2 * lane + 1;
            gn[0] = GT[(rbn + i0) * 32 + gi_off]; gn[1] = GT[(rbn + i0) * 32 + gf_off]; gn[2] = GT[(rbn + i1) * 32 + gi_off]; gn[3] = GT[(rbn + i1) * 32 + gf_off]; }
        LDS_WAIT(); __syncthreads();
        const int tl_ = 16 * wave + fr;
        const float mm_t = MM[tl_], g_t = G_[tl_], emt = EMT[tl_];
        f32x4 o[8];
        {
            const LAS bf16* cb = CTL + fr * 264 + 8 * fq; bf16x8 ring[ML_DA]; const f32x4 zero4 = (f32x4){0.f, 0.f, 0.f, 0.f};
#define ML_A_RD(i_) (*(const LAS bf16x8*)(cb + (16 * (2 * ((i_) >> 4) + ((i_) & 1))) * 264 + 32 * (((i_) >> 1) & 7)))
#pragma unroll
            for (int d = 0; d < ML_DA; ++d) ring[d] = ML_A_RD(d);
#pragma unroll
            for (int i = 0; i < 64; ++i) { const int nt = 2 * (i >> 4) + (i & 1), kk = (i >> 1) & 7;
                __builtin_amdgcn_sched_barrier(0);
                const f32x4 oin = kk == 0 ? zero4 : o[nt]; o[nt] = MFMA16(ring[i % ML_DA], qf[kk], oin);
                if (kk == 7) o[nt] = o[nt] * g_t;
                if (i + ML_DA < 64) ring[i % ML_DA] = ML_A_RD(i + ML_DA);
                __builtin_amdgcn_sched_barrier(0); }
#undef ML_A_RD
        }
        float qn = 0.f;
#pragma unroll
        for (int kk = 0; kk < 8; ++kk) { const f32x4 n0 = *(const LAS f32x4*)(NV + 32 * kk + 8 * fq), n1 = *(const LAS f32x4*)(NV + 32 * kk + 8 * fq + 4);
#pragma unroll
            for (int jj = 0; jj < 4; ++jj) { qn += bf2f((unsigned short)qf[kk][jj]) * n0[jj]; qn += bf2f((unsigned short)qf[kk][4 + jj]) * n1[jj]; } }
        qn = rows_sum(qn);
        __builtin_amdgcn_sched_barrier(0);
#pragma unroll
        for (int i = 0; i < 4; ++i) k1r[i] = *(const v4u*)(Kp + (rb + 64) * DM + hh * 256 + (unsigned)(((tid >> 5) + 16 * i) * DM + 8 * (tid & 31)));
        float rsum = 0.f;
#pragma unroll
        for (int half = 0; half < 2; ++half) {
            if (half == 1) {
                __syncthreads();
#pragma unroll
                for (int i = 0; i < 4; ++i) { const int cc = tid + NTHR * i; *(LAS v4u*)(KL + (cc >> 5) * 264 + 8 * (cc & 31)) = k1r[i]; }
                LDS_WAIT(); __syncthreads();
            }
            if (half == scan_half && wave == scan_wave && has_next) ml2_scan(arn, gn[0], gn[1], gn[2], gn[3], arr[641], dir, lane);
#pragma unroll
            for (int pp = 0; pp < 2; ++pp) {
                const int p = 2 * half + pp, ta = 2 * p, tbb = 2 * p + 1;
                const bool na = dir ? ta >= wave : ta <= wave, nb = dir ? tbb >= wave : tbb <= wave;
                if (!na && !nb) continue;
                float pv[8];
#pragma unroll
                for (int which = 0; which < 2; ++which) {
                    const int st = which ? tbb : ta; const bool need = which ? nb : na;
                    f32x4 s4 = (f32x4){0.f, 0.f, 0.f, 0.f};
                    if (need) {
                        const LAS bf16* kb = KL + ((st & 3) * 16 + fr) * 264 + 8 * fq; bf16x8 ring[ML_DB];
#pragma unroll
                        for (int d = 0; d < ML_DB; ++d) ring[d] = *(const LAS bf16x8*)(kb + 32 * d);
#pragma unroll
                        for (int kk = 0; kk < 8; ++kk) {
                            __builtin_amdgcn_sched_barrier(0);
                            s4 = MFMA16(ring[kk % ML_DB], qf[kk], s4);
                            if (kk + ML_DB < 8) ring[kk % ML_DB] = *(const LAS bf16x8*)(kb + 32 * (kk + ML_DB));
                            __builtin_amdgcn_sched_barrier(0); }
                    }
                    if (need) {
                        const f32x4 a4 = *(const LAS f32x4*)(A_ + 16 * st + 4 * fq);
                        const int sgn = dir ? 1 : -1, d0 = sgn * (16 * st + 4 * fq - tl_), dlim = st == wave ? 0 : -(1 << 20);
#pragma unroll
                        for (int e = 0; e < 4; ++e) { float w = __expf(a4[e] - mm_t); w = (d0 + sgn * e >= dlim) ? w : 0.f;
                            pv[4 * which + e] = s4[e] * w; rsum += pv[4 * which + e]; }
                    } else {
#pragma unroll
                        for (int e = 0; e < 4; ++e) pv[4 * which + e] = 0.f; }
                }
                const bf16x8 pb = pack8(pv);
                {   const LAS bf16* vq = VTL + fr * 136 + 32 * p + 4 * fq; v2u rlo[ML_DV], rhi[ML_DV];
#pragma unroll
                    for (int d = 0; d < ML_DV; ++d) { rlo[d] = *(const LAS v2u*)(vq + (16 * d) * 136); rhi[d] = *(const LAS v2u*)(vq + (16 * d) * 136 + 16); }
#pragma unroll
                    for (int nt = 0; nt < 8; ++nt) {
                        __builtin_amdgcn_sched_barrier(0);
                        const v4u vv = (v4u){rlo[nt % ML_DV].x, rlo[nt % ML_DV].y, rhi[nt % ML_DV].x, rhi[nt % ML_DV].y}; o[nt] = MFMA16(__builtin_bit_cast(bf16x8, vv), pb, o[nt]);
                        if (nt + ML_DV < 8) { rlo[nt % ML_DV] = *(const LAS v2u*)(vq + (16 * (nt + ML_DV)) * 136); rhi[nt % ML_DV] = *(const LAS v2u*)(vq + (16 * (nt + ML_DV)) * 136 + 16); }
                        __builtin_amdgcn_sched_barrier(0); } }
            }
        }
        __builtin_amdgcn_sched_barrier(0);
#pragma unroll
        for (int mt = 0; mt < 2; ++mt) { const bf16* kp = KT + (size_t)(32 * wave + 16 * mt) * T + tok0 + (unsigned)(fr * T + 8 * fq);
#pragma unroll
            for (int kk = 0; kk < 4; ++kk) akr[mt][kk] = *(const v4u*)(kp + 32 * kk); }
        rsum = rows_sum(rsum);
        { const float den = rsum + g_t * qn; const float inv = 1.0f / fmaxf(fabsf(den), emt);
          bf16* op = HO + (rb + 16 * wave) * DM + hh * 256 + dvh * 128 + (unsigned)(fr * DM + 4 * fq);
#pragma unroll
          for (int nt = 0; nt < 8; ++nt) *(v2u*)(op + 16 * nt) = (v2u){pk2(o[nt][0] * inv, o[nt][1] * inv), pk2(o[nt][2] * inv, o[nt][3] * inv)}; }
        const float ge = arr[640];
        float nsum[2]; bf16x8 ak[2][4];
#pragma unroll
        for (int mt = 0; mt < 2; ++mt) { float ns = 0.f;
#pragma unroll
            for (int kk = 0; kk < 4; ++kk) { const v4u raw = akr[mt][kk]; const f32x4 w0 = *(const LAS f32x4*)(WE + 32 * kk + 8 * fq), w1 = *(const LAS f32x4*)(WE + 32 * kk + 8 * fq + 4);
                const unsigned rw[4] = {raw.x, raw.y, raw.z, raw.w}; float f[8];
#pragma unroll
                for (int e = 0; e < 4; ++e) { f[2 * e] = __uint_as_float(rw[e] << 16); f[2 * e + 1] = __uint_as_float(rw[e] & 0xffff0000u); }
                f[0] *= w0[0]; f[1] *= w0[1]; f[2] *= w0[2]; f[3] *= w0[3]; f[4] *= w1[0]; f[5] *= w1[1]; f[6] *= w1[2]; f[7] *= w1[3];
#pragma unroll
                for (int e = 0; e < 8; ++e) ns += f[e];
                ak[mt][kk] = pack8(f); }
            nsum[mt] = rows_sum(ns); }
        {   const LAS bf16* vb = VTL + fr * 136 + 8 * fq; bf16x8 ring[ML_DC];
#define ML_C_RD(i_) (*(const LAS bf16x8*)(vb + (16 * ((i_) >> 2)) * 136 + 32 * ((i_) & 3)))
#pragma unroll
            for (int d = 0; d < ML_DC; ++d) ring[d] = ML_C_RD(d);
#pragma unroll
            for (int i = 0; i < 32; ++i) { const int nt = i >> 2, kk = i & 3;
                __builtin_amdgcn_sched_barrier(0);
                if (kk == 0) { C[0][nt] = C[0][nt] * ge; C[1][nt] = C[1][nt] * ge; }
                C[0][nt] = MFMA16(ak[0][kk], ring[i % ML_DC], C[0][nt]); C[1][nt] = MFMA16(ak[1][kk], ring[i % ML_DC], C[1][nt]);
                if (i + ML_DC < 32) ring[i % ML_DC] = ML_C_RD(i + ML_DC);
                __builtin_amdgcn_sched_barrier(0); }
#undef ML_C_RD
        }
#pragma unroll
        for (int mt = 0; mt < 2; ++mt) {
#pragma unroll
            for (int nt = 0; nt < 8; ++nt) *(LAS v2u*)(CTL + (16 * nt + fr) * 264 + 32 * wave + 16 * mt + 4 * fq) = (v2u){pk2(C[mt][nt][0], C[mt][nt][1]), pk2(C[mt][nt][2], C[mt][nt][3])};
            if (fq == 0) { const int dk = 32 * wave + 16 * mt + fr; NV[dk] = ge * NV[dk] + nsum[mt]; }
        }
    }
    if (kind == 0) {
        float* oc = a.out + 83918848 + ((size_t)((b * 2 + dir) * 8 + hh) * 256) * 256 + dvh * 128;
#pragma unroll
        for (int mt = 0; mt < 2; ++mt)
#pragma unroll
            for (int nt = 0; nt < 8; ++nt)
#pragma unroll
                for (int e = 0; e < 4; ++e) oc[(unsigned)((32 * wave + 16 * mt + 4 * fq + e) * 256 + 16 * nt + fr)] = C[mt][nt][e];
        if (dvh == 0) { LDS_WAIT(); __syncthreads();
            if (tid < 256) a.out[100696064 + (size_t)((b * 2 + dir) * 8 + hh) * 256 + tid] = NV[tid];
            if (tid == 0) a.out[100761600 + (b * 2 + dir) * 8 + hh] = ((LAS float*)(lds + (((nch - 1) & 1) ? ML2_ARR1 : ML2_ARR0)))[641]; }
    }
}

#ifndef WGM_G1
#define WGM_G1 4
#endif
#ifndef WGM_N8
#define WGM_N8 4
#endif
template <int L, int F, bool FIRST>
__device__ __forceinline__ void ffn_gemm1(const Args& a, LAS unsigned char* lds, int G) {
    pg8::Gemm g{(const bf16*)(a.ws + WS_H), (const bf16*)(a.ws + (F == 0 ? WS_W1A : WS_W1B)), MT, 2 * DFF, DM / 2}; pg8::StaticOrder S; S.init(MT, 2 * DFF, G, (int)blockIdx.x, WGM_G1);
    pg8::EpiGluQ E{a.ws + WS_ACT, (const float*)(a.ws + WS_SA), (const float*)(a.ws + WS_SB1) + (F == 0 ? 0 : 11264)};
    pg8::gemm_phase<pg8::EpiGluQ, pg8::StaticOrder, PG8_ALIGN, PG8_SP2, 1>(lds, g, S, E);
}
template <int L, int F, bool FIRST>
__device__ __forceinline__ void ffn_gemm2(const Args& a, LAS unsigned char* lds, int G) {
    pg8::Gemm g{(const bf16*)(a.ws + WS_ACT), (const bf16*)(a.ws + (F == 0 ? WS_W2A : WS_W2B)), MT, DM, DFF / 2}; pg8::StaticOrder S; S.init(MT, DM, G, (int)blockIdx.x, WGM_N8);
    const float* modg = (const float*)(a.ws + WS_MOD) + (size_t)L * 9 * MODS + (size_t)(F == 0 ? 2 : 8) * DM;
    constexpr bool LAST = (L == 1 && F == 1);
    typedef pg8::EpiRes2<FIRST, LAST, true> EpiT;
    EpiT E{FIRST ? (const void*)a.in[0] : (LAST ? (const void*)(a.ws + WS_XB2) : (const void*)a.out), FIRST ? (const void*)(a.in[1] - (size_t)MP * DM) : nullptr, a.out, modg, (const float*)(a.ws + WS_SB2) + (F == 0 ? 0 : 2048), nullptr, LAST ? DM : XPITCH, XPITCH, 0.5f};
    pg8::gemm_phase<EpiT, pg8::StaticOrder, PG8_ALIGN, PG8_SP2, 2>(lds, g, S, E);
}
#define FFN_NORM norm_pass_q
#define FFN_CONV_ITEMS 416
#define FFN_CONV(l, f, slot, it) ffn_quant_item(a, l, f, slot, it, lds, wave, lane, tid)
__global__ void __launch_bounds__(NTHR, 2) fwd_kernel(Args a) {
    extern __shared__ __attribute__((aligned(16))) unsigned char lds_raw[];
    LAS unsigned char* lds = (LAS unsigned char*)lds_raw;
    const int tid = threadIdx.x, lane = tid & 63, wave = __builtin_amdgcn_readfirstlane(tid >> 6);
    const int G = gridDim.x;
    volatile LAS unsigned* MISC = (volatile LAS unsigned*)(lds + MISC_OFF);
    if (tid < 64) MISC[tid] = 0u;
    __syncthreads();
#if MK_ONE_LAUNCH
    XcdBarrier bar = xcd_barrier_post((unsigned*)(a.ws + WS_CTL) + CW_BAR, MISC + 8);
#define GRID_BAR() xcd_barrier(bar)
#else
#define GRID_BAR() do { } while (0)
#endif
    const int lo = a.ph_lo, hi = a.ph_hi;
#define IN(k) (lo <= (k) && (k) < hi)
#define SEAM(k) do { if (IN(k) && IN((k) + 1)) GRID_BAR(); } while (0)
    const int NGW = G * NWAVES, gw = blockIdx.x * NWAVES + wave;

    if (IN(0)) { phase_p0(a, lds, G, wave, lane, tid); } SEAM(0);
    if (IN(1)) { FFN_NORM<true>(a, 0, 0, G, wave, lane); } SEAM(1);
    if (IN(2)) { ffn_gemm1<0, 0, true>(a, lds, G); } SEAM(2);
    if (IN(3)) { ffn_gemm2<0, 0, true>(a, lds, G); } SEAM(3);
    if (IN(4)) { norm_pass<false>(a, 0, 1, G, wave, lane);
        for (int it = blockIdx.x; it < FFN_CONV_ITEMS; it += G) FFN_CONV(1, 0, 0, it); }
    if (IN(5)) { pg8::Gemm g{(const bf16*)(a.ws + WS_H), (const bf16*)(a.ws + WS_WINAB), MT, 5120, DM}; pg8::StaticOrder S; S.init(MT, 5120, G, (int)blockIdx.x);
        pg8::EpiBf16<0> E{(bf16*)(a.ws + WS_Z), 5120, nullptr, 0, 0, 1.f};
        pg8::gemm_phase<pg8::EpiBf16<0>, pg8::StaticOrder, PG8_ALIGN, PG8_SP2>(lds, g, S, E); } SEAM(5);
    if (IN(6)) { for (int it = blockIdx.x; it < 1152; it += G) lru_item<1>(a, it >> 3, it & 7, lds, wave, lane, tid);
        { int ib, ni; tail_ids(1152, G, ib, ni); if (ib >= 0) for (int it = ib; it < 576; it += ni) ab_post_item(a, it, lds, wave, lane); } } SEAM(6);
    if (IN(7)) { { for (int it = blockIdx.x; it < 1152; it += G) lru_item<2>(a, it >> 3, it & 7, lds, wave, lane, tid); }
        { const int xu = (G % 8 == 0) ? ((int)blockIdx.x % 8) * (G / 8) + (int)blockIdx.x / 8 : (int)blockIdx.x;
          for (int u = xu; u < 2048; u += G) attn_block(a, 1, u >> 8, (u >> 5) & 7, u & 31, lds, wave, lane, tid);
        { int ib, ni; tail_ids(1152, G, ib, ni); if (ib >= 0) for (int u = ib; u < 256; u += ni) attn_block(a, 0, u >> 4, (u >> 1) & 7, u & 1, lds, wave, lane, tid); } } } SEAM(7);
    if (IN(8)) { pg8::Gemm g{(const bf16*)(a.ws + WS_H), (const bf16*)(a.ws + WS_WOUTAB), MT, DM, DM}; pg8::StaticOrder S; S.init(MT, DM, G, (int)blockIdx.x, WGM_N8);
        typedef pg8::EpiRes2<false, false, false> EpiT; EpiT E{a.out, nullptr, a.out, (const float*)(a.ws + WS_MOD) + 5 * DM, nullptr, nullptr, XPITCH, XPITCH, 1.0f};
        pg8::gemm_phase<EpiT, pg8::StaticOrder, PG8_ALIGN, PG8_SP2>(lds, g, S, E); } SEAM(8);
    if (IN(9)) { FFN_NORM<false>(a, 0, 2, G, wave, lane); } SEAM(9);
    if (IN(10)) { ffn_gemm1<0, 1, false>(a, lds, G); } SEAM(10);
    if (IN(11)) { ffn_gemm2<0, 1, false>(a, lds, G); } SEAM(11);
    if (IN(12)) { FFN_NORM<false>(a, 1, 0, G, wave, lane);
        for (int it = blockIdx.x; it < FFN_CONV_ITEMS; it += G) FFN_CONV(1, 1, 1, it); }
    if (IN(13)) { ffn_gemm1<1, 0, false>(a, lds, G); } SEAM(13);
    if (IN(14)) { ffn_gemm2<1, 0, false>(a, lds, G); } SEAM(14);
    if (IN(15)) { norm_pass_dual<false>(a, 1, 1, G, wave, lane); } SEAM(15);
    if (IN(16)) {
        { pg8::Gemm g{(const bf16*)(a.ws + WS_H), (const bf16*)(a.ws + WS_WINC), MT, 4352, DM}; pg8::StaticOrder S; S.init(MT, 4352, G, (int)blockIdx.x);
          typedef pg8::EpiProj<false, 1> EpiT; EpiT E{(bf16*)(a.ws + WS_PL), (float*)(a.ws + WS_GATES), nullptr, nullptr};
          pg8::gemm_phase<EpiT, pg8::StaticOrder, PG8_ALIGN, PG8_SP2>(lds, g, S, E); }
        { pg8::Gemm g{(const bf16*)(a.ws + WS_H8M), (const bf16*)(a.ws + WS_WQC), MT, 4096, DM / 2}; pg8::StaticOrder S; S.init(MT, 4096, G, G - 1 - (int)blockIdx.x);
          typedef pg8::EpiProj<true, 1> EpiT; EpiT E{(bf16*)(a.ws + WS_PL), nullptr, (const float*)(a.ws + WS_SA), (const float*)(a.ws + WS_SBQC)};
          pg8::gemm_phase<EpiT, pg8::StaticOrder, PG8_ALIGN, PG8_SP2, 1>(lds, g, S, E); } } SEAM(16);
    if (IN(17)) { for (int it = blockIdx.x; it < 576; it += G) c_post_item(a, it, lds, wave, lane, tid); } SEAM(17);
    if (IN(18)) {
        const int xu = (G % 8 == 0) ? ((int)blockIdx.x % 8) * (G / 8) + (int)blockIdx.x / 8 : (int)blockIdx.x;
        for (int u = xu; u < 256; u += G) mlstm_unit2(a, 1, u >> 5, (u >> 2) & 7, (u >> 1) & 1, u & 1, lds, wave, lane, tid);
        for (int u = xu; u < 512; u += G) mlstm_unit2(a, 0, u >> 5, (u >> 2) & 7, (u >> 1) & 1, u & 1, lds, wave, lane, tid); } SEAM(18);
    if (IN(19)) { c_final_pass(a, G, wave, lane); } SEAM(19);
    if (IN(20)) { pg8::Gemm g{(const bf16*)(a.ws + WS_H), (const bf16*)(a.ws + WS_WQOC), MT, DM, DM / 2}; pg8::StaticOrder S; S.init(MT, DM, G, (int)blockIdx.x, WGM_N8);
        typedef pg8::EpiRes2<false, false, true, true> EpiT; EpiT E{a.out, nullptr, a.ws + WS_XB2, (const float*)(a.ws + WS_MOD) + (size_t)9 * MODS + 5 * DM, (const float*)(a.ws + WS_SBOC), (const float*)(a.ws + WS_SA), XPITCH, DM, 1.0f};
        pg8::gemm_phase<EpiT, pg8::StaticOrder, PG8_ALIGN, PG8_SP2, 1>(lds, g, S, E); } SEAM(20);
    if (IN(21)) { FFN_NORM<false, true>(a, 1, 2, G, wave, lane); } SEAM(21);
    if (IN(22)) { ffn_gemm1<1, 1, false>(a, lds, G); } SEAM(22);
    if (IN(23)) { ffn_gemm2<1, 1, false>(a, lds, G); }
#undef IN
#undef SEAM
}

extern "C" void kernel_launch(void* const* d_in, const int* in_sizes, int n_in, void* d_out, int out_size, void* d_ws, size_t ws_size, hipStream_t stream) {
    static int grid = 0;
    if (grid == 0) {
        if (n_in != 32 || out_size != 100761856 || ws_size < WS_END) { fprintf(stderr, "kernel_launch: unexpected problem (n_in %d, out %d, ws %zu < %zu)\n", n_in, out_size, ws_size, (size_t)WS_END); grid = -1; return; }
        int dev = 0, cus = 0, per_cu = 0;
        if (hipGetDevice(&dev) != hipSuccess || hipDeviceGetAttribute(&cus, hipDeviceAttributeMultiprocessorCount, dev) != hipSuccess) { grid = -1; return; }
        if (hipFuncSetAttribute((const void*)fwd_kernel, hipFuncAttributeMaxDynamicSharedMemorySize, LDS_BYTES) != hipSuccess) { fprintf(stderr, "kernel_launch: hipFuncSetAttribute failed\n"); grid = -1; return; }
        if (hipOccupancyMaxActiveBlocksPerMultiprocessor(&per_cu, (const void*)fwd_kernel, NTHR, LDS_BYTES) != hipSuccess || per_cu < 1) fprintf(stderr, "kernel_launch: occupancy query says %d\n", per_cu);
        (void)hipGetLastError();
        grid = cus;
    }
    if (grid < 0) return;
    (void)hipMemsetAsync((char*)d_ws + WS_CTL, 0, CTL_ZERO_BYTES, stream);
    Args a{};
    for (int i = 0; i < 32; ++i) a.in[i] = (const float*)d_in[i];
    a.out = (float*)d_out; a.ws = (unsigned char*)d_ws;
#if MK_ONE_LAUNCH
    a.ph_lo = 0; a.ph_hi = N_PHASES;
    hipLaunchKernelGGL(fwd_kernel, dim3(grid), dim3(NTHR), LDS_BYTES, stream, a);
#else
    for (int p = 0; p < N_PHASES; ++p) { a.ph_lo = p; a.ph_hi = p + 1; hipLaunchKernelGGL(fwd_kernel, dim3(grid), dim3(NTHR), LDS_BYTES, stream, a); }
#endif
}
```

```cpp
#include <hip/hip_runtime.h>
#include <cstdio>
#include <cstdint>
#define MK_ONE_LAUNCH 1

namespace pg8 {
#define PG8_LAS __attribute__((address_space(3)))
typedef unsigned short bf16_t;
typedef short bf16x8 __attribute__((ext_vector_type(8)));
typedef float f32x4 __attribute__((ext_vector_type(4)));
typedef unsigned u32x4 __attribute__((ext_vector_type(4)));
typedef int i32x4 __attribute__((ext_vector_type(4)));
typedef int i32x8 __attribute__((ext_vector_type(8)));
constexpr int BM = 256, BK = 64, HALF = 128, HTB = HALF * BK * 2  , STAGE_BYTES = 8 * HTB, NXCD = 8, WGM = 4;

__host__ __device__ __forceinline__ int lds_byte(int r, int c) { const int st = (r >> 4) * 2 + (c >> 5), rr = r & 15, cc = c & 31, ob = rr * 64 + cc * 2; return st * 1024 + (ob ^ (((ob >> 9) & 1) << 5)); }
__host__ __device__ __forceinline__ void stage_rc(int b, int& R, int& C) { const int st = b / 1024, sb = b % 1024, swz = sb ^ (((sb >> 9) & 1) << 5); R = (st >> 1) * 16 + swz / 64; C = (st & 1) * 32 + (swz % 64) / 2; }
__host__ __device__ __forceinline__ int perm32(int rho) { const int n = rho >> 4, i = rho & 15; return 8 * (i >> 2) + 4 * n + (i & 3); }

struct Unit { int pm, pn; };
struct Gemm { const bf16_t* A; const bf16_t* Bt; int M, N, K; };

struct StaticOrder {
    int nM, nN, nwg, G, c, wgm;
    __host__ __device__ void init(int M, int N, int G_, int c_, int wgm_ = WGM) { nM = M / BM; nN = N / BM; nwg = nM * nN; G = G_; c = c_; wgm = wgm_; }
    __host__ __device__ bool next(int i, Unit& u) const {
        const long L = (long)i * G + c; if (L >= nwg) return false;
        int wgid = (int)L; { const int q = nwg / NXCD, r = nwg % NXCD, xcd = wgid % NXCD, off = wgid / NXCD; wgid = (xcd < r ? xcd * (q + 1) : r * (q + 1) + (xcd - r) * q) + off; }
        const int nig = wgm * nN, gid = wgid / nig, fm = gid * wgm, gsz = (nM - fm) < wgm ? (nM - fm) : wgm;
        u.pm = fm + ((wgid % nig) % gsz); u.pn = (wgid % nig) / gsz; return true;
    }
    __device__ __forceinline__ void a_ready(const Unit&) const {}
    __device__ __forceinline__ void done(const Unit&) const {}
};

__device__ __forceinline__ unsigned cvt_pk_bf16(float lo, float hi) { unsigned r; asm volatile("v_cvt_pk_bf16_f32 %0, %1, %2" : "=v"(r) : "v"(lo), "v"(hi)); return r; }
typedef float f32x2 __attribute__((ext_vector_type(2)));
__device__ __forceinline__ f32x2 gelu_pk(f32x2 v) {
    const f32x2 av = __builtin_elementwise_abs(v), d = av * 0.2316418882f + 1.0f;
    f32x2 t; t.x = __builtin_amdgcn_rcpf(d.x); t.y = __builtin_amdgcn_rcpf(d.y);
    f32x2 q = t * 0.5307027145f + (-0.7265760135f); q = q * t + 0.7107068705f; q = q * t + (-0.142248368f); q = q * t + 0.127414796f; q = q * t;
    const f32x2 s = (v * v) * (-0.72134752044f);
    f32x2 e; e.x = __builtin_amdgcn_exp2f(s.x); e.y = __builtin_amdgcn_exp2f(s.y);
    const f32x2 m = v * (q * e), r = v - m;
    f32x2 o; o.x = v.x < 0.f ? m.x : r.x; o.y = v.y < 0.f ? m.y : r.y; return o;
}

template <int ACT  > struct EpiBf16 {
    static constexpr bool PERM = true, AFTER_DRAIN = false; static_assert(ACT == 0 || ACT == 1, "EpiBf16: ACT is 0 (none) or 1 (gelu_pk)");
    bf16_t* O; int ldc; const float* bias; int split_cols; size_t split_stride; float scale0;
    __device__ __forceinline__ void operator()(const f32x4 (&acc)[2][2][4][2], const Unit& u, int wr, int wc, int fr, int fq) const {
        const int row0 = u.pm * BM + wr * 64 + fr; int colt = u.pn * BM; bf16_t* base = O;
        float sc = 1.f; if (split_cols) { const int t = colt / split_cols; base += (size_t)t * split_stride; colt -= t * split_cols; if (t == 0) sc = scale0; }
        const int col0 = colt + wc * 32 + 8 * fq, bcol0 = u.pn * BM + wc * 32 + 8 * fq;
        f32x4 bv[2][2];
#pragma unroll
        for (int bj = 0; bj < 2; ++bj)
#pragma unroll
            for (int n = 0; n < 2; ++n) bv[bj][n] = bias ? *(const f32x4*)(bias + bcol0 + bj * HALF + 4 * n) : (f32x4){0.f, 0.f, 0.f, 0.f};
#pragma unroll
        for (int ai = 0; ai < 2; ++ai)
#pragma unroll
            for (int m = 0; m < 4; ++m) { bf16_t* rowp = base + (size_t)(row0 + ai * HALF + m * 16) * ldc + col0;
#pragma unroll
                for (int bj = 0; bj < 2; ++bj) { f32x4 v0 = acc[ai][bj][m][0] + bv[bj][0], v1 = acc[ai][bj][m][1] + bv[bj][1];
                    if (ACT == 1) { f32x2 a = gelu_pk((f32x2){v0[0], v0[1]}), b = gelu_pk((f32x2){v0[2], v0[3]}), c = gelu_pk((f32x2){v1[0], v1[1]}), d = gelu_pk((f32x2){v1[2], v1[3]});
                        v0 = (f32x4){a.x, a.y, b.x, b.y}; v1 = (f32x4){c.x, c.y, d.x, d.y}; }
                    v0 = v0 * sc; v1 = v1 * sc; u32x4 w; w.x = cvt_pk_bf16(v0[0], v0[1]); w.y = cvt_pk_bf16(v0[2], v0[3]); w.z = cvt_pk_bf16(v1[0], v1[1]); w.w = cvt_pk_bf16(v1[2], v1[3]);
                    *(u32x4*)(rowp + bj * HALF) = w; } }
    }
};

constexpr int EP_M = 36864, EP_D = 2048, EP_FF = 5632, EP_MODS = 9 * 2048;
__device__ __forceinline__ int set_of_pm(int pm) { return pm < 16 ? 0 : 1 + ((pm - 16) >> 4); }
__device__ __forceinline__ unsigned pk4_fp8(float a, float b, float c, float d) { int w = 0; w = __builtin_amdgcn_cvt_pk_fp8_f32(a, b, w, false); w = __builtin_amdgcn_cvt_pk_fp8_f32(c, d, w, true); return (unsigned)w; }
struct EpiGluQ {
    static constexpr bool PERM = true, AFTER_DRAIN = false;
    unsigned char* O; const float* sa; const float* sb;
    __device__ __forceinline__ void operator()(const f32x4 (&acc)[2][2][4][2], const Unit& u, int wr, int wc, int fr, int fq) const {
        const int row0 = u.pm * BM + wr * 64 + fr, col0 = u.pn * HALF + wc * 32 + 8 * fq, brow = u.pn * BM + wc * 32 + 8 * fq;
        float sr[2][4];
#pragma unroll
        for (int ai = 0; ai < 2; ++ai)
#pragma unroll
            for (int m = 0; m < 4; ++m) sr[ai][m] = sa[row0 + ai * HALF + m * 16];
        const f32x4 sg0 = *(const f32x4*)(sb + brow), sg1 = *(const f32x4*)(sb + brow + 4), su0 = *(const f32x4*)(sb + brow + HALF), su1 = *(const f32x4*)(sb + brow + HALF + 4);
        typedef unsigned u32x2 __attribute__((ext_vector_type(2))); typedef unsigned u32x4_ __attribute__((ext_vector_type(4)));
        const int wcol = col0 - ((fq & 1) ? 8 : 0);
#pragma unroll
        for (int ai = 0; ai < 2; ++ai)
#pragma unroll
            for (int mp = 0; mp < 2; ++mp) { u32x2 pk[2];
#pragma unroll
                for (int mm = 0; mm < 2; ++mm) { const int m = 2 * mp + mm; const float s = sr[ai][m];
                    float v[8];
#pragma unroll
                    for (int n = 0; n < 2; ++n) { const i32x4 gi = __builtin_bit_cast(i32x4, acc[ai][0][m][n]), ui = __builtin_bit_cast(i32x4, acc[ai][1][m][n]);
#pragma unroll
                        for (int j = 0; j < 4; ++j) { const float g = (float)gi[j] * s * (n ? sg1[j] : sg0[j]), up = (float)ui[j] * s * (n ? su1[j] : su0[j]); v[4 * n + j] = g * up * __builtin_amdgcn_rcpf(1.0f + __expf(-g)); } }
                    pk[mm] = (u32x2){pk4_fp8(v[0], v[1], v[2], v[3]), pk4_fp8(v[4], v[5], v[6], v[7])}; }
                const auto sx = __builtin_amdgcn_permlane16_swap(pk[0].x, pk[1].x, false, false), sy = __builtin_amdgcn_permlane16_swap(pk[0].y, pk[1].y, false, false);
                const int row = row0 + ai * HALF + (2 * mp + (fq & 1)) * 16;
                *(u32x4_*)(O + (size_t)row * EP_FF + wcol) = (u32x4_){sx[0], sy[0], sx[1], sy[1]}; }
    }
};

template <bool F32> struct ResRaw { typedef f32x4 T; };
template <> struct ResRaw<false> { typedef unsigned T __attribute__((ext_vector_type(2))); };
template <bool BASE_F32, bool OUT_F32, bool QS, bool I8A = false> struct EpiRes2 {
    static constexpr bool PERM = false, AFTER_DRAIN = false;
    const void* base_p; const void* base_s; void* out; const float* modg; const float* sb; const float* sa; int bpitch, opitch; float coef;
    __device__ __forceinline__ void operator()(const f32x4 (&acc)[2][2][4][2], const Unit& u, int wr, int wc, int fr, int fq) const {
        typedef unsigned u32x2_ __attribute__((ext_vector_type(2)));
        typedef typename ResRaw<BASE_F32>::T RawT;
        constexpr int NB = 8, D = BASE_F32 ? 2 : 4;
        const int row0 = u.pm * BM + wr * 64 + fr, col0 = u.pn * BM + wc * 32 + 4 * fq;
        const float* gp = modg + (size_t)set_of_pm(u.pm) * EP_MODS + col0;
        const float* bf = (const float*)(u.pm < 16 ? base_p : base_s); const bf16_t* bh = (const bf16_t*)base_p;
        float rsv[NB];
        if (I8A) {
#pragma unroll
            for (int k = 0; k < NB; ++k) rsv[k] = sa[row0 + (k >> 2) * HALF + (k & 3) * 16]; }
        f32x4 gv[2][2], sv[2][2];
#pragma unroll
        for (int bj = 0; bj < 2; ++bj)
#pragma unroll
            for (int n = 0; n < 2; ++n) { gv[bj][n] = *(const f32x4*)(gp + bj * HALF + n * 16); if (QS) sv[bj][n] = *(const f32x4*)(sb + col0 + bj * HALF + n * 16); }
        typedef unsigned u32x4_ __attribute__((ext_vector_type(4)));
        const int wcol = col0 + ((fq & 1) ? 12 : 0);
#pragma unroll
        for (int g = 0; g < NB / D; ++g) {
            RawT raw[D][2][2]; u32x4_ raww[D][2];
#pragma unroll
            for (int d = 0; d < D; ++d) { const int k = g * D + d, row = row0 + (k >> 2) * HALF + (k & 3) * 16;
#pragma unroll
                for (int bj = 0; bj < 2; ++bj) {
                    if constexpr (BASE_F32) {
#pragma unroll
                        for (int n = 0; n < 2; ++n) raw[d][bj][n] = *(const RawT*)(bf + (size_t)row * EP_D + col0 + bj * HALF + n * 16); }
                    else raww[d][bj] = *(const u32x4_*)(bh + (size_t)row * bpitch + wcol + bj * HALF); } }
            if (g == 0) {
#pragma unroll
                for (int bj = 0; bj < 2; ++bj)
#pragma unroll
                    for (int n = 0; n < 2; ++n) { gv[bj][n] = gv[bj][n] * coef; if (QS) gv[bj][n] = gv[bj][n] * sv[bj][n]; } }
#pragma unroll
            for (int d = 0; d < D; ++d) { const int k = g * D + d, ai = k >> 2, m = k & 3, row = row0 + ai * HALF + m * 16; const float rs = I8A ? rsv[k] : 1.0f;
#pragma unroll
                for (int bj = 0; bj < 2; ++bj) {
                    u32x2_ bw[2];
                    if constexpr (!BASE_F32) { const auto sx = __builtin_amdgcn_permlane16_swap(raww[d][bj].x, raww[d][bj].z, false, false), sy = __builtin_amdgcn_permlane16_swap(raww[d][bj].y, raww[d][bj].w, false, false);
                        bw[0] = (u32x2_){sx[0], sy[0]}; bw[1] = (u32x2_){sx[1], sy[1]}; }
                    u32x2_ pk[2];
#pragma unroll
                    for (int n = 0; n < 2; ++n) { const int col = col0 + bj * HALF + n * 16; f32x4 b;
                        if constexpr (BASE_F32) b = raw[d][bj][n];
                        else { const u32x2_ w = bw[n]; b = (f32x4){__uint_as_float(w.x << 16), __uint_as_float(w.x & 0xffff0000u), __uint_as_float(w.y << 16), __uint_as_float(w.y & 0xffff0000u)}; }
                        f32x4 av = acc[ai][bj][m][n];
                        if (I8A) { const i32x4 iv = __builtin_bit_cast(i32x4, av); av = (f32x4){(float)iv[0], (float)iv[1], (float)iv[2], (float)iv[3]} * rs; }
                        f32x4 o = b + gv[bj][n] * av;
#ifdef PROBE_YSCALE
                        if (OUT_F32) o = o * PROBE_YSCALE;
#endif
                        if (OUT_F32) *(f32x4*)((float*)out + (size_t)row * EP_D + col) = o;
                        else pk[n] = (u32x2_){cvt_pk_bf16(o[0], o[1]), cvt_pk_bf16(o[2], o[3])}; }
                    if constexpr (!OUT_F32) { const auto sx = __builtin_amdgcn_permlane16_swap(pk[0].x, pk[1].x, false, false), sy = __builtin_amdgcn_permlane16_swap(pk[0].y, pk[1].y, false, false);
                        *(u32x4_*)((bf16_t*)out + (size_t)row * opitch + wcol + bj * HALF) = (u32x4_){sx[0], sy[0], sx[1], sy[1]}; } } }
        }
    }
};
template <bool I8, int WHICH> struct EpiProj {
    static constexpr bool PERM = true, AFTER_DRAIN = false;
    bf16_t* dst; float* gates; const float* sa; const float* sb;
    __device__ __forceinline__ void operator()(const f32x4 (&acc)[2][2][4][2], const Unit& u, int wr, int wc, int fr, int fq) const {
        const int row0 = u.pm * BM + wr * 64 + fr;
        if (!I8 && WHICH == 1 && u.pn == 16) {
            if (wc == 0) {
#pragma unroll
                for (int ai = 0; ai < 2; ++ai)
#pragma unroll
                    for (int m = 0; m < 4; ++m) { float* gp = gates + (size_t)(row0 + ai * HALF + m * 16) * 32 + 8 * fq; *(f32x4*)gp = acc[ai][0][m][0]; *(f32x4*)(gp + 4) = acc[ai][0][m][1]; }
            }
            return;
        }
        bf16_t* base; int pitch;
        if (WHICH == 0) { pitch = 5120; base = dst + (I8 ? (u.pn < 4 ? 256 * u.pn : 3072 + 256 * (u.pn - 4)) : 1024 + 256 * u.pn); }
        else { pitch = EP_D; base = dst + (size_t)(I8 ? (u.pn < 8 ? 0 : 3) : 1 + (u.pn >> 3)) * ((size_t)EP_M * EP_D) + 256 * (u.pn & 7); }
        const int col0 = wc * 32 + 8 * fq, brow = u.pn * BM + wc * 32 + 8 * fq;
        f32x4 sc[2][2]; float sr[2][4];
        if (I8) {
#pragma unroll
            for (int ai = 0; ai < 2; ++ai)
#pragma unroll
                for (int m = 0; m < 4; ++m) sr[ai][m] = sa[row0 + ai * HALF + m * 16];
#pragma unroll
            for (int bj = 0; bj < 2; ++bj) { sc[bj][0] = *(const f32x4*)(sb + brow + bj * HALF); sc[bj][1] = *(const f32x4*)(sb + brow + bj * HALF + 4); } }
#pragma unroll
        for (int ai = 0; ai < 2; ++ai)
#pragma unroll
            for (int m = 0; m < 4; ++m) { const int row = row0 + ai * HALF + m * 16; bf16_t* rowp = base + (size_t)row * pitch + col0; const float s = I8 ? sr[ai][m] : 1.0f;
#pragma unroll
                for (int bj = 0; bj < 2; ++bj) { f32x4 v0, v1;
                    if (I8) { const i32x4 i0 = __builtin_bit_cast(i32x4, acc[ai][bj][m][0]), i1 = __builtin_bit_cast(i32x4, acc[ai][bj][m][1]);
                        v0 = (f32x4){(float)i0[0], (float)i0[1], (float)i0[2], (float)i0[3]} * sc[bj][0] * s; v1 = (f32x4){(float)i1[0], (float)i1[1], (float)i1[2], (float)i1[3]} * sc[bj][1] * s; }
                    else { v0 = acc[ai][bj][m][0]; v1 = acc[ai][bj][m][1]; }
                    u32x4 w; w.x = cvt_pk_bf16(v0[0], v0[1]); w.y = cvt_pk_bf16(v0[2], v0[3]); w.z = cvt_pk_bf16(v1[0], v1[1]); w.w = cvt_pk_bf16(v1[2], v1[3]);
                    *(u32x4*)(rowp + bj * HALF) = w; } }
    }
};

template <class Epi, class Sched, bool ALIGN_EPI = false, bool SP2 = false, int MODE = 0  >
__device__ __forceinline__ void gemm_phase(PG8_LAS unsigned char* lds, const Gemm g, const Sched& S, const Epi& E) {
    int tid_ = threadIdx.x; asm volatile("" : "+v"(tid_));
    const int tid = tid_, wid = __builtin_amdgcn_readfirstlane(tid >> 6), lane = tid & 63, wr = wid >> 2, wc = wid & 3, fr = lane & 15, fq = lane >> 4;
    const int K = g.K, nt = K / BK;
    unsigned voffA[2], voffB[2];
#pragma unroll
    for (int i = 0; i < 2; ++i) { int R, C; stage_rc(tid * 16 + i * 8192, R, C); const int Rb = Epi::PERM ? ((R & ~31) + perm32(R & 31)) : R;
        voffA[i] = (unsigned)(R * K + C) * 2u; voffB[i] = (unsigned)(Rb * K + C) * 2u; }
    const size_t kstep = (size_t)(BK * 2);
    const size_t hstep = (size_t)HALF * K * 2;
    const size_t tstep = 2 * hstep;
    const unsigned ldsw = (unsigned)wid * 1024u;
    const int aoff = lds_byte(wr * 64 + fr, fq * 8), boff = lds_byte(wc * 32 + fr, fq * 8);
#define PG8_SA(b, h) (((b) * 2 + (h)) * HTB)
#define PG8_SB(b, h) ((4 + (b) * 2 + (h)) * HTB)
#define PG8_STAGE(bufoff, gbase, voff) do { _Pragma("unroll") for (int _i = 0; _i < 2; ++_i) \
        __builtin_amdgcn_global_load_lds((const unsigned*)((const char*)(gbase) + (voff)[_i]), (PG8_LAS unsigned*)(lds + (bufoff) + ldsw + _i * 8192), 16, 0, 0); } while (0)
#define PG8_LDA(dst, b, h) do { if constexpr (MODE == 2) { _Pragma("unroll") for (int m = 0; m < 4; ++m) { const i32x4 lo_ = *(const PG8_LAS i32x4*)(lds + PG8_SA(b, h) + aoff + m * 2048), hi_ = *(const PG8_LAS i32x4*)(lds + PG8_SA(b, h) + aoff + m * 2048 + 1024); dst##8[m] = __builtin_shufflevector(lo_, hi_, 0, 1, 2, 3, 4, 5, 6, 7); } } \
        else { _Pragma("unroll") for (int m = 0; m < 4; ++m) _Pragma("unroll") for (int k = 0; k < 2; ++k) dst[m][k] = *(const PG8_LAS bf16x8*)(lds + PG8_SA(b, h) + aoff + m * 2048 + k * 1024); } } while (0)
#define PG8_LDB(dst, b, h) do { if constexpr (MODE == 2) { _Pragma("unroll") for (int n = 0; n < 2; ++n) { const i32x4 lo_ = *(const PG8_LAS i32x4*)(lds + PG8_SB(b, h) + boff + n * 2048), hi_ = *(const PG8_LAS i32x4*)(lds + PG8_SB(b, h) + boff + n * 2048 + 1024); dst##8[n] = __builtin_shufflevector(lo_, hi_, 0, 1, 2, 3, 4, 5, 6, 7); } } \
        else { _Pragma("unroll") for (int n = 0; n < 2; ++n) _Pragma("unroll") for (int k = 0; k < 2; ++k) dst[n][k] = *(const PG8_LAS bf16x8*)(lds + PG8_SB(b, h) + boff + n * 2048 + k * 1024); } } while (0)
#define PG8_MMA(ai, bj, At, Bt) do { __builtin_amdgcn_s_setprio(1); _Pragma("unroll") for (int m = 0; m < 4; ++m) _Pragma("unroll") for (int n = 0; n < 2; ++n) { \
        if constexpr (MODE == 0) { _Pragma("unroll") for (int k = 0; k < 2; ++k) acc[ai][bj][m][n] = __builtin_amdgcn_mfma_f32_16x16x32_bf16(Bt[n][k], At[m][k], acc[ai][bj][m][n], 0, 0, 0); } \
        else if constexpr (MODE == 1) { _Pragma("unroll") for (int k = 0; k < 2; ++k) acc[ai][bj][m][n] = __builtin_bit_cast(f32x4, __builtin_amdgcn_mfma_i32_16x16x64_i8(__builtin_bit_cast(i32x4, Bt[n][k]), __builtin_bit_cast(i32x4, At[m][k]), __builtin_bit_cast(i32x4, acc[ai][bj][m][n]), 0, 0, 0)); } \
        else { asm volatile("v_mfma_f32_16x16x128_f8f6f4 %0, %1, %2, %0" : "+v"(acc[ai][bj][m][n]) : "v"(Bt##8[n]), "v"(At##8[m])); } } \
        __builtin_amdgcn_s_setprio(0); } while (0)
#define PG8_WAIT_V(n) asm volatile("s_waitcnt vmcnt(" #n ")" ::: "memory")
#define PG8_WAIT_L(n) asm volatile("s_waitcnt lgkmcnt(" #n ")" ::: "memory")
#define PG8_BAR __builtin_amdgcn_s_barrier()
#define PG8_SCHED __builtin_amdgcn_sched_barrier(0)
    Unit cur, nxt; int ui = 0;
    if (!S.next(0, cur)) return;
    f32x4 acc[2][2][4][2];
#pragma unroll
    for (int a = 0; a < 2; ++a)
#pragma unroll
        for (int b = 0; b < 2; ++b)
#pragma unroll
            for (int m = 0; m < 4; ++m)
#pragma unroll
                for (int n = 0; n < 2; ++n) acc[a][b][m][n] = (f32x4){0.f, 0.f, 0.f, 0.f};
    bf16x8 At[4][2], B0[2][2], B1[2][2]; i32x8 At8[4], B08[2], B18[2];
    const char* cA = (const char*)g.A + (size_t)cur.pm * tstep; const char* cB = (const char*)g.Bt + (size_t)cur.pn * tstep;
    S.a_ready(cur);
    if constexpr (SP2) {
        PG8_STAGE(PG8_SB(0, 0), cB, voffB); PG8_STAGE(PG8_SB(0, 1), cB + hstep, voffB); PG8_STAGE(PG8_SA(0, 0), cA, voffA); PG8_STAGE(PG8_SA(0, 1), cA + hstep, voffA);
        if (wr == 1) PG8_BAR;
        PG8_WAIT_V(2); PG8_BAR;
        PG8_STAGE(PG8_SB(1, 0), cB + kstep, voffB); PG8_STAGE(PG8_SA(1, 0), cA + kstep, voffA); PG8_STAGE(PG8_SB(1, 1), cB + hstep + kstep, voffB);
        PG8_WAIT_V(6); PG8_BAR;
    } else {
        PG8_STAGE(PG8_SB(0, 0), cB, voffB); PG8_STAGE(PG8_SA(0, 0), cA, voffA); PG8_STAGE(PG8_SB(0, 1), cB + hstep, voffB); PG8_STAGE(PG8_SA(0, 1), cA + hstep, voffA);
        if (wr == 1) PG8_BAR;
        PG8_WAIT_V(4); PG8_BAR;
        PG8_STAGE(PG8_SB(1, 0), cB + kstep, voffB); PG8_STAGE(PG8_SA(1, 0), cA + kstep, voffA); PG8_STAGE(PG8_SB(1, 1), cB + hstep + kstep, voffB);
        PG8_WAIT_V(6); PG8_BAR;
    }
    for (;;) {
        const bool has_next = S.next(ui + 1, nxt);
        const char* nA = has_next ? (const char*)g.A + (size_t)nxt.pm * tstep : cA; const char* nB = has_next ? (const char*)g.Bt + (size_t)nxt.pn * tstep : cB;
        for (int t = 0; t < nt; t += 2) {
            const bool last = (t == nt - 2);
            const char* a1 = cA + (size_t)(t + 1) * kstep;
            const char* a2 = last ? nA : cA + (size_t)(t + 2) * kstep; const char* b2 = last ? nB : cB + (size_t)(t + 2) * kstep;
            const char* a3 = a2 + kstep; const char* b3 = b2 + kstep;
            if (last && has_next) S.a_ready(nxt);
            if constexpr (SP2) {
            PG8_LDB(B0, 0, 0); PG8_LDB(B1, 0, 1); PG8_SCHED; PG8_LDA(At, 0, 0); PG8_STAGE(PG8_SA(1, 1), a1 + hstep, voffA);
            PG8_WAIT_V(8); PG8_WAIT_L(0); PG8_BAR; PG8_MMA(0, 0, At, B0); PG8_MMA(0, 1, At, B1); PG8_BAR; PG8_SCHED;
            PG8_LDA(At, 0, 1); PG8_STAGE(PG8_SB(0, 0), b2, voffB); PG8_STAGE(PG8_SB(0, 1), b2 + hstep, voffB); PG8_STAGE(PG8_SA(0, 0), a2, voffA);
            PG8_WAIT_V(8); PG8_WAIT_L(0); PG8_BAR; PG8_MMA(1, 0, At, B0); PG8_MMA(1, 1, At, B1); PG8_BAR; PG8_SCHED;
            PG8_LDB(B0, 1, 0); PG8_LDB(B1, 1, 1); PG8_SCHED; PG8_LDA(At, 1, 0); PG8_STAGE(PG8_SA(0, 1), a2 + hstep, voffA);
            PG8_WAIT_V(8); PG8_WAIT_L(0); PG8_BAR; PG8_MMA(0, 0, At, B0); PG8_MMA(0, 1, At, B1); PG8_BAR; PG8_SCHED;
            PG8_LDA(At, 1, 1); PG8_STAGE(PG8_SB(1, 0), b3, voffB); PG8_STAGE(PG8_SB(1, 1), b3 + hstep, voffB); PG8_STAGE(PG8_SA(1, 0), a3, voffA);
            PG8_WAIT_V(8); PG8_WAIT_L(0); PG8_BAR; PG8_MMA(1, 0, At, B0); PG8_MMA(1, 1, At, B1); PG8_BAR; PG8_SCHED;
            } else {
            PG8_LDB(B0, 0, 0); PG8_SCHED; PG8_LDA(At, 0, 0); PG8_STAGE(PG8_SA(1, 1), a1 + hstep, voffA);
            PG8_WAIT_L(8); PG8_BAR; PG8_WAIT_L(0); PG8_MMA(0, 0, At, B0); PG8_BAR; PG8_SCHED;
            PG8_LDB(B1, 0, 1); PG8_STAGE(PG8_SB(0, 0), b2, voffB);
            PG8_BAR; PG8_WAIT_L(0); PG8_MMA(0, 1, At, B1); PG8_BAR;
            PG8_LDA(At, 0, 1); PG8_STAGE(PG8_SA(0, 0), a2, voffA);
            PG8_BAR; PG8_WAIT_L(0); PG8_MMA(1, 0, At, B0); PG8_BAR; PG8_SCHED;
            PG8_STAGE(PG8_SB(0, 1), b2 + hstep, voffB);
            PG8_WAIT_V(6); PG8_BAR; PG8_MMA(1, 1, At, B1); PG8_BAR;
            PG8_LDB(B0, 1, 0); PG8_SCHED; PG8_LDA(At, 1, 0); PG8_STAGE(PG8_SA(0, 1), a2 + hstep, voffA);
            PG8_WAIT_L(8); PG8_BAR; PG8_WAIT_L(0); PG8_MMA(0, 0, At, B0); PG8_BAR; PG8_SCHED;
            PG8_LDB(B1, 1, 1); PG8_STAGE(PG8_SB(1, 0), b3, voffB);
            PG8_BAR; PG8_WAIT_L(0); PG8_MMA(0, 1, At, B1); PG8_BAR;
            PG8_LDA(At, 1, 1); PG8_STAGE(PG8_SA(1, 0), a3, voffA);
            PG8_BAR; PG8_WAIT_L(0); PG8_MMA(1, 0, At, B0); PG8_BAR; PG8_SCHED;
            PG8_STAGE(PG8_SB(1, 1), b3 + hstep, voffB);
            PG8_WAIT_V(6); PG8_BAR; PG8_MMA(1, 1, At, B1); PG8_BAR;
            }
        }
        if constexpr (MODE == 2) asm volatile("s_nop 15\n\ts_nop 15" ::: "memory");
        if constexpr (ALIGN_EPI) { if (wr == 0) PG8_BAR; }
        if constexpr (!Epi::AFTER_DRAIN) { E(acc, cur, wr, wc, fr, fq); S.done(cur); }
        if (!has_next) break;
#pragma unroll
        for (int a = 0; a < 2; ++a)
#pragma unroll
            for (int b = 0; b < 2; ++b)
#pragma unroll
                for (int m = 0; m < 4; ++m)
#pragma unroll
                    for (int n = 0; n < 2; ++n) acc[a][b][m][n] = (f32x4){0.f, 0.f, 0.f, 0.f};
        cur = nxt; cA = nA; cB = nB; ++ui;
        if constexpr (ALIGN_EPI) { if (wr == 1) PG8_BAR; }
    }
    PG8_WAIT_V(0);
    if constexpr (!ALIGN_EPI) { if (wr == 0) PG8_BAR; }
    PG8_BAR;
    if constexpr (Epi::AFTER_DRAIN) { E.fused(acc, cur, wr, wc, fr, fq, lds, wid, lane); S.done(cur); }
#undef PG8_SA
#undef PG8_SB
#undef PG8_STAGE
#undef PG8_LDA
#undef PG8_LDB
#undef PG8_MMA
#undef PG8_WAIT_V
#undef PG8_WAIT_L
#undef PG8_BAR
#undef PG8_SCHED
}
}

#ifndef PG8_SP2
#define PG8_SP2 true
#endif
#ifndef PG8_ALIGN
#define PG8_ALIGN true
#endif
#define GAS __attribute__((address_space(1)))
#define LAS __attribute__((address_space(3)))
typedef unsigned short bf16;
typedef unsigned v4u __attribute__((ext_vector_type(4)));
typedef unsigned v2u __attribute__((ext_vector_type(2)));
typedef float f32x4 __attribute__((ext_vector_type(4)));
typedef short bf16x8 __attribute__((ext_vector_type(8)));
#define LDS_WAIT() asm volatile("s_waitcnt lgkmcnt(0)" ::: "memory")
#define VM_WAIT() asm volatile("s_waitcnt vmcnt(0)" ::: "memory")
#define MFMA16(a, b, c) __builtin_amdgcn_mfma_f32_16x16x32_bf16((a), (b), (c), 0, 0, 0)

constexpr int NWAVES = 8, NTHR = 512;
constexpr int DM = 2048, MP = 4096, MS = 32768, MT = 36864, DFF = 5632, MODS = 9 * 2048;
constexpr float EPS = 1e-6f;
constexpr int N_PHASES = 24;
#ifndef MK_ONE_LAUNCH
#define MK_ONE_LAUNCH 1
#endif
constexpr size_t MiB = 1u << 20;
constexpr size_t WS_CTL = 0, CTL_ZERO_BYTES = 32768;
constexpr size_t WS_MOD = 1 * MiB, WS_ROPE = 3 * MiB, WS_LW = 4 * MiB, WS_KC = 5 * MiB, WS_VCT = 13 * MiB, WS_SUMW = 21 * MiB, WS_SUMB = 39 * MiB, WS_GATES = 42 * MiB;
constexpr size_t WS_W1A = 48 * MiB, WS_W2A = 92 * MiB, WS_W1B = 114 * MiB, WS_W2B = 158 * MiB, WS_WINAB = 180 * MiB, WS_WOUTAB = 200 * MiB, WS_WINC = 208 * MiB, WS_WOUTC = 241 * MiB;
constexpr size_t WS_H = 256 * MiB, WS_BIG = 400 * MiB;
constexpr size_t WS_ACT = WS_BIG;
constexpr size_t WS_Z = WS_BIG, WS_VTS = 760 * MiB, WS_VTP = 824 * MiB;
constexpr size_t WS_PL = WS_BIG, WS_KT = 976 * MiB, WS_HB = 1120 * MiB;
constexpr size_t WS_END = 1264 * MiB;
constexpr size_t WS_XB2 = 656 * MiB;
constexpr int XPITCH = 4096;
constexpr size_t WS_SA = 3 * MiB + 65536, WS_SB1 = 3 * MiB + 262144, WS_SB2 = 3 * MiB + 393216;
constexpr size_t WS_H8M = 1120 * MiB;
constexpr size_t WS_WQAB = 70 * MiB, WS_WQC = 76 * MiB;
constexpr size_t WS_SBQAB = 3 * MiB + 458752, WS_SBQC = 3 * MiB + 475136, WS_SBOC = 3 * MiB + 491520;
constexpr size_t WS_WQOC = 84 * MiB;
constexpr size_t PLANE = (size_t)MT * DM;
constexpr int CW_BAR = 4096;
constexpr int SCR_BYTES = 147456, MISC_OFF = SCR_BYTES, LDS_BYTES = SCR_BYTES + 256;

__device__ __forceinline__ float bf2f(unsigned short b) { return __uint_as_float(((unsigned)b) << 16); }
__device__ __forceinline__ unsigned f2bf(float f) { unsigned u = __float_as_uint(f); return (u + 0x7fffu + ((u >> 16) & 1u)) >> 16; }
typedef float f32x2c_t __attribute__((ext_vector_type(2))); typedef __bf16 bf16x2c_t __attribute__((ext_vector_type(2)));
__device__ __forceinline__ unsigned pk2(float lo, float hi) { const f32x2c_t v = {lo, hi}; return __builtin_bit_cast(unsigned, __builtin_convertvector(v, bf16x2c_t)); }
typedef unsigned u32x2s __attribute__((ext_vector_type(2)));
__device__ __forceinline__ float rows_max(float v) { u32x2s r = __builtin_amdgcn_permlane16_swap(__float_as_uint(v), __float_as_uint(v), false, false); v = fmaxf(__uint_as_float(r.x), __uint_as_float(r.y));
    r = __builtin_amdgcn_permlane32_swap(__float_as_uint(v), __float_as_uint(v), false, false); return fmaxf(__uint_as_float(r.x), __uint_as_float(r.y)); }
__device__ __forceinline__ float rows_sum(float v) { u32x2s r = __builtin_amdgcn_permlane16_swap(__float_as_uint(v), __float_as_uint(v), false, false); v = __uint_as_float(r.x) + __uint_as_float(r.y);
    r = __builtin_amdgcn_permlane32_swap(__float_as_uint(v), __float_as_uint(v), false, false); return __uint_as_float(r.x) + __uint_as_float(r.y); }
#define DPP_MOV(v, ctrl) __builtin_bit_cast(float, __builtin_amdgcn_update_dpp(0, __builtin_bit_cast(int, (v)), (ctrl), 0xf, 0xf, true))
__device__ __forceinline__ float wave_sum(float v) { v += DPP_MOV(v, 0xB1); v += DPP_MOV(v, 0x4E); v += DPP_MOV(v, 0x141); v += DPP_MOV(v, 0x140); return rows_sum(v); }
__device__ __forceinline__ float wave_max(float v) { v = fmaxf(v, DPP_MOV(v, 0xB1)); v = fmaxf(v, DPP_MOV(v, 0x4E)); v = fmaxf(v, DPP_MOV(v, 0x141)); v = fmaxf(v, DPP_MOV(v, 0x140)); return rows_max(v); }
__device__ __forceinline__ int set_of_row(int m) { return m < MP ? 0 : 1 + ((m - MP) >> 12); }
__device__ __forceinline__ float sigmoidf_(float x) { return __builtin_amdgcn_rcpf(1.0f + __expf(-x)); }

#define XB_TMO      128
#define XB_XCNT(j)  (256  + 64 * (j))
#define XB_XSUB(j)  (1280 + 64 * (j))
#define XB_XGEN(j)  (2304 + 64 * (j))
#define XB_TOP      3328
#define XB_TOPGEN   3392
#define XCD_BAR_WORDS 3456
#define XB_SPIN_CAP (1u << 18)

__device__ __forceinline__ unsigned xb_ld(unsigned* p)              { return __hip_atomic_load(p, __ATOMIC_RELAXED, __HIP_MEMORY_SCOPE_AGENT); }
__device__ __forceinline__ unsigned xb_add(unsigned* p, unsigned v) { return __hip_atomic_fetch_add(p, v, __ATOMIC_RELAXED, __HIP_MEMORY_SCOPE_AGENT); }
__device__ __forceinline__ unsigned xb_xcc_id() { return (unsigned)__builtin_amdgcn_s_getreg((3 << 11) | 20) & 0xFu; }
#define XB_SPIN(cond, bar) do { unsigned _sp = 0; while (cond) { __builtin_amdgcn_s_sleep(1); \
    if ((++_sp & 255u) == 0u) { if (xb_ld(&(bar)[XB_TMO])) break; if (_sp > XB_SPIN_CAP) { atomicAdd(&(bar)[XB_TMO], 1u); break; } } } } while (0)

struct XcdBarrier {
    unsigned* bar; unsigned x;
    volatile LAS unsigned* st;
};

__device__ __forceinline__ XcdBarrier xcd_barrier_post(unsigned* bar, volatile LAS unsigned* st) {
    XcdBarrier b; b.bar = bar; b.x = xb_xcc_id(); b.st = st;
    if (threadIdx.x == 0) (void)xb_add(&bar[XB_XCNT(b.x)], 1u);
    return b;
}
__device__ __forceinline__ void xcd_barrier_complete(unsigned* bar, unsigned x, unsigned& nloc, unsigned& nx) {
    const unsigned G = gridDim.x * gridDim.y * gridDim.z;
    unsigned sum, cnt, mine, sp = 0u;
    for (;;) {
        sum = 0u; cnt = 0u; mine = 0u;
#pragma unroll
        for (unsigned j = 0; j < 16; ++j) { const unsigned c = xb_ld(&bar[XB_XCNT(j)]); sum += c; cnt += (c > 0u) ? 1u : 0u; mine = (j == x) ? c : mine; }
        if (sum == G) break;
        __builtin_amdgcn_s_sleep(1);
        if ((++sp & 255u) == 0u) { if (xb_ld(&bar[XB_TMO])) break; if (sp > XB_SPIN_CAP) { atomicAdd(&bar[XB_TMO], 1u); break; } }
    }
    nloc = mine > 0u ? mine : 1u; nx = cnt > 0u ? cnt : 1u;
}

__device__ __forceinline__ void xcd_barrier(const XcdBarrier& b) {
    asm volatile("s_waitcnt vmcnt(0)" ::: "memory");
    __syncthreads();
    if (threadIdx.x == 0) {
        unsigned* bar = b.bar;
        __builtin_amdgcn_s_waitcnt(0);
        unsigned nloc = b.st[0], nx = b.st[1];
        if (nloc == 0u) { xcd_barrier_complete(bar, b.x, nloc, nx); b.st[0] = nloc; b.st[1] = nx; }
        const unsigned old = xb_add(&bar[XB_XSUB(b.x)], 1u);
        const unsigned gen = old / nloc;
        if (old + 1u == (gen + 1u) * nloc) {
            __builtin_amdgcn_fence(__ATOMIC_RELEASE, "agent");
            asm volatile("s_waitcnt vmcnt(0)" ::: "memory");
            const unsigned og = xb_add(&bar[XB_TOP], 1u);
            const unsigned tg = og / nx;
            if (og + 1u == (tg + 1u) * nx) xb_add(&bar[XB_TOPGEN], 1u);
            else XB_SPIN(xb_ld(&bar[XB_TOPGEN]) == tg, bar);
            __builtin_amdgcn_fence(__ATOMIC_ACQUIRE, "agent");
            xb_add(&bar[XB_XGEN(b.x)], 1u);
            asm volatile("s_waitcnt vmcnt(0)" ::: "memory");
        } else {
            XB_SPIN(xb_ld(&bar[XB_XGEN(b.x)]) == gen, bar);
            __builtin_amdgcn_fence(__ATOMIC_ACQUIRE, "agent");
            asm volatile("s_waitcnt vmcnt(0)" ::: "memory");
        }
    }
    __syncthreads();
}


struct Args { const float* in[32]; float* out; unsigned char* ws; int ph_lo, ph_hi; };

__device__ __forceinline__ void xpose_sub(const float* src, int ldw, bf16* dst, int K, int k0, bool zero, LAS float* scr, int lane, float wsc = 1.0f) {
    const int c = lane & 7;
    if (zero) {
#pragma unroll
        for (int j = 0; j < 4; ++j) { const int n = (lane >> 3) + 8 * j; *(v4u*)(dst + (size_t)n * K + k0 + 8 * c) = (v4u){0u, 0u, 0u, 0u}; }
        return;
    }
    { float t32[32]; const float* p = src + (size_t)(k0 + (lane >> 5)) * ldw + (lane & 31);
#pragma unroll
      for (int i = 0; i < 32; ++i) t32[i] = p[(size_t)(2 * i) * ldw];
#pragma unroll
      for (int i = 0; i < 32; ++i) scr[(2 * i + (lane >> 5)) * 33 + (lane & 31)] = t32[i]; }
    LDS_WAIT(); asm volatile("" ::: "memory");
#pragma unroll
    for (int j = 0; j < 4; ++j) { const int n = (lane >> 3) + 8 * j; const LAS float* s = scr + (8 * c) * 33 + n;
        v4u o; o.x = pk2(s[0 * 33] * wsc, s[1 * 33] * wsc); o.y = pk2(s[2 * 33] * wsc, s[3 * 33] * wsc); o.z = pk2(s[4 * 33] * wsc, s[5 * 33] * wsc); o.w = pk2(s[6 * 33] * wsc, s[7 * 33] * wsc);
        *(v4u*)(dst + (size_t)n * K + k0 + 8 * c) = o; }
    LDS_WAIT(); asm volatile("" ::: "memory");
}
__device__ __forceinline__ void xpose_run(const float* s0, const float* s1, bf16* dst, int ldw, int K, int nblk, int mode, int sub, LAS float* scr, int lane) {
    const int kb = sub / nblk, nb = sub - kb * nblk, n0 = nb * 32;
    const float* sp; bool zero = false;
    if (mode == 1) { const int pn = n0 >> 8, r = n0 & 255; sp = (r < 128 ? s0 : s1) + pn * 128 + (r & 127); }
    else { sp = s0 + n0; if (mode == 2 && n0 >= 8224) zero = true; }
    xpose_sub(sp, ldw, dst + (size_t)n0 * K, K, kb * 64, zero, scr, lane);
}
template <int FMT>
__device__ __forceinline__ void quant_item(const float* sp, int ldw, int K, unsigned char* dst  , float* sbv  , LAS unsigned char* lds, int wave, int lane, int tid) {
    LAS float* scr = (LAS float*)(lds + wave * 8448); LAS float* pm = (LAS float*)(lds + 67584);
    const int kper = K >> 3, nsub = kper >> 6, kbase = wave * kper;
    const float QMAX = FMT == 1 ? 127.0f : 240.0f;
    float mx = 0.f;
    for (int st = 0; st < nsub; ++st) { const float* p = sp + (size_t)(kbase + 64 * st + (lane >> 5)) * ldw + (lane & 31);
        float t32[32];
#pragma unroll
        for (int i = 0; i < 32; ++i) t32[i] = p[(size_t)(2 * i) * ldw];
#pragma unroll
        for (int i = 0; i < 32; ++i) mx = fmaxf(mx, fabsf(t32[i])); }
    mx = fmaxf(mx, __shfl_xor(mx, 32));
    if (lane < 32) pm[wave * 32 + lane] = mx;
    __syncthreads();
    float inv[4];
#pragma unroll
    for (int j = 0; j < 4; ++j) { const int n = (lane >> 3) + 8 * j; float m = pm[n];
#pragma unroll
        for (int w = 1; w < 8; ++w) m = fmaxf(m, pm[w * 32 + n]);
        inv[j] = m > 0.f ? QMAX / m : 0.f; }
    if (tid < 32) { float m = pm[tid];
#pragma unroll
        for (int w = 1; w < 8; ++w) m = fmaxf(m, pm[w * 32 + tid]);
        sbv[tid] = m / QMAX; }
    const int c = lane & 7;
    for (int st = 0; st < nsub; ++st) { const int k0 = kbase + 64 * st;
        { float t32[32]; const float* p = sp + (size_t)(k0 + (lane >> 5)) * ldw + (lane & 31);
#pragma unroll
          for (int i = 0; i < 32; ++i) t32[i] = p[(size_t)(2 * i) * ldw];
#pragma unroll
          for (int i = 0; i < 32; ++i) scr[(2 * i + (lane >> 5)) * 33 + (lane & 31)] = t32[i]; }
        LDS_WAIT(); asm volatile("" ::: "memory");
#pragma unroll
        for (int j = 0; j < 4; ++j) { const int n = (lane >> 3) + 8 * j; const LAS float* s = scr + (8 * c) * 33 + n; float v[8];
#pragma unroll
            for (int e = 0; e < 8; ++e) v[e] = s[e * 33] * inv[j];
            v2u o;
            if (FMT == 1) { int q[8];
#pragma unroll
                for (int e = 0; e < 8; ++e) q[e] = (int)rintf(v[e]) & 0xff;
                o.x = (unsigned)(q[0] | (q[1] << 8) | (q[2] << 16) | (q[3] << 24)); o.y = (unsigned)(q[4] | (q[5] << 8) | (q[6] << 16) | (q[7] << 24)); }
            else { o.x = pg8::pk4_fp8(v[0], v[1], v[2], v[3]); o.y = pg8::pk4_fp8(v[4], v[5], v[6], v[7]); }
            *(v2u*)(dst + (size_t)n * K + k0 + 8 * c) = o; }
        LDS_WAIT(); asm volatile("" ::: "memory"); }
    __syncthreads();
}
__device__ __forceinline__ void ffn_quant_item(const Args& a, int l, int f, int slot, int item, LAS unsigned char* lds, int wave, int lane, int tid) {
    const size_t wo = (size_t)(l * 2 + f) * DM * DFF;
    if (item < 352) { const int n0 = 32 * item, pn = n0 >> 8, r = n0 & 255; const float* sp = (r < 128 ? a.in[13] : a.in[14]) + wo + pn * 128 + (r & 127);
        quant_item<1>(sp, DFF, DM, a.ws + (slot ? WS_W1B : WS_W1A) + (size_t)n0 * DM, (float*)(a.ws + WS_SB1) + slot * 11264 + n0, lds, wave, lane, tid); }
    else { const int n0 = 32 * (item - 352);
        quant_item<2>(a.in[15] + wo + n0, DM, DFF, a.ws + (slot ? WS_W2B : WS_W2A) + (size_t)n0 * DFF, (float*)(a.ws + WS_SB2) + slot * 2048 + n0, lds, wave, lane, tid); }
}
__device__ __forceinline__ void mod_item(const Args& a, int item, float* MOD, LAS unsigned char* lds, int wave, int lane, int tid) {
    const int l = item / 144, cb = item % 144;
    LAS float* sil = (LAS float*)(lds + wave * 9216);
    LAS float* part = (LAS float*)(lds + 73728);
    const float* cvec = a.in[8]; const float* cctx = a.in[9];
    for (int i = lane; i < 9 * 256; i += 64) { const int s = i >> 8, kk = i & 255, k = wave * 256 + kk; const float c = s == 0 ? cctx[k] : cvec[(s - 1) * DM + k]; sil[i] = c * sigmoidf_(c); }
    LDS_WAIT(); asm volatile("" ::: "memory");
    typedef float f32x2 __attribute__((ext_vector_type(2)));
    f32x2 acc[9];
#pragma unroll
    for (int s = 0; s < 9; ++s) acc[s] = (f32x2){0.f, 0.f};
    const float* wp = a.in[10] + ((size_t)l * DM + wave * 256) * (9 * DM) + cb * 128 + 2 * lane;
    for (int k16 = 0; k16 < 16; ++k16) {
        f32x2 w[16];
#pragma unroll
        for (int j = 0; j < 16; ++j) w[j] = *(const f32x2*)(wp + (size_t)(16 * k16 + j) * (9 * DM));
#pragma unroll
        for (int s = 0; s < 9; ++s) {
#pragma unroll
            for (int q = 0; q < 4; ++q) { const f32x4 c = *(const LAS f32x4*)(sil + s * 256 + 16 * k16 + 4 * q);
                acc[s] += w[4 * q] * c[0]; acc[s] += w[4 * q + 1] * c[1]; acc[s] += w[4 * q + 2] * c[2]; acc[s] += w[4 * q + 3] * c[3]; } }
    }
#pragma unroll
    for (int s = 0; s < 9; ++s) *(LAS f32x2*)(part + (wave * 9 + s) * 128 + 2 * lane) = acc[s];
    __syncthreads();
    for (int i = tid; i < 9 * 128; i += NTHR) { const int s = i >> 7, col = i & 127; float v = a.in[11][l * (9 * DM) + cb * 128 + col];
#pragma unroll
        for (int w = 0; w < 8; ++w) v += part[(w * 9 + s) * 128 + col];
        MOD[((size_t)l * 9 + s) * MODS + cb * 128 + col] = v; }
    __syncthreads();
}
__device__ __forceinline__ void tail_ids(int nwg, int G, int& ib, int& nidle) { const int rem = nwg % G, c = (int)blockIdx.x; if (rem == 0) { ib = c; nidle = G; } else if (c >= rem) { ib = c - rem; nidle = G - rem; } else { ib = -1; nidle = G - rem; } }
constexpr int P0_ITEMS = 3040;
__device__ __forceinline__ void p0_item(const Args& a, int it, LAS unsigned char* lds, int wave, int lane, int tid) {
    unsigned char* ws = a.ws; LAS float* scr = (LAS float*)(lds + wave * 8448);
    int r = it;
    if (r < 128) { ffn_quant_item(a, 0, r >> 6, r >> 6, 352 + (r & 63), lds, wave, lane, tid); return; } r -= 128;
    if (r < 288) { mod_item(a, r, (float*)(ws + WS_MOD), lds, wave, lane, tid); return; } r -= 288;
    if (r < 704) { const int f = r >= 352 ? 1 : 0; ffn_quant_item(a, 0, f, f, r - 352 * f, lds, wave, lane, tid); return; } r -= 704;
    if (r < 128) { const int n0 = 32 * r; const int col = n0 < 2048 ? n0 : 6144 + (n0 - 2048);
        quant_item<1>(a.in[28] + col, 8224, DM, ws + WS_WQC + (size_t)n0 * DM, (float*)(ws + WS_SBQC) + n0, lds, wave, lane, tid); return; } r -= 128;
    if (r < 64) { const int n0 = 32 * r; quant_item<1>(a.in[31] + n0, DM, DM, ws + WS_WQOC + (size_t)n0 * DM, (float*)(ws + WS_SBOC) + n0, lds, wave, lane, tid); return; } r -= 64;
    if (r < 640) { xpose_run(a.in[16], nullptr, (bf16*)(ws + WS_WINAB), 5120, DM, 160, 0, r * 8 + wave, scr, lane); return; } r -= 640;
    if (r < 256) { xpose_run(a.in[17], nullptr, (bf16*)(ws + WS_WOUTAB), DM, DM, 64, 0, r * 8 + wave, scr, lane); return; } r -= 256;
    if (r < 544) {
        const int sub = r * 8 + wave, kb = sub / 136, nb = sub - kb * 136, n0 = nb * 32; const int col = n0 < 4096 ? 2048 + n0 : 8192 + (n0 - 4096);
        xpose_sub(a.in[28] + col, 8224, (bf16*)(ws + WS_WINC) + (size_t)n0 * DM, DM, kb * 64, col >= 8224, scr, lane); return; } r -= 544;
    if (r < 32) { const int which = r >> 4, dh = r & 15;
        { const int sub = wave, kb = sub >> 2, nb = sub & 3;
          xpose_sub(a.in[which ? 25 : 23] + (size_t)dh * 16384 + nb * 32, 128, (bf16*)(ws + WS_LW) + (size_t)(dh * 2 + which) * 16384 + (size_t)(nb * 32) * 128, 128, kb * 64, false, scr, lane, -1.4426950408889634f); } return; } r -= 32;
    { const int b = r >> 5;
      xpose_run(a.in[3] + (size_t)b * 512 * 1024, nullptr, (bf16*)(ws + WS_VCT) + (size_t)b * 1024 * 512, 1024, 512, 32, 0, (r & 31) * 8 + wave, scr, lane); }
}
__device__ __forceinline__ void phase_p0(const Args& a, LAS unsigned char* lds, int G, int wave, int lane, int tid) {
    unsigned* ctr = (unsigned*)(a.ws + WS_CTL) + 64; volatile LAS int* qs = (volatile LAS int*)(lds + MISC_OFF + 64);
    if (tid == 0) qs[0] = (int)__hip_atomic_fetch_add(ctr, 1u, __ATOMIC_RELAXED, __HIP_MEMORY_SCOPE_AGENT);
    __syncthreads();
    int it = qs[0];
    while (it < P0_ITEMS) {
        __syncthreads();
        int nxt = 0; if (tid == 0) nxt = (int)__hip_atomic_fetch_add(ctr, 1u, __ATOMIC_RELAXED, __HIP_MEMORY_SCOPE_AGENT);
        p0_item(a, it, lds, wave, lane, tid);
        if (tid == 0) qs[0] = nxt;
        __syncthreads();
        it = qs[0];
    }
    unsigned char* ws = a.ws;
    { const f32x4* src = (const f32x4*)a.in[2]; v2u* dst = (v2u*)(ws + WS_KC);
      for (int i = blockIdx.x * NTHR + tid; i < 1048576; i += G * NTHR) { const f32x4 v = src[i]; dst[i] = (v2u){pk2(v[0], v[1]), pk2(v[2], v[3])}; } }
    { float* R = (float*)(ws + WS_ROPE);
      for (int i = blockIdx.x * NTHR + tid; i < 4096; i += G * NTHR) { const int p = i >> 6, fi = i & 63; const float fr = powf(10000.0f, -(float)fi * (1.0f / 64.0f)); const float ang = (float)p * fr;
          R[2 * i] = cosf(ang); R[2 * i + 1] = sinf(ang); } }
}
#define NORM_REQ(mm) do { if (FIRST) { const float* xr_ = (mm) < MP ? a.in[0] + (size_t)(mm) * DM : a.in[1] + (size_t)((mm) - MP) * DM; _Pragma("unroll") for (int q = 0; q < 8; ++q) nf[q] = *(const f32x4*)(xr_ + 4 * lane + 256 * q); } \
        else { const bf16* xr_ = COPY ? (const bf16*)(a.ws + WS_XB2) + (size_t)(mm) * DM : (const bf16*)a.out + (size_t)(mm) * XPITCH; _Pragma("unroll") for (int q = 0; q < 8; ++q) nh[q] = *(const v2u*)(xr_ + 4 * lane + 256 * q); } } while (0)
template <bool FIRST, bool COPY = false  >
__device__ __forceinline__ void norm_pass(const Args& a, int l, int j, int G, int wave, int lane) {
    const float* MOD = (const float*)(a.ws + WS_MOD) + (size_t)l * 9 * MODS;
    const float* gvec = a.in[12] + (size_t)(l * 3 + j) * DM;
    bf16* H = (bf16*)(a.ws + WS_H);
    const int NGW = G * NWAVES, gw = blockIdx.x * NWAVES + wave, rpw = (MT + NGW - 1) / NGW;
    int cur = -1; f32x4 ge[8], sh[8];
    const int m_end = (gw + 1) * rpw < MT ? (gw + 1) * rpw : MT;
    f32x4 nf[8]; v2u nh[8];
    if (gw * rpw < m_end) NORM_REQ(gw * rpw);
    for (int m = gw * rpw; m < m_end; ++m) {
        const int s = set_of_row(m);
        if (s != cur) { cur = s; const float* sc = MOD + (size_t)s * MODS + (3 * j + 1) * DM; const float* sf = MOD + (size_t)s * MODS + (3 * j) * DM;
#pragma unroll
            for (int q = 0; q < 8; ++q) { const int c = 4 * lane + 256 * q; const f32x4 g4 = *(const f32x4*)(gvec + c), s4 = *(const f32x4*)(sc + c); ge[q] = g4 * (s4 + 1.0f); sh[q] = *(const f32x4*)(sf + c); } }
        f32x4 v[8]; float ss = 0.f;
        if (FIRST) {
#pragma unroll
            for (int q = 0; q < 8; ++q) v[q] = nf[q]; }
        else {
#pragma unroll
            for (int q = 0; q < 8; ++q) { const v2u w = nh[q]; v[q] = (f32x4){__uint_as_float(w.x << 16), __uint_as_float(w.x & 0xffff0000u), __uint_as_float(w.y << 16), __uint_as_float(w.y & 0xffff0000u)}; } }
        if (m + 1 < m_end) NORM_REQ(m + 1);
#pragma unroll
        for (int q = 0; q < 8; ++q) ss += (v[q][0] * v[q][0] + v[q][1] * v[q][1]) + (v[q][2] * v[q][2] + v[q][3] * v[q][3]);
        const float rstd = rsqrtf(wave_sum(ss) * (1.0f / DM) + EPS);
        bf16* orow = H + (size_t)m * DM;
#pragma unroll
        for (int q = 0; q < 8; ++q) { const f32x4 o = v[q] * rstd * ge[q] + sh[q]; *(v2u*)(orow + 4 * lane + 256 * q) = (v2u){pk2(o[0], o[1]), pk2(o[2], o[3])}; }
    }
}

template <bool FIRST, bool COPY = false  >
__device__ __forceinline__ void norm_pass_dual(const Args& a, int l, int j, int G, int wave, int lane) {
    const float* MOD = (const float*)(a.ws + WS_MOD) + (size_t)l * 9 * MODS;
    const float* gvec = a.in[12] + (size_t)(l * 3 + j) * DM;
    bf16* H = (bf16*)(a.ws + WS_H);
    const int NGW = G * NWAVES, gw = blockIdx.x * NWAVES + wave, rpw = (MT + NGW - 1) / NGW;
    int cur = -1; f32x4 ge[8], sh[8];
    const int m_end = (gw + 1) * rpw < MT ? (gw + 1) * rpw : MT;
    f32x4 nf[8]; v2u nh[8];
    if (gw * rpw < m_end) NORM_REQ(gw * rpw);
    for (int m = gw * rpw; m < m_end; ++m) {
        const int s = set_of_row(m);
        if (s != cur) { cur = s; const float* sc = MOD + (size_t)s * MODS + (3 * j + 1) * DM; const float* sf = MOD + (size_t)s * MODS + (3 * j) * DM;
#pragma unroll
            for (int q = 0; q < 8; ++q) { const int c = 4 * lane + 256 * q; const f32x4 g4 = *(const f32x4*)(gvec + c), s4 = *(const f32x4*)(sc + c); ge[q] = g4 * (s4 + 1.0f); sh[q] = *(const f32x4*)(sf + c); } }
        f32x4 v[8]; float ss = 0.f;
        if (FIRST) {
#pragma unroll
            for (int q = 0; q < 8; ++q) v[q] = nf[q]; }
        else {
#pragma unroll
            for (int q = 0; q < 8; ++q) { const v2u w = nh[q]; v[q] = (f32x4){__uint_as_float(w.x << 16), __uint_as_float(w.x & 0xffff0000u), __uint_as_float(w.y << 16), __uint_as_float(w.y & 0xffff0000u)}; } }
        if (m + 1 < m_end) NORM_REQ(m + 1);
#pragma unroll
        for (int q = 0; q < 8; ++q) ss += (v[q][0] * v[q][0] + v[q][1] * v[q][1]) + (v[q][2] * v[q][2] + v[q][3] * v[q][3]);
        const float rstd = rsqrtf(wave_sum(ss) * (1.0f / DM) + EPS);
        bf16* orow = H + (size_t)m * DM;
#pragma unroll
        for (int q = 0; q < 8; ++q) { v[q] = v[q] * rstd * ge[q] + sh[q]; *(v2u*)(orow + 4 * lane + 256 * q) = (v2u){pk2(v[q][0], v[q][1]), pk2(v[q][2], v[q][3])}; }
        float am = 0.f;
#pragma unroll
        for (int q = 0; q < 8; ++q) am = fmaxf(am, fmaxf(fmaxf(fabsf(v[q][0]), fabsf(v[q][1])), fmaxf(fabsf(v[q][2]), fabsf(v[q][3]))));
        am = wave_max(am);
        const float inv = am > 0.f ? 127.0f / am : 0.f;
        unsigned char* o8 = a.ws + WS_H8M + (size_t)m * DM;
#pragma unroll
        for (int q = 0; q < 8; ++q) { const int q0 = (int)rintf(v[q][0] * inv) & 0xff, q1 = (int)rintf(v[q][1] * inv) & 0xff, q2 = (int)rintf(v[q][2] * inv) & 0xff, q3 = (int)rintf(v[q][3] * inv) & 0xff;
            *(unsigned*)(o8 + 4 * lane + 256 * q) = (unsigned)(q0 | (q1 << 8) | (q2 << 16) | (q3 << 24)); }
        if (lane == 0) ((float*)(a.ws + WS_SA))[m] = am * (1.0f / 127.0f);
    }
}

template <bool FIRST, bool COPY = false  >
__device__ __forceinline__ void norm_pass_q(const Args& a, int l, int j, int G, int wave, int lane) {
    const float* MOD = (const float*)(a.ws + WS_MOD) + (size_t)l * 9 * MODS;
    const float* gvec = a.in[12] + (size_t)(l * 3 + j) * DM;
    unsigned char* H8 = a.ws + WS_H; float* SA = (float*)(a.ws + WS_SA);
    const int NGW = G * NWAVES, gw = blockIdx.x * NWAVES + wave, rpw = (MT + NGW - 1) / NGW;
    int cur = -1; f32x4 ge[8], sh[8];
    const int m_end = (gw + 1) * rpw < MT ? (gw + 1) * rpw : MT;
    f32x4 nf[8]; v2u nh[8];
    if (gw * rpw < m_end) NORM_REQ(gw * rpw);
    for (int m = gw * rpw; m < m_end; ++m) {
        const int s = set_of_row(m);
        if (s != cur) { cur = s; const float* sc = MOD + (size_t)s * MODS + (3 * j + 1) * DM; const float* sf = MOD + (size_t)s * MODS + (3 * j) * DM;
#pragma unroll
            for (int q = 0; q < 8; ++q) { const int c = 4 * lane + 256 * q; const f32x4 g4 = *(const f32x4*)(gvec + c), s4 = *(const f32x4*)(sc + c); ge[q] = g4 * (s4 + 1.0f); sh[q] = *(const f32x4*)(sf + c); } }
        f32x4 v[8]; float ss = 0.f;
        if (FIRST) {
#pragma unroll
            for (int q = 0; q < 8; ++q) v[q] = nf[q]; }
        else {
#pragma unroll
            for (int q = 0; q < 8; ++q) { const v2u w = nh[q]; v[q] = (f32x4){__uint_as_float(w.x << 16), __uint_as_float(w.x & 0xffff0000u), __uint_as_float(w.y << 16), __uint_as_float(w.y & 0xffff0000u)}; } }
        if (m + 1 < m_end) NORM_REQ(m + 1);
#pragma unroll
        for (int q = 0; q < 8; ++q) ss += (v[q][0] * v[q][0] + v[q][1] * v[q][1]) + (v[q][2] * v[q][2] + v[q][3] * v[q][3]);
        const float rstd = rsqrtf(wave_sum(ss) * (1.0f / DM) + EPS);
        float am = 0.f;
#pragma unroll
        for (int q = 0; q < 8; ++q) { v[q] = v[q] * rstd * ge[q] + sh[q]; am = fmaxf(am, fmaxf(fmaxf(fabsf(v[q][0]), fabsf(v[q][1])), fmaxf(fabsf(v[q][2]), fabsf(v[q][3])))); }
        am = wave_max(am);
        const float inv = am > 0.f ? 127.0f / am : 0.f;
        unsigned char* orow = H8 + (size_t)m * DM;
#pragma unroll
        for (int q = 0; q < 8; ++q) { const int q0 = (int)rintf(v[q][0] * inv) & 0xff, q1 = (int)rintf(v[q][1] * inv) & 0xff, q2 = (int)rintf(v[q][2] * inv) & 0xff, q3 = (int)rintf(v[q][3] * inv) & 0xff;
            *(unsigned*)(orow + 4 * lane + 256 * q) = (unsigned)(q0 | (q1 << 8) | (q2 << 16) | (q3 << 24)); }
        if (lane == 0) SA[m] = am * (1.0f / 127.0f);
    }
}

__device__ __forceinline__ void tile_load(const bf16* src, size_t spitch, LAS bf16* tl, int lane) {
    v4u r[16];
#pragma unroll
    for (int i = 0; i < 16; ++i) { const int c = lane + 64 * i, t = c >> 4, dc = c & 15; r[i] = *(const v4u*)(src + (size_t)t * spitch + 8 * dc); }
#pragma unroll
    for (int i = 0; i < 16; ++i) { const int c = lane + 64 * i, t = c >> 4, dc = c & 15; *(LAS v4u*)(tl + t * 136 + 8 * dc) = r[i]; }
}
__device__ __forceinline__ void tile_store_rows(bf16* dst, size_t dpitch, const LAS bf16* tl, int lane) {
#pragma unroll
    for (int i = 0; i < 16; ++i) { const int c = lane + 64 * i, t = c >> 4, dc = c & 15; *(v4u*)(dst + (size_t)t * dpitch + 8 * dc) = *(const LAS v4u*)(tl + t * 136 + 8 * dc); }
}
__device__ __forceinline__ void tile_store_T(bf16* dst, size_t dpitch, const LAS bf16* tl, int lane) {
#pragma unroll 4
    for (int i = 0; i < 16; ++i) { const int c = lane + 64 * i, d = c >> 3, tc = c & 7; const LAS bf16* s = tl + (8 * tc) * 136 + d;
        v4u o; o.x = (unsigned)s[0] | ((unsigned)s[136] << 16); o.y = (unsigned)s[2 * 136] | ((unsigned)s[3 * 136] << 16); o.z = (unsigned)s[4 * 136] | ((unsigned)s[5 * 136] << 16); o.w = (unsigned)s[6 * 136] | ((unsigned)s[7 * 136] << 16);
        *(v4u*)(dst + (size_t)d * dpitch + 8 * tc) = o; }
}
__device__ __forceinline__ void ab_post_item(const Args& a, int item, LAS unsigned char* lds, int wave, int lane) {
    bf16* Z = (bf16*)(a.ws + WS_Z);
    const int R0 = item * 64;
    const bool prompt = R0 < MP;
    float* outk = a.out + 75497472; float* outv = a.out + 79691776;
    float qg[16], kg[16];
#pragma unroll
    for (int e = 0; e < 16; ++e) { qg[e] = a.in[18][16 * (lane & 7) + e]; kg[e] = a.in[19][16 * (lane & 7) + e]; }
    const int rowb = R0 + wave * 8; bf16* zb = Z + (size_t)rowb * 5120 + 16 * lane;
#pragma unroll
    for (int which = 0; which < 2; ++which) {
        v4u r0[8], r1[8];
#pragma unroll
        for (int tt = 0; tt < 8; ++tt) { const bf16* p = zb + (size_t)tt * 5120 + which * 1024; r0[tt] = *(const v4u*)p; r1[tt] = *(const v4u*)(p + 8); }
#pragma unroll
        for (int tt = 0; tt < 8; ++tt) {
            bf16* p = zb + (size_t)tt * 5120 + which * 1024;
            float x[16]; const unsigned w8[8] = {r0[tt].x, r0[tt].y, r0[tt].z, r0[tt].w, r1[tt].x, r1[tt].y, r1[tt].z, r1[tt].w};
#pragma unroll
            for (int e = 0; e < 8; ++e) { x[2 * e] = __uint_as_float(w8[e] << 16); x[2 * e + 1] = __uint_as_float(w8[e] & 0xffff0000u); }
            float ss = 0.f;
#pragma unroll
            for (int e = 0; e < 16; ++e) ss += x[e] * x[e];
            ss += __shfl_xor(ss, 1); ss += __shfl_xor(ss, 2); ss += __shfl_xor(ss, 4);
            const float rs = rsqrtf(ss * (1.0f / 128.0f) + EPS);
#pragma unroll
            for (int e = 0; e < 16; ++e) x[e] = x[e] * rs * (which ? kg[e] : qg[e]);
            v4u o0, o1; o0.x = pk2(x[0], x[1]); o0.y = pk2(x[2], x[3]); o0.z = pk2(x[4], x[5]); o0.w = pk2(x[6], x[7]); o1.x = pk2(x[8], x[9]); o1.y = pk2(x[10], x[11]); o1.z = pk2(x[12], x[13]); o1.w = pk2(x[14], x[15]);
            *(v4u*)p = o0; *(v4u*)(p + 8) = o1;
            if (which == 1 && prompt) { float* ok = outk + (size_t)(rowb + tt) * 1024 + 16 * lane;
#pragma unroll
                for (int e = 0; e < 4; ++e) *(f32x4*)(ok + 4 * e) = (f32x4){x[4 * e], x[4 * e + 1], x[4 * e + 2], x[4 * e + 3]}; }
        }
    }
    if (prompt) {
        v4u r0[8], r1[8];
#pragma unroll
        for (int tt = 0; tt < 8; ++tt) { const bf16* p = zb + (size_t)tt * 5120 + 2048; r0[tt] = *(const v4u*)p; r1[tt] = *(const v4u*)(p + 8); }
#pragma unroll
        for (int tt = 0; tt < 8; ++tt) { const unsigned w8[8] = {r0[tt].x, r0[tt].y, r0[tt].z, r0[tt].w, r1[tt].x, r1[tt].y, r1[tt].z, r1[tt].w};
            float* ov = outv + (size_t)(rowb + tt) * 1024 + 16 * lane;
#pragma unroll
            for (int e = 0; e < 4; ++e) *(f32x4*)(ov + 4 * e) = (f32x4){__uint_as_float(w8[2 * e] << 16), __uint_as_float(w8[2 * e] & 0xffff0000u), __uint_as_float(w8[2 * e + 1] << 16), __uint_as_float(w8[2 * e + 1] & 0xffff0000u)}; }
    }
    LAS bf16* tl = (LAS bf16*)(lds + wave * 17408);
    tile_load(Z + (size_t)R0 * 5120 + 2048 + wave * 128, 5120, tl, lane);
    LDS_WAIT(); asm volatile("" ::: "memory");
    bf16* dst; size_t dp;
    if (prompt) { const int b = R0 >> 8, t0 = R0 & 255; dst = (bf16*)(a.ws + WS_VTP) + ((size_t)(b * 8 + wave) * 128) * 256 + t0; dp = 256; }
    else { const int rs = R0 - MP, b = rs >> 12, t0 = rs & 4095; dst = (bf16*)(a.ws + WS_VTS) + ((size_t)(b * 8 + wave) * 128) * 4096 + t0; dp = 4096; }
    tile_store_T(dst, dp, tl, lane);
    LDS_WAIT(); asm volatile("" ::: "memory");
}
__device__ __forceinline__ float gelu_tanh(float x) { const float y = 0.7978845608028654f * (x + 0.044715f * x * x * x); const float t = 1.0f - 2.0f * __builtin_amdgcn_rcpf(1.0f + __expf(2.0f * y)); return 0.5f * x * (1.0f + t); }
template <int PASS>
__device__ __forceinline__ void lru_item(const Args& a, int cq, int hh, LAS unsigned char* lds, int wave, int lane, int tid) {
    const bf16* Z = (const bf16*)(a.ws + WS_Z); const bf16* LW = (const bf16*)(a.ws + WS_LW);
    float* SUMW = (float*)(a.ws + WS_SUMW); float* SUMB = (float*)(a.ws + WS_SUMB);
    const int fr = lane & 15, fq = lane >> 4;
    int S0, T, tseq, bs = 0, cis = 0, nchk = 1;
    if (cq < 16) { S0 = cq * 256; T = 256; tseq = 0; } else { bs = (cq - 16) >> 4; cis = (cq - 16) & 15; nchk = 16; S0 = MP + bs * 4096; T = 4096; tseq = cis * 256; }
    const int t0 = tseq + 32 * wave;
    LAS bf16* xt = (LAS bf16*)(lds + wave * 8704);
    LAS float* WS = (LAS float*)(lds + 69632);
    LAS float* HW = (LAS float*)(lds + 69632 + 16384);
    {
        const int ch = hh * 128 + 2 * lane;
        const float* cw = a.in[21]; const float* cbp = a.in[22];
        float w[4][2];
#pragma unroll
        for (int i = 0; i < 4; ++i) { w[i][0] = cw[i * 1024 + ch]; w[i][1] = cw[i * 1024 + ch + 1]; }
        const float cb0 = cbp[ch], cb1 = cbp[ch + 1];
        const bf16* xb = Z + (size_t)S0 * 5120 + 3072 + ch;
        unsigned xr[35];
#pragma unroll
        for (int i = 0; i < 35; ++i) { const int t = t0 - 1 + i; xr[i] = (t >= 0 && t < T) ? *(const unsigned*)(xb + (size_t)t * 5120) : 0u; }
#pragma unroll
        for (int t = 0; t < 32; ++t) {
            const float y0 = w[0][0] * __uint_as_float(xr[t] << 16) + w[1][0] * __uint_as_float(xr[t + 1] << 16) + w[2][0] * __uint_as_float(xr[t + 2] << 16) + w[3][0] * __uint_as_float(xr[t + 3] << 16) + cb0;
            const float y1 = w[0][1] * __uint_as_float(xr[t] & 0xffff0000u) + w[1][1] * __uint_as_float(xr[t + 1] & 0xffff0000u) + w[2][1] * __uint_as_float(xr[t + 2] & 0xffff0000u) + w[3][1] * __uint_as_float(xr[t + 3] & 0xffff0000u) + cb1;
            *(LAS unsigned*)(xt + t * 136 + 2 * lane) = pk2(y0, y1);
        }
    }
    if (PASS == 2) {
        if (tid < 256) { const int dir = tid >> 7, chl = tid & 127;
            float Hs = (cq < 16) ? 0.f : a.in[4][(size_t)(bs * 2 + dir) * 1024 + hh * 128 + chl];
            typedef float f32x2_ __attribute__((ext_vector_type(2)));
            f32x2_ sb_[15], sw_[8];
            const float* sbp = SUMB + ((size_t)((cq - cis) * 8 + hh) * 2 + dir) * 256 + 2 * chl;
#pragma unroll
            for (int i = 0; i < 15; ++i) { const int c = dir ? nchk - 1 - i : i; const bool use = dir ? c > cis : c < cis; sb_[i] = use ? *(const f32x2_*)(sbp + (size_t)c * 4096) : (f32x2_){1.f, 0.f}; }
            const float* sw = SUMW + ((size_t)(cq * 8 + hh) * 8) * 512 + dir * 256 + 2 * chl;
#pragma unroll
            for (int w = 0; w < 8; ++w) sw_[w] = *(const f32x2_*)(sw + w * 512);
#pragma unroll
            for (int i = 0; i < 15; ++i) Hs = sb_[i][0] * Hs + sb_[i][1];
            if (dir == 0) {
#pragma unroll
                for (int w = 0; w < 8; ++w) { HW[(w * 2 + 0) * 128 + chl] = Hs; Hs = sw_[w][0] * Hs + sw_[w][1]; } }
            else {
#pragma unroll
                for (int w = 7; w >= 0; --w) { HW[(w * 2 + 1) * 128 + chl] = Hs; Hs = sw_[w][0] * Hs + sw_[w][1]; } }
        }
        __syncthreads();
    }
    LDS_WAIT(); asm volatile("" ::: "memory");
    bf16x8 af[2][4];
#pragma unroll
    for (int mt = 0; mt < 2; ++mt)
#pragma unroll
        for (int kk = 0; kk < 4; ++kk) af[mt][kk] = *(const LAS bf16x8*)(xt + (16 * mt + fr) * 136 + 32 * kk + 8 * fq);
    bf16x8 bw[2][4]; float sc3[3];
#define LRU_REQ(dstw, dsts, q_) do { const int d_ = (q_) & 1, chl_ = 16 * ((q_) >> 1) + fr; const bf16* wa_ = LW + (size_t)((d_ * 8 + hh) * 2) * 16384 + chl_ * 128 + 8 * fq; \
        _Pragma("unroll") for (int kk = 0; kk < 4; ++kk) { dstw[0][kk] = *(const bf16x8*)(wa_ + 32 * kk); dstw[1][kk] = *(const bf16x8*)(wa_ + 16384 + 32 * kk); } \
        dsts[0] = a.in[24][d_ * 1024 + hh * 128 + chl_]; dsts[1] = a.in[26][d_ * 1024 + hh * 128 + chl_]; dsts[2] = a.in[27][d_ * 1024 + hh * 128 + chl_]; } while (0)
    LRU_REQ(bw, sc3, 0);
    for (int jt = 0; jt < 8; ++jt) {
        const int chl = 16 * jt + fr, ch = hh * 128 + chl;
        bf16 gbr[2][4];
        if (PASS == 2) {
#pragma unroll
            for (int mt = 0; mt < 2; ++mt)
#pragma unroll
                for (int r = 0; r < 4; ++r) gbr[mt][r] = Z[((size_t)S0 + t0 + 16 * mt + 4 * fq + r) * 5120 + 4096 + ch]; }
        float xv[2][4];
#pragma unroll
        for (int mt = 0; mt < 2; ++mt)
#pragma unroll
            for (int r = 0; r < 4; ++r) xv[mt][r] = bf2f(xt[(16 * mt + 4 * fq + r) * 136 + chl]);
        float av[2][2][4], uv[2][2][4];
#pragma unroll
        for (int dir = 0; dir < 2; ++dir) {
            f32x4 acca[2], accx[2];
            acca[0] = acca[1] = accx[0] = accx[1] = (f32x4){0.f, 0.f, 0.f, 0.f};
            bf16x8 bn[2][4]; float sn3[3];
            if (2 * jt + dir < 15) LRU_REQ(bn, sn3, 2 * jt + dir + 1);
#pragma unroll
            for (int kk = 0; kk < 4; ++kk) {
#pragma unroll
                for (int mt = 0; mt < 2; ++mt) { acca[mt] = MFMA16(af[mt][kk], bw[0][kk], acca[mt]); accx[mt] = MFMA16(af[mt][kk], bw[1][kk], accx[mt]); } }
            const float bav = sc3[0] * -1.4426950408889634f, bxv = sc3[1] * -1.4426950408889634f, lm = sc3[2];
            const float c8 = -8.0f * 1.4426950408889634f * log1pf(__expf(-lm));
#pragma unroll
            for (int mt = 0; mt < 2; ++mt)
#pragma unroll
                for (int r = 0; r < 4; ++r) { const float ra = __builtin_amdgcn_rcpf(1.0f + __builtin_amdgcn_exp2f(acca[mt][r] + bav)), ix = __builtin_amdgcn_rcpf(1.0f + __builtin_amdgcn_exp2f(accx[mt][r] + bxv)); const float la = c8 * ra;
                    const float aa = __builtin_amdgcn_exp2f(la); av[dir][mt][r] = aa; uv[dir][mt][r] = __builtin_amdgcn_sqrtf(fmaxf(1.0f - aa * aa, 0.f)) * ix * xv[mt][r]; }
            if (2 * jt + dir < 15) {
#pragma unroll
                for (int x_ = 0; x_ < 2; ++x_)
#pragma unroll
                    for (int kk = 0; kk < 4; ++kk) bw[x_][kk] = bn[x_][kk];
                sc3[0] = sn3[0]; sc3[1] = sn3[1]; sc3[2] = sn3[2]; }
        }
        float GA[2][2][4], GB[2][2][4];
#pragma unroll
        for (int dir = 0; dir < 2; ++dir)
#pragma unroll
            for (int mt = 0; mt < 2; ++mt) { float A = 1.f, B = 0.f;
#pragma unroll
                for (int rr = 0; rr < 4; ++rr) { const int r = dir ? 3 - rr : rr; A *= av[dir][mt][r]; B = av[dir][mt][r] * B + uv[dir][mt][r]; }
#pragma unroll
                for (int q = 0; q < 4; ++q) { GA[dir][mt][q] = __shfl(A, fr + 16 * q); GB[dir][mt][q] = __shfl(B, fr + 16 * q); } }
        if (PASS == 1) {
#pragma unroll
            for (int dir = 0; dir < 2; ++dir) { float A = 1.f, B = 0.f;
#pragma unroll
                for (int mm = 0; mm < 2; ++mm)
#pragma unroll
                    for (int qq = 0; qq < 4; ++qq) { const int mt = dir ? 1 - mm : mm, q = dir ? 3 - qq : qq; B = GA[dir][mt][q] * B + GB[dir][mt][q]; A *= GA[dir][mt][q]; }
                if (fq == 0) { WS[((wave * 2 + dir) * 128 + chl) * 2] = A; WS[((wave * 2 + dir) * 128 + chl) * 2 + 1] = B;
                    float* g = SUMW + ((size_t)((cq * 8 + hh) * 8 + wave)) * 512 + dir * 256 + 2 * chl; g[0] = A; g[1] = B; } }
        } else {
            float hsum[2][4] = {{0.f, 0.f, 0.f, 0.f}, {0.f, 0.f, 0.f, 0.f}};
#pragma unroll
            for (int dir = 0; dir < 2; ++dir) { float st = HW[(wave * 2 + dir) * 128 + chl]; float hin[2] = {0.f, 0.f};
#pragma unroll
                for (int mm = 0; mm < 2; ++mm)
#pragma unroll
                    for (int qq = 0; qq < 4; ++qq) { const int mt = dir ? 1 - mm : mm, q = dir ? 3 - qq : qq; if (q == fq) hin[mt] = st; st = GA[dir][mt][q] * st + GB[dir][mt][q]; }
#pragma unroll
                for (int mt = 0; mt < 2; ++mt) { float h = hin[mt];
#pragma unroll
                    for (int rr = 0; rr < 4; ++rr) { const int r = dir ? 3 - rr : rr; h = av[dir][mt][r] * h + uv[dir][mt][r]; hsum[mt][r] += h;
                        if (cq < 16) { if (dir == 0 && wave == 7 && mt == 1 && fq == 3 && r == 3) a.out[83886080 + (size_t)(cq * 2 + 0) * 1024 + ch] = h;
                                       if (dir == 1 && wave == 0 && mt == 0 && fq == 0 && r == 0) a.out[83886080 + (size_t)(cq * 2 + 1) * 1024 + ch] = h; } } } }
            bf16* Hb = (bf16*)(a.ws + WS_H);
#pragma unroll
            for (int mt = 0; mt < 2; ++mt)
#pragma unroll
                for (int r = 0; r < 4; ++r) { const size_t row = (size_t)S0 + t0 + 16 * mt + 4 * fq + r; const float gb = bf2f(gbr[mt][r]);
                    Hb[row * DM + 1024 + ch] = (bf16)f2bf(hsum[mt][r] * gelu_tanh(gb)); }
        }
    }
#undef LRU_REQ
    if (PASS == 1) {
        LDS_WAIT(); __syncthreads();
        if (tid < 256) { const int dir = tid >> 7, chl = tid & 127; float A = 1.f, B = 0.f;
            for (int ww = 0; ww < 8; ++ww) { const int w = dir ? 7 - ww : ww; const float wa_ = WS[((w * 2 + dir) * 128 + chl) * 2], wb_ = WS[((w * 2 + dir) * 128 + chl) * 2 + 1]; B = wa_ * B + wb_; A *= wa_; }
            float* g = SUMB + ((size_t)(cq * 8 + hh) * 2 + dir) * 256 + 2 * chl; g[0] = A; g[1] = B; }
    }
    __syncthreads();
}

__device__ __forceinline__ bf16x8 pack8(const float (&p)[8]) { v4u w; w.x = pk2(p[0], p[1]); w.y = pk2(p[2], p[3]); w.z = pk2(p[4], p[5]); w.w = pk2(p[6], p[7]); return __builtin_bit_cast(bf16x8, w); }
__device__ __forceinline__ void c_post_item(const Args& a, int item, LAS unsigned char* lds, int wave, int lane, int tid) {
    bf16* PL = (bf16*)(a.ws + WS_PL);
    const int R0 = item * 64; const bool prompt = R0 < MP;
    int b, tok0; size_t T, tbase;
    if (prompt) { b = R0 >> 8; tok0 = R0 & 255; T = 256; tbase = ((size_t)(b * 8 + wave) * 256) * 256; }
    else { const int rs = R0 - MP; b = rs >> 12; tok0 = rs & 4095; T = 4096; tbase = (size_t)MP * DM + ((size_t)(b * 8 + wave) * 256) * 4096; }
    LAS bf16* tl = (LAS bf16*)(lds + wave * 17408);
    const float* ROPE = (const float*)(a.ws + WS_ROPE);
    const int prow = tok0 >> 6;
    for (int pl = 0; pl < 3; ++pl)
        for (int hf = 0; hf < 2; ++hf) {
            if (pl == 0 && prompt) continue;
            bf16* src = PL + (size_t)pl * PLANE + (size_t)R0 * DM + wave * 256 + hf * 128;
            tile_load(src, DM, tl, lane);
            LDS_WAIT(); asm volatile("" ::: "memory");
            if (pl < 2) {
                const float ksc = pl == 1 ? 0.0625f : 1.0f;
                if (!prompt) {
                    float cr = 0.f, sr = 0.f; if (hf == 0) { cr = ROPE[(prow * 64 + lane) * 2]; sr = ROPE[(prow * 64 + lane) * 2 + 1]; }
#pragma unroll 4
                    for (int t = 0; t < 64; ++t) { float c = cr, s = sr; if (hf) { c = ROPE[(t * 64 + lane) * 2]; s = ROPE[(t * 64 + lane) * 2 + 1]; }
                        const float x1 = bf2f(tl[t * 136 + lane]), x2 = bf2f(tl[t * 136 + 64 + lane]);
                        tl[t * 136 + lane] = (bf16)f2bf((x1 * c - x2 * s) * ksc); tl[t * 136 + 64 + lane] = (bf16)f2bf((x1 * s + x2 * c) * ksc); }
                } else {
#pragma unroll 4
                    for (int t = 0; t < 64; ++t) { const float x1 = bf2f(tl[t * 136 + lane]), x2 = bf2f(tl[t * 136 + 64 + lane]);
                        tl[t * 136 + lane] = (bf16)f2bf(x1 * ksc); tl[t * 136 + 64 + lane] = (bf16)f2bf(x2 * ksc); }
                }
                LDS_WAIT(); asm volatile("" ::: "memory");
                tile_store_rows(src, DM, tl, lane);
            }
            if (pl >= 1) { bf16* dstT = (pl == 1 ? (bf16*)(a.ws + WS_KT) : (bf16*)(a.ws + WS_H)) + tbase + (size_t)(hf * 128) * T + tok0; tile_store_T(dstT, T, tl, lane); }
            LDS_WAIT(); asm volatile("" ::: "memory");
        }
    float* GT = (float*)(a.ws + WS_GATES);
    float gt4[4];
#pragma unroll
    for (int i = 0; i < 4; ++i) { const int idx = tid + NTHR * i; gt4[i] = GT[(size_t)(R0 + (idx >> 5)) * 32 + (idx & 31)]; }
#pragma unroll
    for (int i = 0; i < 4; ++i) { const int idx = tid + NTHR * i, rl = idx >> 5, gi = idx & 31; float* p = GT + (size_t)(R0 + rl) * 32 + gi; float v = gt4[i] + a.in[29][gi];
        if ((gi >> 3) & 1) v = fminf(v, 0.f) - log1pf(__expf(-fabsf(v)));
        *p = v; }
}
constexpr int ML_KL = 0, ML_VTL = 33792, ML_CTL = 68608, ML_ARR = 136192;
__device__ __forceinline__ void c_final_pass(const Args& a, int G, int wave, int lane) {
    const bf16* HF = (const bf16*)(a.ws + WS_PL) + 2 * PLANE; const bf16* HB = (const bf16*)(a.ws + WS_HB); const bf16* OG = (const bf16*)(a.ws + WS_PL) + 3 * PLANE;
    bf16* H = (bf16*)(a.ws + WS_H);
    float gv[32];
#pragma unroll
    for (int e = 0; e < 32; ++e) gv[e] = a.in[30][32 * lane + e];
    v4u nfv[4], nbv[4], ngv[4];
#define CF_REQ(mm) do { const size_t off_ = (size_t)(mm) * DM + 32 * lane; _Pragma("unroll") for (int q = 0; q < 4; ++q) { nfv[q] = *(const v4u*)(HF + off_ + 8 * q); nbv[q] = *(const v4u*)(HB + off_ + 8 * q); ngv[q] = *(const v4u*)(OG + off_ + 8 * q); } } while (0)
    if ((int)(blockIdx.x * NWAVES + wave) < MT) CF_REQ(blockIdx.x * NWAVES + wave);
    for (int m = blockIdx.x * NWAVES + wave; m < MT; m += G * NWAVES) {
        const size_t off = (size_t)m * DM + 32 * lane;
        v4u fv[4], bv[4], gv4[4];
#pragma unroll
        for (int q = 0; q < 4; ++q) { fv[q] = nfv[q]; bv[q] = nbv[q]; gv4[q] = ngv[q]; }
        if (m + G * NWAVES < MT) CF_REQ(m + G * NWAVES);
        float x[32]; float ss = 0.f;
#pragma unroll
        for (int q = 0; q < 4; ++q) { const unsigned fw[4] = {fv[q].x, fv[q].y, fv[q].z, fv[q].w}, bw[4] = {bv[q].x, bv[q].y, bv[q].z, bv[q].w};
#pragma unroll
            for (int e = 0; e < 4; ++e) { x[8 * q + 2 * e] = __uint_as_float(fw[e] << 16) + __uint_as_float(bw[e] << 16); x[8 * q + 2 * e + 1] = __uint_as_float(fw[e] & 0xffff0000u) + __uint_as_float(bw[e] & 0xffff0000u); } }
#pragma unroll
        for (int e = 0; e < 32; ++e) ss += x[e] * x[e];
        ss += __shfl_xor(ss, 1); ss += __shfl_xor(ss, 2); ss += __shfl_xor(ss, 4);
        const float rs = rsqrtf(ss * (1.0f / 256.0f) + EPS);
        float y[32]; float am = 0.f;
#pragma unroll
        for (int q = 0; q < 4; ++q) { const unsigned ow[4] = {gv4[q].x, gv4[q].y, gv4[q].z, gv4[q].w};
#pragma unroll
            for (int e = 0; e < 4; ++e) { y[8 * q + 2 * e] = x[8 * q + 2 * e] * rs * gv[8 * q + 2 * e] * sigmoidf_(__uint_as_float(ow[e] << 16)); y[8 * q + 2 * e + 1] = x[8 * q + 2 * e + 1] * rs * gv[8 * q + 2 * e + 1] * sigmoidf_(__uint_as_float(ow[e] & 0xffff0000u)); } }
#pragma unroll
        for (int e = 0; e < 32; ++e) am = fmaxf(am, fabsf(y[e]));
        am = wave_max(am);
        const float inv = am > 0.f ? 127.0f / am : 0.f;
        unsigned wq[8];
#pragma unroll
        for (int q = 0; q < 8; ++q) { const int q0 = (int)rintf(y[4 * q] * inv) & 0xff, q1 = (int)rintf(y[4 * q + 1] * inv) & 0xff, q2 = (int)rintf(y[4 * q + 2] * inv) & 0xff, q3 = (int)rintf(y[4 * q + 3] * inv) & 0xff; wq[q] = (unsigned)(q0 | (q1 << 8) | (q2 << 16) | (q3 << 24)); }
        unsigned char* o8 = a.ws + WS_H + (size_t)m * DM + 32 * lane;
        *(v4u*)o8 = (v4u){wq[0], wq[1], wq[2], wq[3]}; *(v4u*)(o8 + 16) = (v4u){wq[4], wq[5], wq[6], wq[7]};
        if (lane == 0) ((float*)(a.ws + WS_SA))[m] = am * (1.0f / 127.0f);
    }
#undef CF_REQ
}

#ifndef AT_DV
#define AT_DV 4
#endif
constexpr int AT_K0 = 0, AT_V0 = 34816, AT_K1 = 69632, AT_V1 = 104448, AT_RPB = 139264;
__device__ __forceinline__ void attn_block(const Args& a, int kind, int b, int h, int rp, LAS unsigned char* lds, int wave, int lane, int tid) {
    const bf16* Z = (const bf16*)(a.ws + WS_Z);
    const int fr = lane & 15, fq = lane >> 4;
    const float NINF = -__builtin_inff();
    const int rq = 2 * rp + (wave >> 2), j = kind ? (wave & 3) : 0;
    const size_t qrow = kind ? (size_t)MP + (size_t)b * 4096 + rq * 64 + 16 * j + fr : (size_t)b * 256 + 16 * (8 * rp + wave) + fr;
    bf16x8 bq[4];
    { const bf16* qp = Z + qrow * 5120 + h * 128 + 8 * fq; const float qs = 0.08838834764831845f * 1.4426950408889634f;
#pragma unroll
      for (int kk = 0; kk < 4; ++kk) { const v4u raw = *(const v4u*)(qp + 32 * kk); const unsigned rw[4] = {raw.x, raw.y, raw.z, raw.w}; v4u w;
          w.x = pk2(__uint_as_float(rw[0] << 16) * qs, __uint_as_float(rw[0] & 0xffff0000u) * qs); w.y = pk2(__uint_as_float(rw[1] << 16) * qs, __uint_as_float(rw[1] & 0xffff0000u) * qs);
          w.z = pk2(__uint_as_float(rw[2] << 16) * qs, __uint_as_float(rw[2] & 0xffff0000u) * qs); w.w = pk2(__uint_as_float(rw[3] << 16) * qs, __uint_as_float(rw[3] & 0xffff0000u) * qs);
          bq[kk] = __builtin_bit_cast(bf16x8, w); } }
    const int rlo = min(max(2 * rp - 4, 0), 56), rhi = min(max(2 * rp + 1 - 4, 0), 56) + 8;
    const int nsw = kind ? (rhi - rlo + 1) >> 1 : 0, ntile = kind ? nsw + 4 : 2;
    const int r0 = min(max(rq - 4, 0), 56), start = min(max(16 * j - 8, 0), 32);
    float m_run = NINF, l_run = 0.f;
    f32x4 o[8];
#pragma unroll
    for (int dt = 0; dt < 8; ++dt) o[dt] = (f32x4){0.f, 0.f, 0.f, 0.f};
    v4u sk[4], sv[4], sk2[4], sv2[4];
#define AT_LOAD(t, SK, SV) do { _Pragma("unroll") for (int i_ = 0; i_ < 4; ++i_) { const int id_ = tid + NTHR * i_, key_ = id_ >> 4, ch_ = id_ & 15; \
        if (kind == 0) { SK[i_] = *(const v4u*)(Z + ((size_t)b * 256 + 128 * (t) + key_) * 5120 + 1024 + h * 128 + 8 * ch_); SV[i_] = *(const v4u*)((const bf16*)(a.ws + WS_VTP) + ((size_t)(b * 8 + h) * 128 + key_) * 256 + 128 * (t) + 8 * ch_); } \
        else if ((t) < nsw) { const int rk_ = min(rlo + 2 * (t) + (key_ >> 6), rhi - 1), rv_ = min(rlo + 2 * (t) + (ch_ >> 3), rhi - 1); \
            SK[i_] = *(const v4u*)(Z + ((size_t)MP + (size_t)b * 4096 + rk_ * 64 + (key_ & 63)) * 5120 + 1024 + h * 128 + 8 * ch_); SV[i_] = *(const v4u*)((const bf16*)(a.ws + WS_VTS) + ((size_t)(b * 8 + h) * 128 + key_) * 4096 + rv_ * 64 + 8 * (ch_ & 7)); } \
        else { const int c_ = (t) - nsw; SK[i_] = *(const v4u*)((const bf16*)(a.ws + WS_KC) + ((size_t)(b * 512 + 128 * c_ + key_) * 8 + h) * 128 + 8 * ch_); SV[i_] = *(const v4u*)((const bf16*)(a.ws + WS_VCT) + ((size_t)b * 1024 + h * 128 + key_) * 512 + 128 * c_ + 8 * ch_); } } } while (0)
#define AT_STORE(buf) do { LAS bf16* kl_ = (LAS bf16*)(lds + ((buf) ? AT_K1 : AT_K0)); LAS bf16* vl_ = (LAS bf16*)(lds + ((buf) ? AT_V1 : AT_V0)); \
        _Pragma("unroll") for (int i_ = 0; i_ < 4; ++i_) { const int id_ = tid + NTHR * i_; *(LAS v4u*)(kl_ + (id_ >> 4) * 136 + 8 * (id_ & 15)) = sk[i_]; *(LAS v4u*)(vl_ + (id_ >> 4) * 136 + 8 * (id_ & 15)) = sv[i_]; } } while (0)
    __syncthreads();
    LAS float* rpbl = (LAS float*)(lds + AT_RPB);
    if (kind && tid < 465) rpbl[tid] = a.in[20][h * 465 + tid] * 1.4426950408889634f;
    AT_LOAD(0, sk, sv); AT_STORE(0);
    AT_LOAD(1, sk, sv);
    if (ntile > 2) AT_LOAD(2, sk2, sv2);
    LDS_WAIT(); __syncthreads();
    for (int t = 0; t < ntile; ++t) {
        const LAS bf16* kl = (const LAS bf16*)(lds + ((t & 1) ? AT_K1 : AT_K0)); const LAS bf16* vl = (const LAS bf16*)(lds + ((t & 1) ? AT_V1 : AT_V0));
        const bool win = kind && t < nsw;
        const int ng = win ? 2 : 4;
        for (int g = 0; g < ng; ++g) {
            const int rr = rlo + 2 * t + g;
            if (win && !(rr >= r0 && rr < r0 + 8)) continue;
            const int koff = win ? 64 * g + start : 32 * g;
            f32x4 s0 = (f32x4){0.f, 0.f, 0.f, 0.f}, s1 = (f32x4){0.f, 0.f, 0.f, 0.f};
            const LAS bf16* k0p = kl + (koff + fr) * 136 + 8 * fq;
#pragma unroll
            for (int kk = 0; kk < 4; ++kk) { const bf16x8 a0 = *(const LAS bf16x8*)(k0p + 32 * kk), a1 = *(const LAS bf16x8*)(k0p + 16 * 136 + 32 * kk); s0 = MFMA16(a0, bq[kk], s0); s1 = MFMA16(a1, bq[kk], s1); }
            const LAS bf16* vq0 = vl + fr * 136 + koff + 4 * fq;
            v2u rlo[AT_DV], rhi[AT_DV];
#pragma unroll
            for (int d = 0; d < AT_DV; ++d) { rlo[d] = *(const LAS v2u*)(vq0 + (16 * d) * 136); rhi[d] = *(const LAS v2u*)(vq0 + (16 * d) * 136 + 16); }
            __builtin_amdgcn_sched_barrier(0);
            float p[8];
#pragma unroll
            for (int e = 0; e < 4; ++e) { p[e] = s0[e]; p[4 + e] = s1[e]; }
            if (win) {
                const int qc = 16 * j + fr, c0 = min(max(qc - 8, 0), 48); const LAS float* rb = rpbl + (rr - rq + 7) * 31;
#pragma unroll
                for (int e = 0; e < 8; ++e) { const int kc = start + (e < 4 ? 4 * fq + e : 16 + 4 * fq + (e - 4)); const bool ok = kc >= c0 && kc < c0 + 16; const int dci = min(max(kc - qc + 15, 0), 30);
                    p[e] = ok ? p[e] + rb[dci] : NINF; }
            }
            float mx = fmaxf(fmaxf(fmaxf(p[0], p[1]), fmaxf(p[2], p[3])), fmaxf(fmaxf(p[4], p[5]), fmaxf(p[6], p[7])));
            mx = rows_max(mx);
            const float m_new = fmaxf(m_run, mx); const float corr = __builtin_amdgcn_exp2f(m_run - m_new);
            float rs = 0.f;
#pragma unroll
            for (int e = 0; e < 8; ++e) { p[e] = __builtin_amdgcn_exp2f(p[e] - m_new); rs += p[e]; }
            rs = rows_sum(rs);
            l_run = l_run * corr + rs; m_run = m_new;
            const bf16x8 pb = pack8(p); const bool resc = !__all(corr == 1.0f);
#pragma unroll
            for (int dt = 0; dt < 8; ++dt) {
                __builtin_amdgcn_sched_barrier(0);
                const v4u vv = (v4u){rlo[dt % AT_DV].x, rlo[dt % AT_DV].y, rhi[dt % AT_DV].x, rhi[dt % AT_DV].y}; if (resc) o[dt] = o[dt] * corr; o[dt] = MFMA16(__builtin_bit_cast(bf16x8, vv), pb, o[dt]);
                if (dt + AT_DV < 8) { rlo[dt % AT_DV] = *(const LAS v2u*)(vq0 + (16 * (dt + AT_DV)) * 136); rhi[dt % AT_DV] = *(const LAS v2u*)(vq0 + (16 * (dt + AT_DV)) * 136 + 16); }
                __builtin_amdgcn_sched_barrier(0); }
        }
        if (t + 1 < ntile) AT_STORE((t + 1) & 1);
#pragma unroll
        for (int i_ = 0; i_ < 4; ++i_) { sk[i_] = sk2[i_]; sv[i_] = sv2[i_]; }
        if (t + 3 < ntile) AT_LOAD(t + 3, sk2, sv2);
        LDS_WAIT(); __syncthreads();
    }
#undef AT_LOAD
#undef AT_STORE
    const float inv = 1.0f / l_run;
    bf16* op = (bf16*)(a.ws + WS_H) + qrow * DM + h * 128 + 4 * fq;
#pragma unroll
    for (int dt = 0; dt < 8; ++dt) *(v2u*)(op + 16 * dt) = (v2u){pk2(o[dt][0] * inv, o[dt][1] * inv), pk2(o[dt][2] * inv, o[dt][3] * inv)};
}

#ifndef ML_DA
#define ML_DA 4
#endif
#ifndef ML_DB
#define ML_DB 3
#endif
#ifndef ML_DV
#define ML_DV 3
#endif
#ifndef ML_DC
#define ML_DC 2
#endif
constexpr int ML2_ARR0 = 136192, ML2_ARR1 = 138784, ML2_NV = 141376;
__device__ __forceinline__ void ml2_scan(LAS float* arr, float ii0, float ff0, float ii1, float ff1, float m_prev, int dir, int lane) {
    const int p0 = 2 * lane, p1 = 2 * lane + 1, i0 = dir ? 127 - p0 : p0, i1 = dir ? 127 - p1 : p1;
    const float s1 = ff0 + ff1; float inc = s1;
#pragma unroll
    for (int o = 1; o < 64; o <<= 1) { const float t = __shfl_up(inc, o); if (lane >= o) inc += t; }
    const float exc = inc - s1, bc0 = exc + ff0, bc1 = inc;
    const float a0 = ii0 - bc0, a1 = ii1 - bc1;
    float im = fmaxf(a0, a1);
#pragma unroll
    for (int o = 1; o < 64; o <<= 1) { const float t = __shfl_up(im, o); if (lane >= o) im = fmaxf(im, t); }
    float em = __shfl_up(im, 1); if (lane == 0) em = -__builtin_inff();
    const float mm0 = fmaxf(m_prev, fmaxf(em, a0)), mm1 = fmaxf(m_prev, im);
    const float mml = fmaxf(m_prev, __shfl(im, 63)), bk = __shfl(inc, 63);
    arr[i0] = a0; arr[i1] = a1; arr[128 + i0] = mm0; arr[128 + i1] = mm1; arr[256 + i0] = __expf(m_prev - mm0); arr[256 + i1] = __expf(m_prev - mm1);
    arr[384 + i0] = __expf(-(bc0 + mm0)); arr[384 + i1] = __expf(-(bc1 + mm1)); arr[512 + i0] = __expf(a0 - mml); arr[512 + i1] = __expf(a1 - mml);
    if (lane == 0) { arr[640] = __expf(m_prev - mml); arr[641] = bk + mml; }
}
__device__ __forceinline__ void mlstm_unit2(const Args& a, int kind, int b, int hh, int dir, int dvh, LAS unsigned char* lds, int wave, int lane0, int tid0) {
    asm volatile("" : "+v"(lane0), "+v"(tid0));
    int lane = lane0, tid = tid0;
    const int fr0 = lane0 & 15, fq0 = lane0 >> 4; int fr = fr0, fq = fq0;
    const int T = kind ? 4096 : 256, nch = T >> 7;
    const size_t row0 = kind ? (size_t)MP + (size_t)b * 4096 : (size_t)b * 256;
    const size_t tb = kind ? (size_t)MP * DM + ((size_t)(b * 8 + hh) * 256) * 4096 : ((size_t)(b * 8 + hh) * 256) * 256;
    const bf16* Qp = (const bf16*)(a.ws + WS_PL); const bf16* Kp = Qp + PLANE;
    const bf16* KT = (const bf16*)(a.ws + WS_KT) + tb; const bf16* VT = (const bf16*)(a.ws + WS_H) + tb + (size_t)(dvh * 128) * T;
    bf16* HO = dir ? (bf16*)(a.ws + WS_HB) : (bf16*)(a.ws + WS_PL) + 2 * PLANE;
    const float* GT = (const float*)(a.ws + WS_GATES);
    LAS bf16* KL = (LAS bf16*)(lds + ML_KL); LAS bf16* VTL = (LAS bf16*)(lds + ML_VTL); LAS bf16* CTL = (LAS bf16*)(lds + ML_CTL);
    LAS float* NV = (LAS float*)(lds + ML2_NV);
    const int scan_wave = dir ? 7 : 0, scan_half = dir ? 0 : 1;
    const int gi_off = (dir ? 16 : 0) + hh, gf_off = (dir ? 24 : 8) + hh;
    f32x4 C[2][8];
    float m0 = 0.f;
    __syncthreads();
    if (kind) {
        const float* c0 = a.in[5] + ((size_t)((b * 2 + dir) * 8 + hh) * 256) * 256 + dvh * 128;
#pragma unroll
        for (int mt = 0; mt < 2; ++mt)
#pragma unroll
            for (int nt = 0; nt < 8; ++nt)
#pragma unroll
                for (int e = 0; e < 4; ++e) C[mt][nt][e] = c0[(unsigned)((32 * wave + 16 * mt + 4 * fq + e) * 256 + 16 * nt + fr)];
        if (tid < 256) NV[tid] = a.in[6][(size_t)((b * 2 + dir) * 8 + hh) * 256 + tid];
        m0 = a.in[7][(b * 2 + dir) * 8 + hh];
    } else {
#pragma unroll
        for (int mt = 0; mt < 2; ++mt)
#pragma unroll
            for (int nt = 0; nt < 8; ++nt) C[mt][nt] = (f32x4){0.f, 0.f, 0.f, 0.f};
        if (tid < 256) NV[tid] = 0.f;
    }
#pragma unroll
    for (int mt = 0; mt < 2; ++mt)
#pragma unroll
        for (int nt = 0; nt < 8; ++nt) *(LAS v2u*)(CTL + (16 * nt + fr) * 264 + 32 * wave + 16 * mt + 4 * fq) = (v2u){pk2(C[mt][nt][0], C[mt][nt][1]), pk2(C[mt][nt][2], C[mt][nt][3])};
    v4u vtn[4], k0n[4]; bf16x8 qf[8];
    {
        const int c = dir ? nch - 1 : 0; const size_t rb = row0 + (size_t)c * 128;
        if (wave == scan_wave) { const int i0 = dir ? 127 - 2 * lane : 2 * lane, i1 = dir ? 126 - 2 * lane : 2 * lane + 1;
            ml2_scan((LAS float*)(lds + ML2_ARR0), GT[(rb + i0) * 32 + gi_off], GT[(rb + i0) * 32 + gf_off], GT[(rb + i1) * 32 + gi_off], GT[(rb + i1) * 32 + gf_off], m0, dir, lane); }
#pragma unroll
        for (int i = 0; i < 4; ++i) { vtn[i] = *(const v4u*)(VT + c * 128 + (unsigned)(((tid >> 4) + 32 * i) * T + 8 * (tid & 15))); k0n[i] = *(const v4u*)(Kp + rb * DM + hh * 256 + (unsigned)(((tid >> 5) + 16 * i) * DM + 8 * (tid & 31))); }
        const bf16* qp = Qp + (rb + 16 * wave) * DM + hh * 256 + (unsigned)(fr * DM + 8 * fq);
#pragma unroll
        for (int kk = 0; kk < 8; ++kk) qf[kk] = *(const bf16x8*)(qp + 32 * kk);
    }
    for (int step = 0; step < nch; ++step) {
        const int c = dir ? nch - 1 - step : step; const int tok0 = c * 128; const size_t rb = row0 + tok0;
        const bool has_next = step + 1 < nch; const int cn = dir ? c - 1 : c + 1; const size_t rbn = row0 + (size_t)cn * 128;
        fr = fr0; fq = fq0; lane = lane0; tid = tid0; asm volatile("" : "+v"(fr), "+v"(fq), "+v"(lane), "+v"(tid));
        LAS float* arr = (LAS float*)(lds + ((step & 1) ? ML2_ARR1 : ML2_ARR0)); LAS float* arn = (LAS float*)(lds + ((step & 1) ? ML2_ARR0 : ML2_ARR1));
        LAS float* A_ = arr; LAS float* MM = arr + 128; LAS float* G_ = arr + 256; LAS float* EMT = arr + 384; LAS float* WE = arr + 512;
        if (step > 0) {
#pragma unroll
            for (int i = 0; i < 4; ++i) { vtn[i] = *(const v4u*)(VT + c * 128 + (unsigned)(((tid >> 4) + 32 * i) * T + 8 * (tid & 15))); k0n[i] = *(const v4u*)(Kp + rb * DM + hh * 256 + (unsigned)(((tid >> 5) + 16 * i) * DM + 8 * (tid & 31))); }
        }
        __syncthreads();
#pragma unroll
        for (int i = 0; i < 4; ++i) { const int cc = tid + NTHR * i; *(LAS v4u*)(VTL + (cc >> 4) * 136 + 8 * (cc & 15)) = vtn[i]; *(LAS v4u*)(KL + (cc >> 5) * 264 + 8 * (cc & 31)) = k0n[i]; }
        v4u k1r[4], akr[2][4];
        if (step > 0) { const bf16* qp = Qp + (rb + 16 * wave) * DM + hh * 256 + (unsigned)(fr * DM + 8 * fq);
#pragma unroll
            for (int kk = 0; kk < 8; ++kk) qf[kk] = *(const bf16x8*)(qp + 32 * kk); }
        float gn[4] = {0.f, 0.f, 0.f, 0.f};
        if (wave == scan_wave && has_next) { const int i0 = dir ? 127 - 2 * lane : 2 * lane, i1 = dir ? 126 - 2 * lane : 2 * lane + 1;
            gn[0] = GT[(rbn + i0) * 32 + gi_off]; gn[1] = GT[(rbn + i0) * 32 + gf_off]; gn[2] = GT[(rbn + i1) * 32 + gi_off]; gn[3] = GT[(rbn + i1) * 32 + gf_off]; }
        LDS_WAIT(); __syncthreads();
        const int tl_ = 16 * wave + fr;
        const float mm_t = MM[tl_], g_t = G_[tl_], emt = EMT[tl_];
        f32x4 o[8];
        {
            const LAS bf16* cb = CTL + fr * 264 + 8 * fq; bf16x8 ring[ML_DA]; const f32x4 zero4 = (f32x4){0.f, 0.f, 0.f, 0.f};
#define ML_A_RD(i_) (*(const LAS bf16x8*)(cb + (16 * (2 * ((i_) >> 4) + ((i_) & 1))) * 264 + 32 * (((i_) >> 1) & 7)))
#pragma unroll
            for (int d = 0; d < ML_DA; ++d) ring[d] = ML_A_RD(d);
#pragma unroll
            for (int i = 0; i < 64; ++i) { const int nt = 2 * (i >> 4) + (i & 1), kk = (i >> 1) & 7;
                __builtin_amdgcn_sched_barrier(0);
                const f32x4 oin = kk == 0 ? zero4 : o[nt]; o[nt] = MFMA16(ring[i % ML_DA], qf[kk], oin);
                if (kk == 7) o[nt] = o[nt] * g_t;
                if (i + ML_DA < 64) ring[i % ML_DA] = ML_A_RD(i + ML_DA);
                __builtin_amdgcn_sched_barrier(0); }
#undef ML_A_RD
        }
        float qn = 0.f;
#pragma unroll
        for (int kk = 0; kk < 8; ++kk) { const f32x4 n0 = *(const LAS f32x4*)(NV + 32 * kk + 8 * fq), n1 = *(const LAS f32x4*)(NV + 32 * kk + 8 * fq + 4);
#pragma unroll
            for (int jj = 0; jj < 4; ++jj) { qn += bf2f((unsigned short)qf[kk][jj]) * n0[jj]; qn += bf2f((unsigned short)qf[kk][4 + jj]) * n1[jj]; } }
        qn = rows_sum(qn);
        __builtin_amdgcn_sched_barrier(0);
#pragma unroll
        for (int i = 0; i < 4; ++i) k1r[i] = *(const v4u*)(Kp + (rb + 64) * DM + hh * 256 + (unsigned)(((tid >> 5) + 16 * i) * DM + 8 * (tid & 31)));
        float rsum = 0.f;
#pragma unroll
        for (int half = 0; half < 2; ++half) {
            if (half == 1) {
                __syncthreads();
#pragma unroll
                for (int i = 0; i < 4; ++i) { const int cc = tid + NTHR * i; *(LAS v4u*)(KL + (cc >> 5) * 264 + 8 * (cc & 31)) = k1r[i]; }
                LDS_WAIT(); __syncthreads();
            }
            if (half == scan_half && wave == scan_wave && has_next) ml2_scan(arn, gn[0], gn[1], gn[2], gn[3], arr[641], dir, lane);
#pragma unroll
            for (int pp = 0; pp < 2; ++pp) {
                const int p = 2 * half + pp, ta = 2 * p, tbb = 2 * p + 1;
                const bool na = dir ? ta >= wave : ta <= wave, nb = dir ? tbb >= wave : tbb <= wave;
                if (!na && !nb) continue;
                float pv[8];
#pragma unroll
                for (int which = 0; which < 2; ++which) {
                    const int st = which ? tbb : ta; const bool need = which ? nb : na;
                    f32x4 s4 = (f32x4){0.f, 0.f, 0.f, 0.f};
                    if (need) {
                        const LAS bf16* kb = KL + ((st & 3) * 16 + fr) * 264 + 8 * fq; bf16x8 ring[ML_DB];
#pragma unroll
                        for (int d = 0; d < ML_DB; ++d) ring[d] = *(const LAS bf16x8*)(kb + 32 * d);
#pragma unroll
                        for (int kk = 0; kk < 8; ++kk) {
                            __builtin_amdgcn_sched_barrier(0);
                            s4 = MFMA16(ring[kk % ML_DB], qf[kk], s4);
                            if (kk + ML_DB < 8) ring[kk % ML_DB] = *(const LAS bf16x8*)(kb + 32 * (kk + ML_DB));
                            __builtin_amdgcn_sched_barrier(0); }
                    }
                    if (need) {
                        const f32x4 a4 = *(const LAS f32x4*)(A_ + 16 * st + 4 * fq);
                        const int sgn = dir ? 1 : -1, d0 = sgn * (16 * st + 4 * fq - tl_), dlim = st == wave ? 0 : -(1 << 20);
#pragma unroll
                        for (int e = 0; e < 4; ++e) { float w = __expf(a4[e] - mm_t); w = (d0 + sgn * e >= dlim) ? w : 0.f;
                            pv[4 * which + e] = s4[e] * w; rsum += pv[4 * which + e]; }
                    } else {
#pragma unroll
                        for (int e = 0; e < 4; ++e) pv[4 * which + e] = 0.f; }
                }
                const bf16x8 pb = pack8(pv);
                {   const LAS bf16* vq = VTL + fr * 136 + 32 * p + 4 * fq; v2u rlo[ML_DV], rhi[ML_DV];
#pragma unroll
                    for (int d = 0; d < ML_DV; ++d) { rlo[d] = *(const LAS v2u*)(vq + (16 * d) * 136); rhi[d] = *(const LAS v2u*)(vq + (16 * d) * 136 + 16); }
#pragma unroll
                    for (int nt = 0; nt < 8; ++nt) {
                        __builtin_amdgcn_sched_barrier(0);
                        const v4u vv = (v4u){rlo[nt % ML_DV].x, rlo[nt % ML_DV].y, rhi[nt % ML_DV].x, rhi[nt % ML_DV].y}; o[nt] = MFMA16(__builtin_bit_cast(bf16x8, vv), pb, o[nt]);
                        if (nt + ML_DV < 8) { rlo[nt % ML_DV] = *(const LAS v2u*)(vq + (16 * (nt + ML_DV)) * 136); rhi[nt % ML_DV] = *(const LAS v2u*)(vq + (16 * (nt + ML_DV)) * 136 + 16); }
                        __builtin_amdgcn_sched_barrier(0); } }
            }
        }
        __builtin_amdgcn_sched_barrier(0);
#pragma unroll
        for (int mt = 0; mt < 2; ++mt) { const bf16* kp = KT + (size_t)(32 * wave + 16 * mt) * T + tok0 + (unsigned)(fr * T + 8 * fq);
#pragma unroll
            for (int kk = 0; kk < 4; ++kk) akr[mt][kk] = *(const v4u*)(kp + 32 * kk); }
        rsum = rows_sum(rsum);
        { const float den = rsum + g_t * qn; const float inv = 1.0f / fmaxf(fabsf(den), emt);
          bf16* op = HO + (rb + 16 * wave) * DM + hh * 256 + dvh * 128 + (unsigned)(fr * DM + 4 * fq);
#pragma unroll
          for (int nt = 0; nt < 8; ++nt) *(v2u*)(op + 16 * nt) = (v2u){pk2(o[nt][0] * inv, o[nt][1] * inv), pk2(o[nt][2] * inv, o[nt][3] * inv)}; }
        const float ge = arr[640];
        float nsum[2]; bf16x8 ak[2][4];
#pragma unroll
        for (int mt = 0; mt < 2; ++mt) { float ns = 0.f;
#pragma unroll
            for (int kk = 0; kk < 4; ++kk) { const v4u raw = akr[mt][kk]; const f32x4 w0 = *(const LAS f32x4*)(WE + 32 * kk + 8 * fq), w1 = *(const LAS f32x4*)(WE + 32 * kk + 8 * fq + 4);
                const unsigned rw[4] = {raw.x, raw.y, raw.z, raw.w}; float f[8];
#pragma unroll
                for (int e = 0; e < 4; ++e) { f[2 * e] = __uint_as_float(rw[e] << 16); f[2 * e + 1] = __uint_as_float(rw[e] & 0xffff0000u); }
                f[0] *= w0[0]; f[1] *= w0[1]; f[2] *= w0[2]; f[3] *= w0[3]; f[4] *= w1[0]; f[5] *= w1[1]; f[6] *= w1[2]; f[7] *= w1[3];
#pragma unroll
                for (int e = 0; e < 8; ++e) ns += f[e];
                ak[mt][kk] = pack8(f); }
            nsum[mt] = rows_sum(ns); }
        {   const LAS bf16* vb = VTL + fr * 136 + 8 * fq; bf16x8 ring[ML_DC];
#define ML_C_RD(i_) (*(const LAS bf16x8*)(vb + (16 * ((i_) >> 2)) * 136 + 32 * ((i_) & 3)))
#pragma unroll
            for (int d = 0; d < ML_DC; ++d) ring[d] = ML_C_RD(d);
#pragma unroll
            for (int i = 0; i < 32; ++i) { const int nt = i >> 2, kk = i & 3;
                __builtin_amdgcn_sched_barrier(0);
                if (kk == 0) { C[0][nt] = C[0][nt] * ge; C[1][nt] = C[1][nt] * ge; }
                C[0][nt] = MFMA16(ak[0][kk], ring[i % ML_DC], C[0][nt]); C[1][nt] = MFMA16(ak[1][kk], ring[i % ML_DC], C[1][nt]);
                if (i + ML_DC < 32) ring[i % ML_DC] = ML_C_RD(i + ML_DC);
                __builtin_amdgcn_sched_barrier(0); }
#undef ML_C_RD
        }
#pragma unroll
        for (int mt = 0; mt < 2; ++mt) {
#pragma unroll
            for (int nt = 0; nt < 8; ++nt) *(LAS v2u*)(CTL + (16 * nt + fr) * 264 + 32 * wave + 16 * mt + 4 * fq) = (v2u){pk2(C[mt][nt][0], C[mt][nt][1]), pk2(C[mt][nt][2], C[mt][nt][3])};
            if (fq == 0) { const int dk = 32 * wave + 16 * mt + fr; NV[dk] = ge * NV[dk] + nsum[mt]; }
        }
    }
    if (kind == 0) {
        float* oc = a.out + 83918848 + ((size_t)((b * 2 + dir) * 8 + hh) * 256) * 256 + dvh * 128;
#pragma unroll
        for (int mt = 0; mt < 2; ++mt)
#pragma unroll
            for (int nt = 0; nt < 8; ++nt)
#pragma unroll
                for (int e = 0; e < 4; ++e) oc[(unsigned)((32 * wave + 16 * mt + 4 * fq + e) * 256 + 16 * nt + fr)] = C[mt][nt][e];
        if (dvh == 0) { LDS_WAIT(); __syncthreads();
            if (tid < 256) a.out[100696064 + (size_t)((b * 2 + dir) * 8 + hh) * 256 + tid] = NV[tid];
            if (tid == 0) a.out[100761600 + (b * 2 + dir) * 8 + hh] = ((LAS float*)(lds + (((nch - 1) & 1) ? ML2_ARR1 : ML2_ARR0)))[641]; }
    }
}

#ifndef WGM_G1
#define WGM_G1 4
#endif
#ifndef WGM_N8
#define WGM_N8 4
#endif
template <int L, int F, bool FIRST>
__device__ __forceinline__ void ffn_gemm1(const Args& a, LAS unsigned char* lds, int G) {
    pg8::Gemm g{(const bf16*)(a.ws + WS_H), (const bf16*)(a.ws + (F == 0 ? WS_W1A : WS_W1B)), MT, 2 * DFF, DM / 2}; pg8::StaticOrder S; S.init(MT, 2 * DFF, G, (int)blockIdx.x, WGM_G1);
    pg8::EpiGluQ E{a.ws + WS_ACT, (const float*)(a.ws + WS_SA), (const float*)(a.ws + WS_SB1) + (F == 0 ? 0 : 11264)};
    pg8::gemm_phase<pg8::EpiGluQ, pg8::StaticOrder, PG8_ALIGN, PG8_SP2, 1>(lds, g, S, E);
}
template <int L, int F, bool FIRST>
__device__ __forceinline__ void ffn_gemm2(const Args& a, LAS unsigned char* lds, int G) {
    pg8::Gemm g{(const bf16*)(a.ws + WS_ACT), (const bf16*)(a.ws + (F == 0 ? WS_W2A : WS_W2B)), MT, DM, DFF / 2}; pg8::StaticOrder S; S.init(MT, DM, G, (int)blockIdx.x, WGM_N8);
    const float* modg = (const float*)(a.ws + WS_MOD) + (size_t)L * 9 * MODS + (size_t)(F == 0 ? 2 : 8) * DM;
    constexpr bool LAST = (L == 1 && F == 1);
    typedef pg8::EpiRes2<FIRST, LAST, true> EpiT;
    EpiT E{FIRST ? (const void*)a.in[0] : (LAST ? (const void*)(a.ws + WS_XB2) : (const void*)a.out), FIRST ? (const void*)(a.in[1] - (size_t)MP * DM) : nullptr, a.out, modg, (const float*)(a.ws + WS_SB2) + (F == 0 ? 0 : 2048), nullptr, LAST ? DM : XPITCH, XPITCH, 0.5f};
    pg8::gemm_phase<EpiT, pg8::StaticOrder, PG8_ALIGN, PG8_SP2, 2>(lds, g, S, E);
}
#define FFN_NORM norm_pass_q
#define FFN_CONV_ITEMS 416
#define FFN_CONV(l, f, slot, it) ffn_quant_item(a, l, f, slot, it, lds, wave, lane, tid)
__global__ void __launch_bounds__(NTHR, 2) fwd_kernel(Args a) {
    extern __shared__ __attribute__((aligned(16))) unsigned char lds_raw[];
    LAS unsigned char* lds = (LAS unsigned char*)lds_raw;
    const int tid = threadIdx.x, lane = tid & 63, wave = __builtin_amdgcn_readfirstlane(tid >> 6);
    const int G = gridDim.x;
    volatile LAS unsigned* MISC = (volatile LAS unsigned*)(lds + MISC_OFF);
    if (tid < 64) MISC[tid] = 0u;
    __syncthreads();
#if MK_ONE_LAUNCH
    XcdBarrier bar = xcd_barrier_post((unsigned*)(a.ws + WS_CTL) + CW_BAR, MISC + 8);
#define GRID_BAR() xcd_barrier(bar)
#else
#define GRID_BAR() do { } while (0)
#endif
    const int lo = a.ph_lo, hi = a.ph_hi;
#define IN(k) (lo <= (k) && (k) < hi)
#define SEAM(k) do { if (IN(k) && IN((k) + 1)) GRID_BAR(); } while (0)
    const int NGW = G * NWAVES, gw = blockIdx.x * NWAVES + wave;

    if (IN(0)) { phase_p0(a, lds, G, wave, lane, tid); } SEAM(0);
    if (IN(1)) { FFN_NORM<true>(a, 0, 0, G, wave, lane); } SEAM(1);
    if (IN(2)) { ffn_gemm1<0, 0, true>(a, lds, G); } SEAM(2);
    if (IN(3)) { ffn_gemm2<0, 0, true>(a, lds, G); } SEAM(3);
    if (IN(4)) { norm_pass<false>(a, 0, 1, G, wave, lane);
        for (int it = blockIdx.x; it < FFN_CONV_ITEMS; it += G) FFN_CONV(1, 0, 0, it); }
    if (IN(5)) { pg8::Gemm g{(const bf16*)(a.ws + WS_H), (const bf16*)(a.ws + WS_WINAB), MT, 5120, DM}; pg8::StaticOrder S; S.init(MT, 5120, G, (int)blockIdx.x);
        pg8::EpiBf16<0> E{(bf16*)(a.ws + WS_Z), 5120, nullptr, 0, 0, 1.f};
        pg8::gemm_phase<pg8::EpiBf16<0>, pg8::StaticOrder, PG8_ALIGN, PG8_SP2>(lds, g, S, E); } SEAM(5);
    if (IN(6)) { for (int it = blockIdx.x; it < 1152; it += G) lru_item<1>(a, it >> 3, it & 7, lds, wave, lane, tid);
        { int ib, ni; tail_ids(1152, G, ib, ni); if (ib >= 0) for (int it = ib; it < 576; it += ni) ab_post_item(a, it, lds, wave, lane); } } SEAM(6);
    if (IN(7)) { { for (int it = blockIdx.x; it < 1152; it += G) lru_item<2>(a, it >> 3, it & 7, lds, wave, lane, tid); }
        { const int xu = (G % 8 == 0) ? ((int)blockIdx.x % 8) * (G / 8) + (int)blockIdx.x / 8 : (int)blockIdx.x;
          for (int u = xu; u < 2048; u += G) attn_block(a, 1, u >> 8, (u >> 5) & 7, u & 31, lds, wave, lane, tid);
        { int ib, ni; tail_ids(1152, G, ib, ni); if (ib >= 0) for (int u = ib; u < 256; u += ni) attn_block(a, 0, u >> 4, (u >> 1) & 7, u & 1, lds, wave, lane, tid); } } } SEAM(7);
    if (IN(8)) { pg8::Gemm g{(const bf16*)(a.ws + WS_H), (const bf16*)(a.ws + WS_WOUTAB), MT, DM, DM}; pg8::StaticOrder S; S.init(MT, DM, G, (int)blockIdx.x, WGM_N8);
        typedef pg8::EpiRes2<false, false, false> EpiT; EpiT E{a.out, nullptr, a.out, (const float*)(a.ws + WS_MOD) + 5 * DM, nullptr, nullptr, XPITCH, XPITCH, 1.0f};
        pg8::gemm_phase<EpiT, pg8::StaticOrder, PG8_ALIGN, PG8_SP2>(lds, g, S, E); } SEAM(8);
    if (IN(9)) { FFN_NORM<false>(a, 0, 2, G, wave, lane); } SEAM(9);
    if (IN(10)) { ffn_gemm1<0, 1, false>(a, lds, G); } SEAM(10);
    if (IN(11)) { ffn_gemm2<0, 1, false>(a, lds, G); } SEAM(11);
    if (IN(12)) { FFN_NORM<false>(a, 1, 0, G, wave, lane);
        for (int it = blockIdx.x; it < FFN_CONV_ITEMS; it += G) FFN_CONV(1, 1, 1, it); }
    if (IN(13)) { ffn_gemm1<1, 0, false>(a, lds, G); } SEAM(13);
    if (IN(14)) { ffn_gemm2<1, 0, false>(a, lds, G); } SEAM(14);
    if (IN(15)) { norm_pass_dual<false>(a, 1, 1, G, wave, lane); } SEAM(15);
    if (IN(16)) {
        { pg8::Gemm g{(const bf16*)(a.ws + WS_H), (const bf16*)(a.ws + WS_WINC), MT, 4352, DM}; pg8::StaticOrder S; S.init(MT, 4352, G, (int)blockIdx.x);
          typedef pg8::EpiProj<false, 1> EpiT; EpiT E{(bf16*)(a.ws + WS_PL), (float*)(a.ws + WS_GATES), nullptr, nullptr};
          pg8::gemm_phase<EpiT, pg8::StaticOrder, PG8_ALIGN, PG8_SP2>(lds, g, S, E); }
        { pg8::Gemm g{(const bf16*)(a.ws + WS_H8M), (const bf16*)(a.ws + WS_WQC), MT, 4096, DM / 2}; pg8::StaticOrder S; S.init(MT, 4096, G, G - 1 - (int)blockIdx.x);
          typedef pg8::EpiProj<true, 1> EpiT; EpiT E{(bf16*)(a.ws + WS_PL), nullptr, (const float*)(a.ws + WS_SA), (const float*)(a.ws + WS_SBQC)};
          pg8::gemm_phase<EpiT, pg8::StaticOrder, PG8_ALIGN, PG8_SP2, 1>(lds, g, S, E); } } SEAM(16);
    if (IN(17)) { for (int it = blockIdx.x; it < 576; it += G) c_post_item(a, it, lds, wave, lane, tid); } SEAM(17);
    if (IN(18)) {
        const int xu = (G % 8 == 0) ? ((int)blockIdx.x % 8) * (G / 8) + (int)blockIdx.x / 8 : (int)blockIdx.x;
        for (int u = xu; u < 256; u += G) mlstm_unit2(a, 1, u >> 5, (u >> 2) & 7, (u >> 1) & 1, u & 1, lds, wave, lane, tid);
        for (int u = xu; u < 512; u += G) mlstm_unit2(a, 0, u >> 5, (u >> 2) & 7, (u >> 1) & 1, u & 1, lds, wave, lane, tid); } SEAM(18);
    if (IN(19)) { c_final_pass(a, G, wave, lane); } SEAM(19);
    if (IN(20)) { pg8::Gemm g{(const bf16*)(a.ws + WS_H), (const bf16*)(a.ws + WS_WQOC), MT, DM, DM / 2}; pg8::StaticOrder S; S.init(MT, DM, G, (int)blockIdx.x, WGM_N8);
        typedef pg8::EpiRes2<false, false, true, true> EpiT; EpiT E{a.out, nullptr, a.ws + WS_XB2, (const float*)(a.ws + WS_MOD) + (size_t)9 * MODS + 5 * DM, (const float*)(a.ws + WS_SBOC), (const float*)(a.ws + WS_SA), XPITCH, DM, 1.0f};
        pg8::gemm_phase<EpiT, pg8::StaticOrder, PG8_ALIGN, PG8_SP2, 1>(lds, g, S, E); } SEAM(20);
    if (IN(21)) { FFN_NORM<false, true>(a, 1, 2, G, wave, lane); } SEAM(21);
    if (IN(22)) { ffn_gemm1<1, 1, false>(a, lds, G); } SEAM(22);
    if (IN(23)) { ffn_gemm2<1, 1, false>(a, lds, G); }
#undef IN
#undef SEAM
}

extern "C" void kernel_launch(void* const* d_in, const int* in_sizes, int n_in, void* d_out, int out_size, void* d_ws, size_t ws_size, hipStream_t stream) {
    static int grid = 0;
    if (grid == 0) {
        if (n_in != 32 || out_size != 100761856 || ws_size < WS_END) { fprintf(stderr, "kernel_launch: unexpected problem (n_in %d, out %d, ws %zu < %zu)\n", n_in, out_size, ws_size, (size_t)WS_END); grid = -1; return; }
        int dev = 0, cus = 0, per_cu = 0;
        if (hipGetDevice(&dev) != hipSuccess || hipDeviceGetAttribute(&cus, hipDeviceAttributeMultiprocessorCount, dev) != hipSuccess) { grid = -1; return; }
        if (hipFuncSetAttribute((const void*)fwd_kernel, hipFuncAttributeMaxDynamicSharedMemorySize, LDS_BYTES) != hipSuccess) { fprintf(stderr, "kernel_launch: hipFuncSetAttribute failed\n"); grid = -1; return; }
        if (hipOccupancyMaxActiveBlocksPerMultiprocessor(&per_cu, (const void*)fwd_kernel, NTHR, LDS_BYTES) != hipSuccess || per_cu < 1) fprintf(stderr, "kernel_launch: occupancy query says %d\n", per_cu);
        (void)hipGetLastError();
        grid = cus;
    }
    if (grid < 0) return;
    (void)hipMemsetAsync((char*)d_ws + WS_CTL, 0, CTL_ZERO_BYTES, stream);
    Args a{};
    for (int i = 0; i < 32; ++i) a.in[i] = (const float*)d_in[i];
    a.out = (float*)d_out; a.ws = (unsigned char*)d_ws;
#if MK_ONE_LAUNCH
    a.ph_lo = 0; a.ph_hi = N_PHASES;
    hipLaunchKernelGGL(fwd_kernel, dim3(grid), dim3(NTHR), LDS_BYTES, stream, a);
#else
    for (int p = 0; p < N_PHASES; ++p) { a.ph_lo = p; a.ph_hi = p + 1; hipLaunchKernelGGL(fwd_kernel, dim3(grid), dim3(NTHR), LDS_BYTES, stream, a); }
#endif
}
```

```cpp
#include <hip/hip_runtime.h>
#include <cstdio>
#include <cstdint>
#define MK_ONE_LAUNCH 1

namespace pg8 {
#define PG8_LAS __attribute__((address_space(3)))
typedef unsigned short bf16_t;
typedef short bf16x8 __attribute__((ext_vector_type(8)));
typedef float f32x4 __attribute__((ext_vector_type(4)));
typedef unsigned u32x4 __attribute__((ext_vector_type(4)));
typedef int i32x4 __attribute__((ext_vector_type(4)));
typedef int i32x8 __attribute__((ext_vector_type(8)));
constexpr int BM = 256, BK = 64, HALF = 128, HTB = HALF * BK * 2  , STAGE_BYTES = 8 * HTB, NXCD = 8, WGM = 4;

__host__ __device__ __forceinline__ int lds_byte(int r, int c) { const int st = (r >> 4) * 2 + (c >> 5), rr = r & 15, cc = c & 31, ob = rr * 64 + cc * 2; return st * 1024 + (ob ^ (((ob >> 9) & 1) << 5)); }
__host__ __device__ __forceinline__ void stage_rc(int b, int& R, int& C) { const int st = b / 1024, sb = b % 1024, swz = sb ^ (((sb >> 9) & 1) << 5); R = (st >> 1) * 16 + swz / 64; C = (st & 1) * 32 + (swz % 64) / 2; }
__host__ __device__ __forceinline__ int perm32(int rho) { const int n = rho >> 4, i = rho & 15; return 8 * (i >> 2) + 4 * n + (i & 3); }

struct Unit { int pm, pn; };
struct Gemm { const bf16_t* A; const bf16_t* Bt; int M, N, K; };

struct StaticOrder {
    int nM, nN, nwg, G, c, wgm;
    __host__ __device__ void init(int M, int N, int G_, int c_, int wgm_ = WGM) { nM = M / BM; nN = N / BM; nwg = nM * nN; G = G_; c = c_; wgm = wgm_; }
    __host__ __device__ bool next(int i, Unit& u) const {
        const long L = (long)i * G + c; if (L >= nwg) return false;
        int wgid = (int)L; { const int q = nwg / NXCD, r = nwg % NXCD, xcd = wgid % NXCD, off = wgid / NXCD; wgid = (xcd < r ? xcd * (q + 1) : r * (q + 1) + (xcd - r) * q) + off; }
        const int nig = wgm * nN, gid = wgid / nig, fm = gid * wgm, gsz = (nM - fm) < wgm ? (nM - fm) : wgm;
        u.pm = fm + ((wgid % nig) % gsz); u.pn = (wgid % nig) / gsz; return true;
    }
    __device__ __forceinline__ void a_ready(const Unit&) const {}
    __device__ __forceinline__ void done(const Unit&) const {}
};

__device__ __forceinline__ unsigned cvt_pk_bf16(float lo, float hi) { unsigned r; asm volatile("v_cvt_pk_bf16_f32 %0, %1, %2" : "=v"(r) : "v"(lo), "v"(hi)); return r; }
typedef float f32x2 __attribute__((ext_vector_type(2)));
__device__ __forceinline__ f32x2 gelu_pk(f32x2 v) {
    const f32x2 av = __builtin_elementwise_abs(v), d = av * 0.2316418882f + 1.0f;
    f32x2 t; t.x = __builtin_amdgcn_rcpf(d.x); t.y = __builtin_amdgcn_rcpf(d.y);
    f32x2 q = t * 0.5307027145f + (-0.7265760135f); q = q * t + 0.7107068705f; q = q * t + (-0.142248368f); q = q * t + 0.127414796f; q = q * t;
    const f32x2 s = (v * v) * (-0.72134752044f);
    f32x2 e; e.x = __builtin_amdgcn_exp2f(s.x); e.y = __builtin_amdgcn_exp2f(s.y);
    const f32x2 m = v * (q * e), r = v - m;
    f32x2 o; o.x = v.x < 0.f ? m.x : r.x; o.y = v.y < 0.f ? m.y : r.y; return o;
}

template <int ACT  > struct EpiBf16 {
    static constexpr bool PERM = true, AFTER_DRAIN = false; static_assert(ACT == 0 || ACT == 1, "EpiBf16: ACT is 0 (none) or 1 (gelu_pk)");
    bf16_t* O; int ldc; const float* bias; int split_cols; size_t split_stride; float scale0;
    __device__ __forceinline__ void operator()(const f32x4 (&acc)[2][2][4][2], const Unit& u, int wr, int wc, int fr, int fq) const {
        const int row0 = u.pm * BM + wr * 64 + fr; int colt = u.pn * BM; bf16_t* base = O;
        float sc = 1.f; if (split_cols) { const int t = colt / split_cols; base += (size_t)t * split_stride; colt -= t * split_cols; if (t == 0) sc = scale0; }
        const int col0 = colt + wc * 32 + 8 * fq, bcol0 = u.pn * BM + wc * 32 + 8 * fq;
        f32x4 bv[2][2];
#pragma unroll
        for (int bj = 0; bj < 2; ++bj)
#pragma unroll
            for (int n = 0; n < 2; ++n) bv[bj][n] = bias ? *(const f32x4*)(bias + bcol0 + bj * HALF + 4 * n) : (f32x4){0.f, 0.f, 0.f, 0.f};
#pragma unroll
        for (int ai = 0; ai < 2; ++ai)
#pragma unroll
            for (int m = 0; m < 4; ++m) { bf16_t* rowp = base + (size_t)(row0 + ai * HALF + m * 16) * ldc + col0;
#pragma unroll
                for (int bj = 0; bj < 2; ++bj) { f32x4 v0 = acc[ai][bj][m][0] + bv[bj][0], v1 = acc[ai][bj][m][1] + bv[bj][1];
                    if (ACT == 1) { f32x2 a = gelu_pk((f32x2){v0[0], v0[1]}), b = gelu_pk((f32x2){v0[2], v0[3]}), c = gelu_pk((f32x2){v1[0], v1[1]}), d = gelu_pk((f32x2){v1[2], v1[3]});
                        v0 = (f32x4){a.x, a.y, b.x, b.y}; v1 = (f32x4){c.x, c.y, d.x, d.y}; }
                    v0 = v0 * sc; v1 = v1 * sc; u32x4 w; w.x = cvt_pk_bf16(v0[0], v0[1]); w.y = cvt_pk_bf16(v0[2], v0[3]); w.z = cvt_pk_bf16(v1[0], v1[1]); w.w = cvt_pk_bf16(v1[2], v1[3]);
                    *(u32x4*)(rowp + bj * HALF) = w; } }
    }
};

constexpr int EP_M = 36864, EP_D = 2048, EP_FF = 5632, EP_MODS = 9 * 2048;
__device__ __forceinline__ int set_of_pm(int pm) { return pm < 16 ? 0 : 1 + ((pm - 16) >> 4); }
__device__ __forceinline__ unsigned pk4_fp8(float a, float b, float c, float d) { int w = 0; w = __builtin_amdgcn_cvt_pk_fp8_f32(a, b, w, false); w = __builtin_amdgcn_cvt_pk_fp8_f32(c, d, w, true); return (unsigned)w; }
struct EpiGluQ {
    static constexpr bool PERM = true, AFTER_DRAIN = false;
    unsigned char* O; const float* sa; const float* sb;
    __device__ __forceinline__ void operator()(const f32x4 (&acc)[2][2][4][2], const Unit& u, int wr, int wc, int fr, int fq) const {
        const int row0 = u.pm * BM + wr * 64 + fr, col0 = u.pn * HALF + wc * 32 + 8 * fq, brow = u.pn * BM + wc * 32 + 8 * fq;
        float sr[2][4];
#pragma unroll
        for (int ai = 0; ai < 2; ++ai)
#pragma unroll
            for (int m = 0; m < 4; ++m) sr[ai][m] = sa[row0 + ai * HALF + m * 16];
        const f32x4 sg0 = *(const f32x4*)(sb + brow), sg1 = *(const f32x4*)(sb + brow + 4), su0 = *(const f32x4*)(sb + brow + HALF), su1 = *(const f32x4*)(sb + brow + HALF + 4);
        typedef unsigned u32x2 __attribute__((ext_vector_type(2))); typedef unsigned u32x4_ __attribute__((ext_vector_type(4)));
        const int wcol = col0 - ((fq & 1) ? 8 : 0);
#pragma unroll
        for (int ai = 0; ai < 2; ++ai)
#pragma unroll
            for (int mp = 0; mp < 2; ++mp) { u32x2 pk[2];
#pragma unroll
                for (int mm = 0; mm < 2; ++mm) { const int m = 2 * mp + mm; const float s = sr[ai][m];
                    float v[8];
#pragma unroll
                    for (int n = 0; n < 2; ++n) { const i32x4 gi = __builtin_bit_cast(i32x4, acc[ai][0][m][n]), ui = __builtin_bit_cast(i32x4, acc[ai][1][m][n]);
#pragma unroll
                        for (int j = 0; j < 4; ++j) { const float g = (float)gi[j] * s * (n ? sg1[j] : sg0[j]), up = (float)ui[j] * s * (n ? su1[j] : su0[j]); v[4 * n + j] = g * up * __builtin_amdgcn_rcpf(1.0f + __expf(-g)); } }
                    pk[mm] = (u32x2){pk4_fp8(v[0], v[1], v[2], v[3]), pk4_fp8(v[4], v[5], v[6], v[7])}; }
                const auto sx = __builtin_amdgcn_permlane16_swap(pk[0].x, pk[1].x, false, false), sy = __builtin_amdgcn_permlane16_swap(pk[0].y, pk[1].y, false, false);
                const int row = row0 + ai * HALF + (2 * mp + (fq & 1)) * 16;
                *(u32x4_*)(O + (size_t)row * EP_FF + wcol) = (u32x4_){sx[0], sy[0], sx[1], sy[1]}; }
    }
};

template <bool F32> struct ResRaw { typedef f32x4 T; };
template <> struct ResRaw<false> { typedef unsigned T __attribute__((ext_vector_type(2))); };
template <bool BASE_F32, bool OUT_F32, bool QS, bool I8A = false> struct EpiRes2 {
    static constexpr bool PERM = false, AFTER_DRAIN = false;
    const void* base_p; const void* base_s; void* out; const float* modg; const float* sb; const float* sa; int bpitch, opitch; float coef;
    __device__ __forceinline__ void operator()(const f32x4 (&acc)[2][2][4][2], const Unit& u, int wr, int wc, int fr, int fq) const {
        typedef unsigned u32x2_ __attribute__((ext_vector_type(2)));
        typedef typename ResRaw<BASE_F32>::T RawT;
        constexpr int NB = 8, D = BASE_F32 ? 2 : 4;
        const int row0 = u.pm * BM + wr * 64 + fr, col0 = u.pn * BM + wc * 32 + 4 * fq;
        const float* gp = modg + (size_t)set_of_pm(u.pm) * EP_MODS + col0;
        const float* bf = (const float*)(u.pm < 16 ? base_p : base_s); const bf16_t* bh = (const bf16_t*)base_p;
        float rsv[NB];
        if (I8A) {
#pragma unroll
            for (int k = 0; k < NB; ++k) rsv[k] = sa[row0 + (k >> 2) * HALF + (k & 3) * 16]; }
        f32x4 gv[2][2], sv[2][2];
#pragma unroll
        for (int bj = 0; bj < 2; ++bj)
#pragma unroll
            for (int n = 0; n < 2; ++n) { gv[bj][n] = *(const f32x4*)(gp + bj * HALF + n * 16); if (QS) sv[bj][n] = *(const f32x4*)(sb + col0 + bj * HALF + n * 16); }
        typedef unsigned u32x4_ __attribute__((ext_vector_type(4)));
        const int wcol = col0 + ((fq & 1) ? 12 : 0);
#pragma unroll
        for (int g = 0; g < NB / D; ++g) {
            RawT raw[D][2][2]; u32x4_ raww[D][2];
#pragma unroll
            for (int d = 0; d < D; ++d) { const int k = g * D + d, row = row0 + (k >> 2) * HALF + (k & 3) * 16;
#pragma unroll
                for (int bj = 0; bj < 2; ++bj) {
                    if constexpr (BASE_F32) {
#pragma unroll
                        for (int n = 0; n < 2; ++n) raw[d][bj][n] = *(const RawT*)(bf + (size_t)row * EP_D + col0 + bj * HALF + n * 16); }
                    else raww[d][bj] = *(const u32x4_*)(bh + (size_t)row * bpitch + wcol + bj * HALF); } }
            if (g == 0) {
#pragma unroll
                for (int bj = 0; bj < 2; ++bj)
#pragma unroll
                    for (int n = 0; n < 2; ++n) { gv[bj][n] = gv[bj][n] * coef; if (QS) gv[bj][n] = gv[bj][n] * sv[bj][n]; } }
#pragma unroll
            for (int d = 0; d < D; ++d) { const int k = g * D + d, ai = k >> 2, m = k & 3, row = row0 + ai * HALF + m * 16; const float rs = I8A ? rsv[k] : 1.0f;
#pragma unroll
                for (int bj = 0; bj < 2; ++bj) {
                    u32x2_ bw[2];
                    if constexpr (!BASE_F32) { const auto sx = __builtin_amdgcn_permlane16_swap(raww[d][bj].x, raww[d][bj].z, false, false), sy = __builtin_amdgcn_permlane16_swap(raww[d][bj].y, raww[d][bj].w, false, false);
                        bw[0] = (u32x2_){sx[0], sy[0]}; bw[1] = (u32x2_){sx[1], sy[1]}; }
                    u32x2_ pk[2];
#pragma unroll
                    for (int n = 0; n < 2; ++n) { const int col = col0 + bj * HALF + n * 16; f32x4 b;
                        if constexpr (BASE_F32) b = raw[d][bj][n];
                        else { const u32x2_ w = bw[n]; b = (f32x4){__uint_as_float(w.x << 16), __uint_as_float(w.x & 0xffff0000u), __uint_as_float(w.y << 16), __uint_as_float(w.y & 0xffff0000u)}; }
                        f32x4 av = acc[ai][bj][m][n];
                        if (I8A) { const i32x4 iv = __builtin_bit_cast(i32x4, av); av = (f32x4){(float)iv[0], (float)iv[1], (float)iv[2], (float)iv[3]} * rs; }
                        f32x4 o = b + gv[bj][n] * av;
#ifdef PROBE_YSCALE
                        if (OUT_F32) o = o * PROBE_YSCALE;
#endif
                        if (OUT_F32) *(f32x4*)((float*)out + (size_t)row * EP_D + col) = o;
                        else pk[n] = (u32x2_){cvt_pk_bf16(o[0], o[1]), cvt_pk_bf16(o[2], o[3])}; }
                    if constexpr (!OUT_F32) { const auto sx = __builtin_amdgcn_permlane16_swap(pk[0].x, pk[1].x, false, false), sy = __builtin_amdgcn_permlane16_swap(pk[0].y, pk[1].y, false, false);
                        *(u32x4_*)((bf16_t*)out + (size_t)row * opitch + wcol + bj * HALF) = (u32x4_){sx[0], sy[0], sx[1], sy[1]}; } } }
        }
    }
};
template <bool I8, int WHICH> struct EpiProj {
    static constexpr bool PERM = true, AFTER_DRAIN = false;
    bf16_t* dst; float* gates; const float* sa; const float* sb;
    __device__ __forceinline__ void operator()(const f32x4 (&acc)[2][2][4][2], const Unit& u, int wr, int wc, int fr, int fq) const {
        const int row0 = u.pm * BM + wr * 64 + fr;
        if (!I8 && WHICH == 1 && u.pn == 16) {
            if (wc == 0) {
#pragma unroll
                for (int ai = 0; ai < 2; ++ai)
#pragma unroll
                    for (int m = 0; m < 4; ++m) { float* gp = gates + (size_t)(row0 + ai * HALF + m * 16) * 32 + 8 * fq; *(f32x4*)gp = acc[ai][0][m][0]; *(f32x4*)(gp + 4) = acc[ai][0][m][1]; }
            }
            return;
        }
        bf16_t* base; int pitch;
        if (WHICH == 0) { pitch = 5120; base = dst + (I8 ? (u.pn < 4 ? 256 * u.pn : 3072 + 256 * (u.pn - 4)) : 1024 + 256 * u.pn); }
        else { pitch = EP_D; base = dst + (size_t)(I8 ? (u.pn < 8 ? 0 : 3) : 1 + (u.pn >> 3)) * ((size_t)EP_M * EP_D) + 256 * (u.pn & 7); }
        const int col0 = wc * 32 + 8 * fq, brow = u.pn * BM + wc * 32 + 8 * fq;
        f32x4 sc[2][2]; float sr[2][4];
        if (I8) {
#pragma unroll
            for (int ai = 0; ai < 2; ++ai)
#pragma unroll
                for (int m = 0; m < 4; ++m) sr[ai][m] = sa[row0 + ai * HALF + m * 16];
#pragma unroll
            for (int bj = 0; bj < 2; ++bj) { sc[bj][0] = *(const f32x4*)(sb + brow + bj * HALF); sc[bj][1] = *(const f32x4*)(sb + brow + bj * HALF + 4); } }
#pragma unroll
        for (int ai = 0; ai < 2; ++ai)
#pragma unroll
            for (int m = 0; m < 4; ++m) { const int row = row0 + ai * HALF + m * 16; bf16_t* rowp = base + (size_t)row * pitch + col0; const float s = I8 ? sr[ai][m] : 1.0f;
#pragma unroll
                for (int bj = 0; bj < 2; ++bj) { f32x4 v0, v1;
                    if (I8) { const i32x4 i0 = __builtin_bit_cast(i32x4, acc[ai][bj][m][0]), i1 = __builtin_bit_cast(i32x4, acc[ai][bj][m][1]);
                        v0 = (f32x4){(float)i0[0], (float)i0[1], (float)i0[2], (float)i0[3]} * sc[bj][0] * s; v1 = (f32x4){(float)i1[0], (float)i1[1], (float)i1[2], (float)i1[3]} * sc[bj][1] * s; }
                    else { v0 = acc[ai][bj][m][0]; v1 = acc[ai][bj][m][1]; }
                    u32x4 w; w.x = cvt_pk_bf16(v0[0], v0[1]); w.y = cvt_pk_bf16(v0[2], v0[3]); w.z = cvt_pk_bf16(v1[0], v1[1]); w.w = cvt_pk_bf16(v1[2], v1[3]);
                    *(u32x4*)(rowp + bj * HALF) = w; } }
    }
};

template <class Epi, class Sched, bool ALIGN_EPI = false, bool SP2 = false, int MODE = 0  >
__device__ __forceinline__ void gemm_phase(PG8_LAS unsigned char* lds, const Gemm g, const Sched& S, const Epi& E) {
    int tid_ = threadIdx.x; asm volatile("" : "+v"(tid_));
    const int tid = tid_, wid = __builtin_amdgcn_readfirstlane(tid >> 6), lane = tid & 63, wr = wid >> 2, wc = wid & 3, fr = lane & 15, fq = lane >> 4;
    const int K = g.K, nt = K / BK;
    unsigned voffA[2], voffB[2];
#pragma unroll
    for (int i = 0; i < 2; ++i) { int R, C; stage_rc(tid * 16 + i * 8192, R, C); const int Rb = Epi::PERM ? ((R & ~31) + perm32(R & 31)) : R;
        voffA[i] = (unsigned)(R * K + C) * 2u; voffB[i] = (unsigned)(Rb * K + C) * 2u; }
    const size_t kstep = (size_t)(BK * 2);
    const size_t hstep = (size_t)HALF * K * 2;
    const size_t tstep = 2 * hstep;
    const unsigned ldsw = (unsigned)wid * 1024u;
    const int aoff = lds_byte(wr * 64 + fr, fq * 8), boff = lds_byte(wc * 32 + fr, fq * 8);
#define PG8_SA(b, h) (((b) * 2 + (h)) * HTB)
#define PG8_SB(b, h) ((4 + (b) * 2 + (h)) * HTB)
#define PG8_STAGE(bufoff, gbase, voff) do { _Pragma("unroll") for (int _i = 0; _i < 2; ++_i) \
        __builtin_amdgcn_global_load_lds((const unsigned*)((const char*)(gbase) + (voff)[_i]), (PG8_LAS unsigned*)(lds + (bufoff) + ldsw + _i * 8192), 16, 0, 0); } while (0)
#define PG8_LDA(dst, b, h) do { if constexpr (MODE == 2) { _Pragma("unroll") for (int m = 0; m < 4; ++m) { const i32x4 lo_ = *(const PG8_LAS i32x4*)(lds + PG8_SA(b, h) + aoff + m * 2048), hi_ = *(const PG8_LAS i32x4*)(lds + PG8_SA(b, h) + aoff + m * 2048 + 1024); dst##8[m] = __builtin_shufflevector(lo_, hi_, 0, 1, 2, 3, 4, 5, 6, 7); } } \
        else { _Pragma("unroll") for (int m = 0; m < 4; ++m) _Pragma("unroll") for (int k = 0; k < 2; ++k) dst[m][k] = *(const PG8_LAS bf16x8*)(lds + PG8_SA(b, h) + aoff + m * 2048 + k * 1024); } } while (0)
#define PG8_LDB(dst, b, h) do { if constexpr (MODE == 2) { _Pragma("unroll") for (int n = 0; n < 2; ++n) { const i32x4 lo_ = *(const PG8_LAS i32x4*)(lds + PG8_SB(b, h) + boff + n * 2048), hi_ = *(const PG8_LAS i32x4*)(lds + PG8_SB(b, h) + boff + n * 2048 + 1024); dst##8[n] = __builtin_shufflevector(lo_, hi_, 0, 1, 2, 3, 4, 5, 6, 7); } } \
        else { _Pragma("unroll") for (int n = 0; n < 2; ++n) _Pragma("unroll") for (int k = 0; k < 2; ++k) dst[n][k] = *(const PG8_LAS bf16x8*)(lds + PG8_SB(b, h) + boff + n * 2048 + k * 1024); } } while (0)
#define PG8_MMA(ai, bj, At, Bt) do { __builtin_amdgcn_s_setprio(1); _Pragma("unroll") for (int m = 0; m < 4; ++m) _Pragma("unroll") for (int n = 0; n < 2; ++n) { \
        if constexpr (MODE == 0) { _Pragma("unroll") for (int k = 0; k < 2; ++k) acc[ai][bj][m][n] = __builtin_amdgcn_mfma_f32_16x16x32_bf16(Bt[n][k], At[m][k], acc[ai][bj][m][n], 0, 0, 0); } \
        else if constexpr (MODE == 1) { _Pragma("unroll") for (int k = 0; k < 2; ++k) acc[ai][bj][m][n] = __builtin_bit_cast(f32x4, __builtin_amdgcn_mfma_i32_16x16x64_i8(__builtin_bit_cast(i32x4, Bt[n][k]), __builtin_bit_cast(i32x4, At[m][k]), __builtin_bit_cast(i32x4, acc[ai][bj][m][n]), 0, 0, 0)); } \
        else { asm volatile("v_mfma_f32_16x16x128_f8f6f4 %0, %1, %2, %0" : "+v"(acc[ai][bj][m][n]) : "v"(Bt##8[n]), "v"(At##8[m])); } } \
        __builtin_amdgcn_s_setprio(0); } while (0)
#define PG8_WAIT_V(n) asm volatile("s_waitcnt vmcnt(" #n ")" ::: "memory")
#define PG8_WAIT_L(n) asm volatile("s_waitcnt lgkmcnt(" #n ")" ::: "memory")
#define PG8_BAR __builtin_amdgcn_s_barrier()
#define PG8_SCHED __builtin_amdgcn_sched_barrier(0)
    Unit cur, nxt; int ui = 0;
    if (!S.next(0, cur)) return;
    f32x4 acc[2][2][4][2];
#pragma unroll
    for (int a = 0; a < 2; ++a)
#pragma unroll
        for (int b = 0; b < 2; ++b)
#pragma unroll
            for (int m = 0; m < 4; ++m)
#pragma unroll
                for (int n = 0; n < 2; ++n) acc[a][b][m][n] = (f32x4){0.f, 0.f, 0.f, 0.f};
    bf16x8 At[4][2], B0[2][2], B1[2][2]; i32x8 At8[4], B08[2], B18[2];
    const char* cA = (const char*)g.A + (size_t)cur.pm * tstep; const char* cB = (const char*)g.Bt + (size_t)cur.pn * tstep;
    S.a_ready(cur);
    if constexpr (SP2) {
        PG8_STAGE(PG8_SB(0, 0), cB, voffB); PG8_STAGE(PG8_SB(0, 1), cB + hstep, voffB); PG8_STAGE(PG8_SA(0, 0), cA, voffA); PG8_STAGE(PG8_SA(0, 1), cA + hstep, voffA);
        if (wr == 1) PG8_BAR;
        PG8_WAIT_V(2); PG8_BAR;
        PG8_STAGE(PG8_SB(1, 0), cB + kstep, voffB); PG8_STAGE(PG8_SA(1, 0), cA + kstep, voffA); PG8_STAGE(PG8_SB(1, 1), cB + hstep + kstep, voffB);
        PG8_WAIT_V(6); PG8_BAR;
    } else {
        PG8_STAGE(PG8_SB(0, 0), cB, voffB); PG8_STAGE(PG8_SA(0, 0), cA, voffA); PG8_STAGE(PG8_SB(0, 1), cB + hstep, voffB); PG8_STAGE(PG8_SA(0, 1), cA + hstep, voffA);
        if (wr == 1) PG8_BAR;
        PG8_WAIT_V(4); PG8_BAR;
        PG8_STAGE(PG8_SB(1, 0), cB + kstep, voffB); PG8_STAGE(PG8_SA(1, 0), cA + kstep, voffA); PG8_STAGE(PG8_SB(1, 1), cB + hstep + kstep, voffB);
        PG8_WAIT_V(6); PG8_BAR;
    }
    for (;;) {
        const bool has_next = S.next(ui + 1, nxt);
        const char* nA = has_next ? (const char*)g.A + (size_t)nxt.pm * tstep : cA; const char* nB = has_next ? (const char*)g.Bt + (size_t)nxt.pn * tstep : cB;
        for (int t = 0; t < nt; t += 2) {
            const bool last = (t == nt - 2);
            const char* a1 = cA + (size_t)(t + 1) * kstep;
            const char* a2 = last ? nA : cA + (size_t)(t + 2) * kstep; const char* b2 = last ? nB : cB + (size_t)(t + 2) * kstep;
            const char* a3 = a2 + kstep; const char* b3 = b2 + kstep;
            if (last && has_next) S.a_ready(nxt);
            if constexpr (SP2) {
            PG8_LDB(B0, 0, 0); PG8_LDB(B1, 0, 1); PG8_SCHED; PG8_LDA(At, 0, 0); PG8_STAGE(PG8_SA(1, 1), a1 + hstep, voffA);
            PG8_WAIT_V(8); PG8_WAIT_L(0); PG8_BAR; PG8_MMA(0, 0, At, B0); PG8_MMA(0, 1, At, B1); PG8_BAR; PG8_SCHED;
            PG8_LDA(At, 0, 1); PG8_STAGE(PG8_SB(0, 0), b2, voffB); PG8_STAGE(PG8_SB(0, 1), b2 + hstep, voffB); PG8_STAGE(PG8_SA(0, 0), a2, voffA);
            PG8_WAIT_V(8); PG8_WAIT_L(0); PG8_BAR; PG8_MMA(1, 0, At, B0); PG8_MMA(1, 1, At, B1); PG8_BAR; PG8_SCHED;
            PG8_LDB(B0, 1, 0); PG8_LDB(B1, 1, 1); PG8_SCHED; PG8_LDA(At, 1, 0); PG8_STAGE(PG8_SA(0, 1), a2 + hstep, voffA);
            PG8_WAIT_V(8); PG8_WAIT_L(0); PG8_BAR; PG8_MMA(0, 0, At, B0); PG8_MMA(0, 1, At, B1); PG8_BAR; PG8_SCHED;
            PG8_LDA(At, 1, 1); PG8_STAGE(PG8_SB(1, 0), b3, voffB); PG8_STAGE(PG8_SB(1, 1), b3 + hstep, voffB); PG8_STAGE(PG8_SA(1, 0), a3, voffA);
            PG8_WAIT_V(8); PG8_WAIT_L(0); PG8_BAR; PG8_MMA(1, 0, At, B0); PG8_MMA(1, 1, At, B1); PG8_BAR; PG8_SCHED;
            } else {
            PG8_LDB(B0, 0, 0); PG8_SCHED; PG8_LDA(At, 0, 0); PG8_STAGE(PG8_SA(1, 1), a1 + hstep, voffA);
            PG8_WAIT_L(8); PG8_BAR; PG8_WAIT_L(0); PG8_MMA(0, 0, At, B0); PG8_BAR; PG8_SCHED;
            PG8_LDB(B1, 0, 1); PG8_STAGE(PG8_SB(0, 0), b2, voffB);
            PG8_BAR; PG8_WAIT_L(0); PG8_MMA(0, 1, At, B1); PG8_BAR;
            PG8_LDA(At, 0, 1); PG8_STAGE(PG8_SA(0, 0), a2, voffA);
            PG8_BAR; PG8_WAIT_L(0); PG8_MMA(1, 0, At, B0); PG8_BAR; PG8_SCHED;
            PG8_STAGE(PG8_SB(0, 1), b2 + hstep, voffB);
            PG8_WAIT_V(6); PG8_BAR; PG8_MMA(1, 1, At, B1); PG8_BAR;
            PG8_LDB(B0, 1, 0); PG8_SCHED; PG8_LDA(At, 1, 0); PG8_STAGE(PG8_SA(0, 1), a2 + hstep, voffA);
            PG8_WAIT_L(8); PG8_BAR; PG8_WAIT_L(0); PG8_MMA(0, 0, At, B0); PG8_BAR; PG8_SCHED;
            PG8_LDB(B1, 1, 1); PG8_STAGE(PG8_SB(1, 0), b3, voffB);
            PG8_BAR; PG8_WAIT_L(0); PG8_MMA(0, 1, At, B1); PG8_BAR;
            PG8_LDA(At, 1, 1); PG8_STAGE(PG8_SA(1, 0), a3, voffA);
            PG8_BAR; PG8_WAIT_L(0); PG8_MMA(1, 0, At, B0); PG8_BAR; PG8_SCHED;
            PG8_STAGE(PG8_SB(1, 1), b3 + hstep, voffB);
            PG8_WAIT_V(6); PG8_BAR; PG8_MMA(1, 1, At, B1); PG8_BAR;
            }
        }
        if constexpr (MODE == 2) asm volatile("s_nop 15\n\ts_nop 15" ::: "memory");
        if constexpr (ALIGN_EPI) { if (wr == 0) PG8_BAR; }
        if constexpr (!Epi::AFTER_DRAIN) { E(acc, cur, wr, wc, fr, fq); S.done(cur); }
        if (!has_next) break;
#pragma unroll
        for (int a = 0; a < 2; ++a)
#pragma unroll
            for (int b = 0; b < 2; ++b)
#pragma unroll
                for (int m = 0; m < 4; ++m)
#pragma unroll
                    for (int n = 0; n < 2; ++n) acc[a][b][m][n] = (f32x4){0.f, 0.f, 0.f, 0.f};
        cur = nxt; cA = nA; cB = nB; ++ui;
        if constexpr (ALIGN_EPI) { if (wr == 1) PG8_BAR; }
    }
    PG8_WAIT_V(0);
    if constexpr (!ALIGN_EPI) { if (wr == 0) PG8_BAR; }
    PG8_BAR;
    if constexpr (Epi::AFTER_DRAIN) { E.fused(acc, cur, wr, wc, fr, fq, lds, wid, lane); S.done(cur); }
#undef PG8_SA
#undef PG8_SB
#undef PG8_STAGE
#undef PG8_LDA
#undef PG8_LDB
#undef PG8_MMA
#undef PG8_WAIT_V
#undef PG8_WAIT_L
#undef PG8_BAR
#undef PG8_SCHED
}
}

#ifndef PG8_SP2
#define PG8_SP2 true
#endif
#ifndef PG8_ALIGN
#define PG8_ALIGN true
#endif
#define GAS __attribute__((address_space(1)))
#define LAS __attribute__((address_space(3)))
typedef unsigned short bf16;
typedef unsigned v4u __attribute__((ext_vector_type(4)));
typedef unsigned v2u __attribute__((ext_vector_type(2)));
typedef float f32x4 __attribute__((ext_vector_type(4)));
typedef short bf16x8 __attribute__((ext_vector_type(8)));
#define LDS_WAIT() asm volatile("s_waitcnt lgkmcnt(0)" ::: "memory")
#define VM_WAIT() asm volatile("s_waitcnt vmcnt(0)" ::: "memory")
#define MFMA16(a, b, c) __builtin_amdgcn_mfma_f32_16x16x32_bf16((a), (b), (c), 0, 0, 0)

constexpr int NWAVES = 8, NTHR = 512;
constexpr int DM = 2048, MP = 4096, MS = 32768, MT = 36864, DFF = 5632, MODS = 9 * 2048;
constexpr float EPS = 1e-6f;
constexpr int N_PHASES = 24;
#ifndef MK_ONE_LAUNCH
#define MK_ONE_LAUNCH 1
#endif
constexpr size_t MiB = 1u << 20;
constexpr size_t WS_CTL = 0, CTL_ZERO_BYTES = 32768;
constexpr size_t WS_MOD = 1 * MiB, WS_ROPE = 3 * MiB, WS_LW = 4 * MiB, WS_KC = 5 * MiB, WS_VCT = 13 * MiB, WS_SUMW = 21 * MiB, WS_SUMB = 39 * MiB, WS_GATES = 42 * MiB;
constexpr size_t WS_W1A = 48 * MiB, WS_W2A = 92 * MiB, WS_W1B = 114 * MiB, WS_W2B = 158 * MiB, WS_WINAB = 180 * MiB, WS_WOUTAB = 200 * MiB, WS_WINC = 208 * MiB, WS_WOUTC = 241 * MiB;
constexpr size_t WS_H = 256 * MiB, WS_BIG = 400 * MiB;
constexpr size_t WS_ACT = WS_BIG;
constexpr size_t WS_Z = WS_BIG, WS_VTS = 760 * MiB, WS_VTP = 824 * MiB;
constexpr size_t WS_PL = WS_BIG, WS_KT = 976 * MiB, WS_HB = 1120 * MiB;
constexpr size_t WS_END = 1264 * MiB;
constexpr size_t WS_XB2 = 656 * MiB;
constexpr int XPITCH = 4096;
constexpr size_t WS_SA = 3 * MiB + 65536, WS_SB1 = 3 * MiB + 262144, WS_SB2 = 3 * MiB + 393216;
constexpr size_t WS_H8M = 1120 * MiB;
constexpr size_t WS_WQAB = 70 * MiB, WS_WQC = 76 * MiB;
constexpr size_t WS_SBQAB = 3 * MiB + 458752, WS_SBQC = 3 * MiB + 475136, WS_SBOC = 3 * MiB + 491520;
constexpr size_t WS_WQOC = 84 * MiB;
constexpr size_t PLANE = (size_t)MT * DM;
constexpr int CW_BAR = 4096;
constexpr int SCR_BYTES = 147456, MISC_OFF = SCR_BYTES, LDS_BYTES = SCR_BYTES + 256;

__device__ __forceinline__ float bf2f(unsigned short b) { return __uint_as_float(((unsigned)b) << 16); }
__device__ __forceinline__ unsigned f2bf(float f) { unsigned u = __float_as_uint(f); return (u + 0x7fffu + ((u >> 16) & 1u)) >> 16; }
typedef float f32x2c_t __attribute__((ext_vector_type(2))); typedef __bf16 bf16x2c_t __attribute__((ext_vector_type(2)));
__device__ __forceinline__ unsigned pk2(float lo, float hi) { const f32x2c_t v = {lo, hi}; return __builtin_bit_cast(unsigned, __builtin_convertvector(v, bf16x2c_t)); }
typedef unsigned u32x2s __attribute__((ext_vector_type(2)));
__device__ __forceinline__ float rows_max(float v) { u32x2s r = __builtin_amdgcn_permlane16_swap(__float_as_uint(v), __float_as_uint(v), false, false); v = fmaxf(__uint_as_float(r.x), __uint_as_float(r.y));
    r = __builtin_amdgcn_permlane32_swap(__float_as_uint(v), __float_as_uint(v), false, false); return fmaxf(__uint_as_float(r.x), __uint_as_float(r.y)); }
__device__ __forceinline__ float rows_sum(float v) { u32x2s r = __builtin_amdgcn_permlane16_swap(__float_as_uint(v), __float_as_uint(v), false, false); v = __uint_as_float(r.x) + __uint_as_float(r.y);
    r = __builtin_amdgcn_permlane32_swap(__float_as_uint(v), __float_as_uint(v), false, false); return __uint_as_float(r.x) + __uint_as_float(r.y); }
#define DPP_MOV(v, ctrl) __builtin_bit_cast(float, __builtin_amdgcn_update_dpp(0, __builtin_bit_cast(int, (v)), (ctrl), 0xf, 0xf, true))
__device__ __forceinline__ float wave_sum(float v) { v += DPP_MOV(v, 0xB1); v += DPP_MOV(v, 0x4E); v += DPP_MOV(v, 0x141); v += DPP_MOV(v, 0x140); return rows_sum(v); }
__device__ __forceinline__ float wave_max(float v) { v = fmaxf(v, DPP_MOV(v, 0xB1)); v = fmaxf(v, DPP_MOV(v, 0x4E)); v = fmaxf(v, DPP_MOV(v, 0x141)); v = fmaxf(v, DPP_MOV(v, 0x140)); return rows_max(v); }
__device__ __forceinline__ int set_of_row(int m) { return m < MP ? 0 : 1 + ((m - MP) >> 12); }
__device__ __forceinline__ float sigmoidf_(float x) { return __builtin_amdgcn_rcpf(1.0f + __expf(-x)); }

#define XB_TMO      128
#define XB_XCNT(j)  (256  + 64 * (j))
#define XB_XSUB(j)  (1280 + 64 * (j))
#define XB_XGEN(j)  (2304 + 64 * (j))
#define XB_TOP      3328
#define XB_TOPGEN   3392
#define XCD_BAR_WORDS 3456
#define XB_SPIN_CAP (1u << 18)

__device__ __forceinline__ unsigned xb_ld(unsigned* p)              { return __hip_atomic_load(p, __ATOMIC_RELAXED, __HIP_MEMORY_SCOPE_AGENT); }
__device__ __forceinline__ unsigned xb_add(unsigned* p, unsigned v) { return __hip_atomic_fetch_add(p, v, __ATOMIC_RELAXED, __HIP_MEMORY_SCOPE_AGENT); }
__device__ __forceinline__ unsigned xb_xcc_id() { return (unsigned)__builtin_amdgcn_s_getreg((3 << 11) | 20) & 0xFu; }
#define XB_SPIN(cond, bar) do { unsigned _sp = 0; while (cond) { __builtin_amdgcn_s_sleep(1); \
    if ((++_sp & 255u) == 0u) { if (xb_ld(&(bar)[XB_TMO])) break; if (_sp > XB_SPIN_CAP) { atomicAdd(&(bar)[XB_TMO], 1u); break; } } } } while (0)

struct XcdBarrier {
    unsigned* bar; unsigned x;
    volatile LAS unsigned* st;
};

__device__ __forceinline__ XcdBarrier xcd_barrier_post(unsigned* bar, volatile LAS unsigned* st) {
    XcdBarrier b; b.bar = bar; b.x = xb_xcc_id(); b.st = st;
    if (threadIdx.x == 0) (void)xb_add(&bar[XB_XCNT(b.x)], 1u);
    return b;
}
__device__ __forceinline__ void xcd_barrier_complete(unsigned* bar, unsigned x, unsigned& nloc, unsigned& nx) {
    const unsigned G = gridDim.x * gridDim.y * gridDim.z;
    unsigned sum, cnt, mine, sp = 0u;
    for (;;) {
        sum = 0u; cnt = 0u; mine = 0u;
#pragma unroll
        for (unsigned j = 0; j < 16; ++j) { const unsigned c = xb_ld(&bar[XB_XCNT(j)]); sum += c; cnt += (c > 0u) ? 1u : 0u; mine = (j == x) ? c : mine; }
        if (sum == G) break;
        __builtin_amdgcn_s_sleep(1);
        if ((++sp & 255u) == 0u) { if (xb_ld(&bar[XB_TMO])) break; if (sp > XB_SPIN_CAP) { atomicAdd(&bar[XB_TMO], 1u); break; } }
    }
    nloc = mine > 0u ? mine : 1u; nx = cnt > 0u ? cnt : 1u;
}

__device__ __forceinline__ void xcd_barrier(const XcdBarrier& b) {
    asm volatile("s_waitcnt vmcnt(0)" ::: "memory");
    __syncthreads();
    if (threadIdx.x == 0) {
        unsigned* bar = b.bar;
        __builtin_amdgcn_s_waitcnt(0);
        unsigned nloc = b.st[0], nx = b.st[1];
        if (nloc == 0u) { xcd_barrier_complete(bar, b.x, nloc, nx); b.st[0] = nloc; b.st[1] = nx; }
        const unsigned old = xb_add(&bar[XB_XSUB(b.x)], 1u);
        const unsigned gen = old / nloc;
        if (old + 1u == (gen + 1u) * nloc) {
            __builtin_amdgcn_fence(__ATOMIC_RELEASE, "agent");
            asm volatile("s_waitcnt vmcnt(0)" ::: "memory");
            const unsigned og = xb_add(&bar[XB_TOP], 1u);
            const unsigned tg = og / nx;
            if (og + 1u == (tg + 1u) * nx) xb_add(&bar[XB_TOPGEN], 1u);
            else XB_SPIN(xb_ld(&bar[XB_TOPGEN]) == tg, bar);
            __builtin_amdgcn_fence(__ATOMIC_ACQUIRE, "agent");
            xb_add(&bar[XB_XGEN(b.x)], 1u);
            asm volatile("s_waitcnt vmcnt(0)" ::: "memory");
        } else {
            XB_SPIN(xb_ld(&bar[XB_XGEN(b.x)]) == gen, bar);
            __builtin_amdgcn_fence(__ATOMIC_ACQUIRE, "agent");
            asm volatile("s_waitcnt vmcnt(0)" ::: "memory");
        }
    }
    __syncthreads();
}


struct Args { const float* in[32]; float* out; unsigned char* ws; int ph_lo, ph_hi; };

__device__ __forceinline__ void xpose_sub(const float* src, int ldw, bf16* dst, int K, int k0, bool zero, LAS float* scr, int lane, float wsc = 1.0f) {
    const int c = lane & 7;
    if (zero) {
#pragma unroll
        for (int j = 0; j < 4; ++j) { const int n = (lane >> 3) + 8 * j; *(v4u*)(dst + (size_t)n * K + k0 + 8 * c) = (v4u){0u, 0u, 0u, 0u}; }
        return;
    }
    { float t32[32]; const float* p = src + (size_t)(k0 + (lane >> 5)) * ldw + (lane & 31);
#pragma unroll
      for (int i = 0; i < 32; ++i) t32[i] = p[(size_t)(2 * i) * ldw];
#pragma unroll
      for (int i = 0; i < 32; ++i) scr[(2 * i + (lane >> 5)) * 33 + (lane & 31)] = t32[i]; }
    LDS_WAIT(); asm volatile("" ::: "memory");
#pragma unroll
    for (int j = 0; j < 4; ++j) { const int n = (lane >> 3) + 8 * j; const LAS float* s = scr + (8 * c) * 33 + n;
        v4u o; o.x = pk2(s[0 * 33] * wsc, s[1 * 33] * wsc); o.y = pk2(s[2 * 33] * wsc, s[3 * 33] * wsc); o.z = pk2(s[4 * 33] * wsc, s[5 * 33] * wsc); o.w = pk2(s[6 * 33] * wsc, s[7 * 33] * wsc);
        *(v4u*)(dst + (size_t)n * K + k0 + 8 * c) = o; }
    LDS_WAIT(); asm volatile("" ::: "memory");
}
__device__ __forceinline__ void xpose_run(const float* s0, const float* s1, bf16* dst, int ldw, int K, int nblk, int mode, int sub, LAS float* scr, int lane) {
    const int kb = sub / nblk, nb = sub - kb * nblk, n0 = nb * 32;
    const float* sp; bool zero = false;
    if (mode == 1) { const int pn = n0 >> 8, r = n0 & 255; sp = (r < 128 ? s0 : s1) + pn * 128 + (r & 127); }
    else { sp = s0 + n0; if (mode == 2 && n0 >= 8224) zero = true; }
    xpose_sub(sp, ldw, dst + (size_t)n0 * K, K, kb * 64, zero, scr, lane);
}
template <int FMT>
__device__ __forceinline__ void quant_item(const float* sp, int ldw, int K, unsigned char* dst  , float* sbv  , LAS unsigned char* lds, int wave, int lane, int tid) {
    LAS float* scr = (LAS float*)(lds + wave * 8448); LAS float* pm = (LAS float*)(lds + 67584);
    const int kper = K >> 3, nsub = kper >> 6, kbase = wave * kper;
    const float QMAX = FMT == 1 ? 127.0f : 240.0f;
    float mx = 0.f;
    for (int st = 0; st < nsub; ++st) { const float* p = sp + (size_t)(kbase + 64 * st + (lane >> 5)) * ldw + (lane & 31);
        float t32[32];
#pragma unroll
        for (int i = 0; i < 32; ++i) t32[i] = p[(size_t)(2 * i) * ldw];
#pragma unroll
        for (int i = 0; i < 32; ++i) mx = fmaxf(mx, fabsf(t32[i])); }
    mx = fmaxf(mx, __shfl_xor(mx, 32));
    if (lane < 32) pm[wave * 32 + lane] = mx;
    __syncthreads();
    float inv[4];
#pragma unroll
    for (int j = 0; j < 4; ++j) { const int n = (lane >> 3) + 8 * j; float m = pm[n];
#pragma unroll
        for (int w = 1; w < 8; ++w) m = fmaxf(m, pm[w * 32 + n]);
        inv[j] = m > 0.f ? QMAX / m : 0.f; }
    if (tid < 32) { float m = pm[tid];
#pragma unroll
        for (int w = 1; w < 8; ++w) m = fmaxf(m, pm[w * 32 + tid]);
        sbv[tid] = m / QMAX; }
    const int c = lane & 7;
    for (int st = 0; st < nsub; ++st) { const int k0 = kbase + 64 * st;
        { float t32[32]; const float* p = sp + (size_t)(k0 + (lane >> 5)) * ldw + (lane & 31);
#pragma unroll
          for (int i = 0; i < 32; ++i) t32[i] = p[(size_t)(2 * i) * ldw];
#pragma unroll
          for (int i = 0; i < 32; ++i) scr[(2 * i + (lane >> 5)) * 33 + (lane & 31)] = t32[i]; }
        LDS_WAIT(); asm volatile("" ::: "memory");
#pragma unroll
        for (int j = 0; j < 4; ++j) { const int n = (lane >> 3) + 8 * j; const LAS float* s = scr + (8 * c) * 33 + n; float v[8];
#pragma unroll
            for (int e = 0; e < 8; ++e) v[e] = s[e * 33] * inv[j];
            v2u o;
            if (FMT == 1) { int q[8];
#pragma unroll
                for (int e = 0; e < 8; ++e) q[e] = (int)rintf(v[e]) & 0xff;
                o.x = (unsigned)(q[0] | (q[1] << 8) | (q[2] << 16) | (q[3] << 24)); o.y = (unsigned)(q[4] | (q[5] << 8) | (q[6] << 16) | (q[7] << 24)); }
            else { o.x = pg8::pk4_fp8(v[0], v[1], v[2], v[3]); o.y = pg8::pk4_fp8(v[4], v[5], v[6], v[7]); }
            *(v2u*)(dst + (size_t)n * K + k0 + 8 * c) = o; }
        LDS_WAIT(); asm volatile("" ::: "memory"); }
    __syncthreads();
}
__device__ __forceinline__ void ffn_quant_item(const Args& a, int l, int f, int slot, int item, LAS unsigned char* lds, int wave, int lane, int tid) {
    const size_t wo = (size_t)(l * 2 + f) * DM * DFF;
    if (item < 352) { const int n0 = 32 * item, pn = n0 >> 8, r = n0 & 255; const float* sp = (r < 128 ? a.in[13] : a.in[14]) + wo + pn * 128 + (r & 127);
        quant_item<1>(sp, DFF, DM, a.ws + (slot ? WS_W1B : WS_W1A) + (size_t)n0 * DM, (float*)(a.ws + WS_SB1) + slot * 11264 + n0, lds, wave, lane, tid); }
    else { const int n0 = 32 * (item - 352);
        quant_item<2>(a.in[15] + wo + n0, DM, DFF, a.ws + (slot ? WS_W2B : WS_W2A) + (size_t)n0 * DFF, (float*)(a.ws + WS_SB2) + slot * 2048 + n0, lds, wave, lane, tid); }
}
__device__ __forceinline__ void mod_item(const Args& a, int item, float* MOD, LAS unsigned char* lds, int wave, int lane, int tid) {
    const int l = item / 144, cb = item % 144;
    LAS float* sil = (LAS float*)(lds + wave * 9216);
    LAS float* part = (LAS float*)(lds + 73728);
    const float* cvec = a.in[8]; const float* cctx = a.in[9];
    for (int i = lane; i < 9 * 256; i += 64) { const int s = i >> 8, kk = i & 255, k = wave * 256 + kk; const float c = s == 0 ? cctx[k] : cvec[(s - 1) * DM + k]; sil[i] = c * sigmoidf_(c); }
    LDS_WAIT(); asm volatile("" ::: "memory");
    typedef float f32x2 __attribute__((ext_vector_type(2)));
    f32x2 acc[9];
#pragma unroll
    for (int s = 0; s < 9; ++s) acc[s] = (f32x2){0.f, 0.f};
    const float* wp = a.in[10] + ((size_t)l * DM + wave * 256) * (9 * DM) + cb * 128 + 2 * lane;
    for (int k16 = 0; k16 < 16; ++k16) {
        f32x2 w[16];
#pragma unroll
        for (int j = 0; j < 16; ++j) w[j] = *(const f32x2*)(wp + (size_t)(16 * k16 + j) * (9 * DM));
#pragma unroll
        for (int s = 0; s < 9; ++s) {
#pragma unroll
            for (int q = 0; q < 4; ++q) { const f32x4 c = *(const LAS f32x4*)(sil + s * 256 + 16 * k16 + 4 * q);
                acc[s] += w[4 * q] * c[0]; acc[s] += w[4 * q + 1] * c[1]; acc[s] += w[4 * q + 2] * c[2]; acc[s] += w[4 * q + 3] * c[3]; } }
    }
#pragma unroll
    for (int s = 0; s < 9; ++s) *(LAS f32x2*)(part + (wave * 9 + s) * 128 + 2 * lane) = acc[s];
    __syncthreads();
    for (int i = tid; i < 9 * 128; i += NTHR) { const int s = i >> 7, col = i & 127; float v = a.in[11][l * (9 * DM) + cb * 128 + col];
#pragma unroll
        for (int w = 0; w < 8; ++w) v += part[(w * 9 + s) * 128 + col];
        MOD[((size_t)l * 9 + s) * MODS + cb * 128 + col] = v; }
    __syncthreads();
}
__device__ __forceinline__ void tail_ids(int nwg, int G, int& ib, int& nidle) { const int rem = nwg % G, c = (int)blockIdx.x; if (rem == 0) { ib = c; nidle = G; } else if (c >= rem) { ib = c - rem; nidle = G - rem; } else { ib = -1; nidle = G - rem; } }
constexpr int P0_ITEMS = 3040;
__device__ __forceinline__ void p0_item(const Args& a, int it, LAS unsigned char* lds, int wave, int lane, int tid) {
    unsigned char* ws = a.ws; LAS float* scr = (LAS float*)(lds + wave * 8448);
    int r = it;
    if (r < 128) { ffn_quant_item(a, 0, r >> 6, r >> 6, 352 + (r & 63), lds, wave, lane, tid); return; } r -= 128;
    if (r < 288) { mod_item(a, r, (float*)(ws + WS_MOD), lds, wave, lane, tid); return; } r -= 288;
    if (r < 704) { const int f = r >= 352 ? 1 : 0; ffn_quant_item(a, 0, f, f, r - 352 * f, lds, wave, lane, tid); return; } r -= 704;
    if (r < 128) { const int n0 = 32 * r; const int col = n0 < 2048 ? n0 : 6144 + (n0 - 2048);
        quant_item<1>(a.in[28] + col, 8224, DM, ws + WS_WQC + (size_t)n0 * DM, (float*)(ws + WS_SBQC) + n0, lds, wave, lane, tid); return; } r -= 128;
    if (r < 64) { const int n0 = 32 * r; quant_item<1>(a.in[31] + n0, DM, DM, ws + WS_WQOC + (size_t)n0 * DM, (float*)(ws + WS_SBOC) + n0, lds, wave, lane, tid); return; } r -= 64;
    if (r < 640) { xpose_run(a.in[16], nullptr, (bf16*)(ws + WS_WINAB), 5120, DM, 160, 0, r * 8 + wave, scr, lane); return; } r -= 640;
    if (r < 256) { xpose_run(a.in[17], nullptr, (bf16*)(ws + WS_WOUTAB), DM, DM, 64, 0, r * 8 + wave, scr, lane); return; } r -= 256;
    if (r < 544) {
        const int sub = r * 8 + wave, kb = sub / 136, nb = sub - kb * 136, n0 = nb * 32; const int col = n0 < 4096 ? 2048 + n0 : 8192 + (n0 - 4096);
        xpose_sub(a.in[28] + col, 8224, (bf16*)(ws + WS_WINC) + (size_t)n0 * DM, DM, kb * 64, col >= 8224, scr, lane); return; } r -= 544;
    if (r < 32) { const int which = r >> 4, dh = r & 15;
        { const int sub = wave, kb = sub >> 2, nb = sub & 3;
          xpose_sub(a.in[which ? 25 : 23] + (size_t)dh * 16384 + nb * 32, 128, (bf16*)(ws + WS_LW) + (size_t)(dh * 2 + which) * 16384 + (size_t)(nb * 32) * 128, 128, kb * 64, false, scr, lane, -1.4426950408889634f); } return; } r -= 32;
    { const int b = r >> 5;
      xpose_run(a.in[3] + (size_t)b * 512 * 1024, nullptr, (bf16*)(ws + WS_VCT) + (size_t)b * 1024 * 512, 1024, 512, 32, 0, (r & 31) * 8 + wave, scr, lane); }
}
__device__ __forceinline__ void phase_p0(const Args& a, LAS unsigned char* lds, int G, int wave, int lane, int tid) {
    unsigned* ctr = (unsigned*)(a.ws + WS_CTL) + 64; volatile LAS int* qs = (volatile LAS int*)(lds + MISC_OFF + 64);
    if (tid == 0) qs[0] = (int)__hip_atomic_fetch_add(ctr, 1u, __ATOMIC_RELAXED, __HIP_MEMORY_SCOPE_AGENT);
    __syncthreads();
    int it = qs[0];
    while (it < P0_ITEMS) {
        __syncthreads();
        int nxt = 0; if (tid == 0) nxt = (int)__hip_atomic_fetch_add(ctr, 1u, __ATOMIC_RELAXED, __HIP_MEMORY_SCOPE_AGENT);
        p0_item(a, it, lds, wave, lane, tid);
        if (tid == 0) qs[0] = nxt;
        __syncthreads();
        it = qs[0];
    }
    unsigned char* ws = a.ws;
    { const f32x4* src = (const f32x4*)a.in[2]; v2u* dst = (v2u*)(ws + WS_KC);
      for (int i = blockIdx.x * NTHR + tid; i < 1048576; i += G * NTHR) { const f32x4 v = src[i]; dst[i] = (v2u){pk2(v[0], v[1]), pk2(v[2], v[3])}; } }
    { float* R = (float*)(ws + WS_ROPE);
      for (int i = blockIdx.x * NTHR + tid; i < 4096; i += G * NTHR) { const int p = i >> 6, fi = i & 63; const float fr = powf(10000.0f, -(float)fi * (1.0f / 64.0f)); const float ang = (float)p * fr;
          R[2 * i] = cosf(ang); R[2 * i + 1] = sinf(ang); } }
}
#define NORM_REQ(mm) do { if (FIRST) { const float* xr_ = (mm) < MP ? a.in[0] + (size_t)(mm) * DM : a.in[1] + (size_t)((mm) - MP) * DM; _Pragma("unroll") for (int q = 0; q < 8; ++q) nf[q] = *(const f32x4*)(xr_ + 4 * lane + 256 * q); } \
        else { const bf16* xr_ = COPY ? (const bf16*)(a.ws + WS_XB2) + (size_t)(mm) * DM : (const bf16*)a.out + (size_t)(mm) * XPITCH; _Pragma("unroll") for (int q = 0; q < 8; ++q) nh[q] = *(const v2u*)(xr_ + 4 * lane + 256 * q); } } while (0)
template <bool FIRST, bool COPY = false  >
__device__ __forceinline__ void norm_pass(const Args& a, int l, int j, int G, int wave, int lane) {
    const float* MOD = (const float*)(a.ws + WS_MOD) + (size_t)l * 9 * MODS;
    const float* gvec = a.in[12] + (size_t)(l * 3 + j) * DM;
    bf16* H = (bf16*)(a.ws + WS_H);
    const int NGW = G * NWAVES, gw = blockIdx.x * NWAVES + wave, rpw = (MT + NGW - 1) / NGW;
    int cur = -1; f32x4 ge[8], sh[8];
    const int m_end = (gw + 1) * rpw < MT ? (gw + 1) * rpw : MT;
    f32x4 nf[8]; v2u nh[8];
    if (gw * rpw < m_end) NORM_REQ(gw * rpw);
    for (int m = gw * rpw; m < m_end; ++m) {
        const int s = set_of_row(m);
        if (s != cur) { cur = s; const float* sc = MOD + (size_t)s * MODS + (3 * j + 1) * DM; const float* sf = MOD + (size_t)s * MODS + (3 * j) * DM;
#pragma unroll
            for (int q = 0; q < 8; ++q) { const int c = 4 * lane + 256 * q; const f32x4 g4 = *(const f32x4*)(gvec + c), s4 = *(const f32x4*)(sc + c); ge[q] = g4 * (s4 + 1.0f); sh[q] = *(const f32x4*)(sf + c); } }
        f32x4 v[8]; float ss = 0.f;
        if (FIRST) {
#pragma unroll
            for (int q = 0; q < 8; ++q) v[q] = nf[q]; }
        else {
#pragma unroll
            for (int q = 0; q < 8; ++q) { const v2u w = nh[q]; v[q] = (f32x4){__uint_as_float(w.x << 16), __uint_as_float(w.x & 0xffff0000u), __uint_as_float(w.y << 16), __uint_as_float(w.y & 0xffff0000u)}; } }
        if (m + 1 < m_end) NORM_REQ(m + 1);
#pragma unroll
        for (int q = 0; q < 8; ++q) ss += (v[q][0] * v[q][0] + v[q][1] * v[q][1]) + (v[q][2] * v[q][2] + v[q][3] * v[q][3]);
        const float rstd = rsqrtf(wave_sum(ss) * (1.0f / DM) + EPS);
        bf16* orow = H + (size_t)m * DM;
#pragma unroll
        for (int q = 0; q < 8; ++q) { const f32x4 o = v[q] * rstd * ge[q] + sh[q]; *(v2u*)(orow + 4 * lane + 256 * q) = (v2u){pk2(o[0], o[1]), pk2(o[2], o[3])}; }
    }
}

template <bool FIRST, bool COPY = false  >
__device__ __forceinline__ void norm_pass_dual(const Args& a, int l, int j, int G, int wave, int lane) {
    const float* MOD = (const float*)(a.ws + WS_MOD) + (size_t)l * 9 * MODS;
    const float* gvec = a.in[12] + (size_t)(l * 3 + j) * DM;
    bf16* H = (bf16*)(a.ws + WS_H);
    const int NGW = G * NWAVES, gw = blockIdx.x * NWAVES + wave, rpw = (MT + NGW - 1) / NGW;
    int cur = -1; f32x4 ge[8], sh[8];
    const int m_end = (gw + 1) * rpw < MT ? (gw + 1) * rpw : MT;
    f32x4 nf[8]; v2u nh[8];
    if (gw * rpw < m_end) NORM_REQ(gw * rpw);
    for (int m = gw * rpw; m < m_end; ++m) {
        const int s = set_of_row(m);
        if (s != cur) { cur = s; const float* sc = MOD + (size_t)s * MODS + (3 * j + 1) * DM; const float* sf = MOD + (size_t)s * MODS + (3 * j) * DM;
#pragma unroll
            for (int q = 0; q < 8; ++q) { const int c = 4 * lane + 256 * q; const f32x4 g4 = *(const f32x4*)(gvec + c), s4 = *(const f32x4*)(sc + c); ge[q] = g4 * (s4 + 1.0f); sh[q] = *(const f32x4*)(sf + c); } }
        f32x4 v[8]; float ss = 0.f;
        if (FIRST) {
#pragma unroll
            for (int q = 0; q < 8; ++q) v[q] = nf[q]; }
        else {
#pragma unroll
            for (int q = 0; q < 8; ++q) { const v2u w = nh[q]; v[q] = (f32x4){__uint_as_float(w.x << 16), __uint_as_float(w.x & 0xffff0000u), __uint_as_float(w.y << 16), __uint_as_float(w.y & 0xffff0000u)}; } }
        if (m + 1 < m_end) NORM_REQ(m + 1);
#pragma unroll
        for (int q = 0; q < 8; ++q) ss += (v[q][0] * v[q][0] + v[q][1] * v[q][1]) + (v[q][2] * v[q][2] + v[q][3] * v[q][3]);
        const float rstd = rsqrtf(wave_sum(ss) * (1.0f / DM) + EPS);
        bf16* orow = H + (size_t)m * DM;
#pragma unroll
        for (int q = 0; q < 8; ++q) { v[q] = v[q] * rstd * ge[q] + sh[q]; *(v2u*)(orow + 4 * lane + 256 * q) = (v2u){pk2(v[q][0], v[q][1]), pk2(v[q][2], v[q][3])}; }
        float am = 0.f;
#pragma unroll
        for (int q = 0; q < 8; ++q) am = fmaxf(am, fmaxf(fmaxf(fabsf(v[q][0]), fabsf(v[q][1])), fmaxf(fabsf(v[q][2]), fabsf(v[q][3]))));
        am = wave_max(am);
        const float inv = am > 0.f ? 127.0f / am : 0.f;
        unsigned char* o8 = a.ws + WS_H8M + (size_t)m * DM;
#pragma unroll
        for (int q = 0; q < 8; ++q) { const int q0 = (int)rintf(v[q][0] * inv) & 0xff, q1 = (int)rintf(v[q][1] * inv) & 0xff, q2 = (int)rintf(v[q][2] * inv) & 0xff, q3 = (int)rintf(v[q][3] * inv) & 0xff;
            *(unsigned*)(o8 + 4 * lane + 256 * q) = (unsigned)(q0 | (q1 << 8) | (q2 << 16) | (q3 << 24)); }
        if (lane == 0) ((float*)(a.ws + WS_SA))[m] = am * (1.0f / 127.0f);
    }
}

template <bool FIRST, bool COPY = false  >
__device__ __forceinline__ void norm_pass_q(const Args& a, int l, int j, int G, int wave, int lane) {
    const float* MOD = (const float*)(a.ws + WS_MOD) + (size_t)l * 9 * MODS;
    const float* gvec = a.in[12] + (size_t)(l * 3 + j) * DM;
    unsigned char* H8 = a.ws + WS_H; float* SA = (float*)(a.ws + WS_SA);
    const int NGW = G * NWAVES, gw = blockIdx.x * NWAVES + wave, rpw = (MT + NGW - 1) / NGW;
    int cur = -1; f32x4 ge[8], sh[8];
    const int m_end = (gw + 1) * rpw < MT ? (gw + 1) * rpw : MT;
    f32x4 nf[8]; v2u nh[8];
    if (gw * rpw < m_end) NORM_REQ(gw * rpw);
    for (int m = gw * rpw; m < m_end; ++m) {
        const int s = set_of_row(m);
        if (s != cur) { cur = s; const float* sc = MOD + (size_t)s * MODS + (3 * j + 1) * DM; const float* sf = MOD + (size_t)s * MODS + (3 * j) * DM;
#pragma unroll
            for (int q = 0; q < 8; ++q) { const int c = 4 * lane + 256 * q; const f32x4 g4 = *(const f32x4*)(gvec + c), s4 = *(const f32x4*)(sc + c); ge[q] = g4 * (s4 + 1.0f); sh[q] = *(const f32x4*)(sf + c); } }
        f32x4 v[8]; float ss = 0.f;
        if (FIRST) {
#pragma unroll
            for (int q = 0; q < 8; ++q) v[q] = nf[q]; }
        else {
#pragma unroll
            for (int q = 0; q < 8; ++q) { const v2u w = nh[q]; v[q] = (f32x4){__uint_as_float(w.x << 16), __uint_as_float(w.x & 0xffff0000u), __uint_as_float(w.y << 16), __uint_as_float(w.y & 0xffff0000u)}; } }
        if (m + 1 < m_end) NORM_REQ(m + 1);
#pragma unroll
        for (int q = 0; q < 8; ++q) ss += (v[q][0] * v[q][0] + v[q][1] * v[q][1]) + (v[q][2] * v[q][2] + v[q][3] * v[q][3]);
        const float rstd = rsqrtf(wave_sum(ss) * (1.0f / DM) + EPS);
        float am = 0.f;
#pragma unroll
        for (int q = 0; q < 8; ++q) { v[q] = v[q] * rstd * ge[q] + sh[q]; am = fmaxf(am, fmaxf(fmaxf(fabsf(v[q][0]), fabsf(v[q][1])), fmaxf(fabsf(v[q][2]), fabsf(v[q][3])))); }
        am = wave_max(am);
        const float inv = am > 0.f ? 127.0f / am : 0.f;
        unsigned char* orow = H8 + (size_t)m * DM;
#pragma unroll
        for (int q = 0; q < 8; ++q) { const int q0 = (int)rintf(v[q][0] * inv) & 0xff, q1 = (int)rintf(v[q][1] * inv) & 0xff, q2 = (int)rintf(v[q][2] * inv) & 0xff, q3 = (int)rintf(v[q][3] * inv) & 0xff;
            *(unsigned*)(orow + 4 * lane + 256 * q) = (unsigned)(q0 | (q1 << 8) | (q2 << 16) | (q3 << 24)); }
        if (lane == 0) SA[m] = am * (1.0f / 127.0f);
    }
}

__device__ __forceinline__ void tile_load(const bf16* src, size_t spitch, LAS bf16* tl, int lane) {
    v4u r[16];
#pragma unroll
    for (int i = 0; i < 16; ++i) { const int c = lane + 64 * i, t = c >> 4, dc = c & 15; r[i] = *(const v4u*)(src + (size_t)t * spitch + 8 * dc); }
#pragma unroll
    for (int i = 0; i < 16; ++i) { const int c = lane + 64 * i, t = c >> 4, dc = c & 15; *(LAS v4u*)(tl + t * 136 + 8 * dc) = r[i]; }
}
__device__ __forceinline__ void tile_store_rows(bf16* dst, size_t dpitch, const LAS bf16* tl, int lane) {
#pragma unroll
    for (int i = 0; i < 16; ++i) { const int c = lane + 64 * i, t = c >> 4, dc = c & 15; *(v4u*)(dst + (size_t)t * dpitch + 8 * dc) = *(const LAS v4u*)(tl + t * 136 + 8 * dc); }
}
__device__ __forceinline__ void tile_store_T(bf16* dst, size_t dpitch, const LAS bf16* tl, int lane) {
#pragma unroll 4
    for (int i = 0; i < 16; ++i) { const int c = lane + 64 * i, d = c >> 3, tc = c & 7; const LAS bf16* s = tl + (8 * tc) * 136 + d;
        v4u o; o.x = (unsigned)s[0] | ((unsigned)s[136] << 16); o.y = (unsigned)s[2 * 136] | ((unsigned)s[3 * 136] << 16); o.z = (unsigned)s[4 * 136] | ((unsigned)s[5 * 136] << 16); o.w = (unsigned)s[6 * 136] | ((unsigned)s[7 * 136] << 16);
        *(v4u*)(dst + (size_t)d * dpitch + 8 * tc) = o; }
}
__device__ __forceinline__ void ab_post_item(const Args& a, int item, LAS unsigned char* lds, int wave, int lane) {
    bf16* Z = (bf16*)(a.ws + WS_Z);
    const int R0 = item * 64;
    const bool prompt = R0 < MP;
    float* outk = a.out + 75497472; float* outv = a.out + 79691776;
    float qg[16], kg[16];
#pragma unroll
    for (int e = 0; e < 16; ++e) { qg[e] = a.in[18][16 * (lane & 7) + e]; kg[e] = a.in[19][16 * (lane & 7) + e]; }
    const int rowb = R0 + wave * 8; bf16* zb = Z + (size_t)rowb * 5120 + 16 * lane;
#pragma unroll
    for (int which = 0; which < 2; ++which) {
        v4u r0[8], r1[8];
#pragma unroll
        for (int tt = 0; tt < 8; ++tt) { const bf16* p = zb + (size_t)tt * 5120 + which * 1024; r0[tt] = *(const v4u*)p; r1[tt] = *(const v4u*)(p + 8); }
#pragma unroll
        for (int tt = 0; tt < 8; ++tt) {
            bf16* p = zb + (size_t)tt * 5120 + which * 1024;
            float x[16]; const unsigned w8[8] = {r0[tt].x, r0[tt].y, r0[tt].z, r0[tt].w, r1[tt].x, r1[tt].y, r1[tt].z, r1[tt].w};
#pragma unroll
            for (int e = 0; e < 8; ++e) { x[2 * e] = __uint_as_float(w8[e] << 16); x[2 * e + 1] = __uint_as_float(w8[e] & 0xffff0000u); }
            float ss = 0.f;
#pragma unroll
            for (int e = 0; e < 16; ++e) ss += x[e] * x[e];
            ss += __shfl_xor(ss, 1); ss += __shfl_xor(ss, 2); ss += __shfl_xor(ss, 4);
            const float rs = rsqrtf(ss * (1.0f / 128.0f) + EPS);
#pragma unroll
            for (int e = 0; e < 16; ++e) x[e] = x[e] * rs * (which ? kg[e] : qg[e]);
            v4u o0, o1; o0.x = pk2(x[0], x[1]); o0.y = pk2(x[2], x[3]); o0.z = pk2(x[4], x[5]); o0.w = pk2(x[6], x[7]); o1.x = pk2(x[8], x[9]); o1.y = pk2(x[10], x[11]); o1.z = pk2(x[12], x[13]); o1.w = pk2(x[14], x[15]);
            *(v4u*)p = o0; *(v4u*)(p + 8) = o1;
            if (which == 1 && prompt) { float* ok = outk + (size_t)(rowb + tt) * 1024 + 16 * lane;
#pragma unroll
                for (int e = 0; e < 4; ++e) *(f32x4*)(ok + 4 * e) = (f32x4){x[4 * e], x[4 * e + 1], x[4 * e + 2], x[4 * e + 3]}; }
        }
    }
    if (prompt) {
        v4u r0[8], r1[8];
#pragma unroll
        for (int tt = 0; tt < 8; ++tt) { const bf16* p = zb + (size_t)tt * 5120 + 2048; r0[tt] = *(const v4u*)p; r1[tt] = *(const v4u*)(p + 8); }
#pragma unroll
        for (int tt = 0; tt < 8; ++tt) { const unsigned w8[8] = {r0[tt].x, r0[tt].y, r0[tt].z, r0[tt].w, r1[tt].x, r1[tt].y, r1[tt].z, r1[tt].w};
            float* ov = outv + (size_t)(rowb + tt) * 1024 + 16 * lane;
#pragma unroll
            for (int e = 0; e < 4; ++e) *(f32x4*)(ov + 4 * e) = (f32x4){__uint_as_float(w8[2 * e] << 16), __uint_as_float(w8[2 * e] & 0xffff0000u), __uint_as_float(w8[2 * e + 1] << 16), __uint_as_float(w8[2 * e + 1] & 0xffff0000u)}; }
    }
    LAS bf16* tl = (LAS bf16*)(lds + wave * 17408);
    tile_load(Z + (size_t)R0 * 5120 + 2048 + wave * 128, 5120, tl, lane);
    LDS_WAIT(); asm volatile("" ::: "memory");
    bf16* dst; size_t dp;
    if (prompt) { const int b = R0 >> 8, t0 = R0 & 255; dst = (bf16*)(a.ws + WS_VTP) + ((size_t)(b * 8 + wave) * 128) * 256 + t0; dp = 256; }
    else { const int rs = R0 - MP, b = rs >> 12, t0 = rs & 4095; dst = (bf16*)(a.ws + WS_VTS) + ((size_t)(b * 8 + wave) * 128) * 4096 + t0; dp = 4096; }
    tile_store_T(dst, dp, tl, lane);
    LDS_WAIT(); asm volatile("" ::: "memory");
}
__device__ __forceinline__ float gelu_tanh(float x) { const float y = 0.7978845608028654f * (x + 0.044715f * x * x * x); const float t = 1.0f - 2.0f * __builtin_amdgcn_rcpf(1.0f + __expf(2.0f * y)); return 0.5f * x * (1.0f + t); }
template <int PASS>
__device__ __forceinline__ void lru_item(const Args& a, int cq, int hh, LAS unsigned char* lds, int wave, int lane, int tid) {
    const bf16* Z = (const bf16*)(a.ws + WS_Z); const bf16* LW = (const bf16*)(a.ws + WS_LW);
    float* SUMW = (float*)(a.ws + WS_SUMW); float* SUMB = (float*)(a.ws + WS_SUMB);
    const int fr = lane & 15, fq = lane >> 4;
    int S0, T, tseq, bs = 0, cis = 0, nchk = 1;
    if (cq < 16) { S0 = cq * 256; T = 256; tseq = 0; } else { bs = (cq - 16) >> 4; cis = (cq - 16) & 15; nchk = 16; S0 = MP + bs * 4096; T = 4096; tseq = cis * 256; }
    const int t0 = tseq + 32 * wave;
    LAS bf16* xt = (LAS bf16*)(lds + wave * 8704);
    LAS float* WS = (LAS float*)(lds + 69632);
    LAS float* HW = (LAS float*)(lds + 69632 + 16384);
    {
        const int ch = hh * 128 + 2 * lane;
        const float* cw = a.in[21]; const float* cbp = a.in[22];
        float w[4][2];
#pragma unroll
        for (int i = 0; i < 4; ++i) { w[i][0] = cw[i * 1024 + ch]; w[i][1] = cw[i * 1024 + ch + 1]; }
        const float cb0 = cbp[ch], cb1 = cbp[ch + 1];
        const bf16* xb = Z + (size_t)S0 * 5120 + 3072 + ch;
        unsigned xr[35];
#pragma unroll
        for (int i = 0; i < 35; ++i) { const int t = t0 - 1 + i; xr[i] = (t >= 0 && t < T) ? *(const unsigned*)(xb + (size_t)t * 5120) : 0u; }
#pragma unroll
        for (int t = 0; t < 32; ++t) {
            const float y0 = w[0][0] * __uint_as_float(xr[t] << 16) + w[1][0] * __uint_as_float(xr[t + 1] << 16) + w[2][0] * __uint_as_float(xr[t + 2] << 16) + w[3][0] * __uint_as_float(xr[t + 3] << 16) + cb0;
            const float y1 = w[0][1] * __uint_as_float(xr[t] & 0xffff0000u) + w[1][1] * __uint_as_float(xr[t + 1] & 0xffff0000u) + w[2][1] * __uint_as_float(xr[t + 2] & 0xffff0000u) + w[3][1] * __uint_as_float(xr[t + 3] & 0xffff0000u) + cb1;
            *(LAS unsigned*)(xt + t * 136 + 2 * lane) = pk2(y0, y1);
        }
    }
    if (PASS == 2) {
        if (tid < 256) { const int dir = tid >> 7, chl = tid & 127;
            float Hs = (cq < 16) ? 0.f : a.in[4][(size_t)(bs * 2 + dir) * 1024 + hh * 128 + chl];
            typedef float f32x2_ __attribute__((ext_vector_type(2)));
            f32x2_ sb_[15], sw_[8];
            const float* sbp = SUMB + ((size_t)((cq - cis) * 8 + hh) * 2 + dir) * 256 + 2 * chl;
#pragma unroll
            for (int i = 0; i < 15; ++i) { const int c = dir ? nchk - 1 - i : i; const bool use = dir ? c > cis : c < cis; sb_[i] = use ? *(const f32x2_*)(sbp + (size_t)c * 4096) : (f32x2_){1.f, 0.f}; }
            const float* sw = SUMW + ((size_t)(cq * 8 + hh) * 8) * 512 + dir * 256 + 2 * chl;
#pragma unroll
            for (int w = 0; w < 8; ++w) sw_[w] = *(const f32x2_*)(sw + w * 512);
#pragma unroll
            for (int i = 0; i < 15; ++i) Hs = sb_[i][0] * Hs + sb_[i][1];
            if (dir == 0) {
#pragma unroll
                for (int w = 0; w < 8; ++w) { HW[(w * 2 + 0) * 128 + chl] = Hs; Hs = sw_[w][0] * Hs + sw_[w][1]; } }
            else {
#pragma unroll
                for (int w = 7; w >= 0; --w) { HW[(w * 2 + 1) * 128 + chl] = Hs; Hs = sw_[w][0] * Hs + sw_[w][1]; } }
        }
        __syncthreads();
    }
    LDS_WAIT(); asm volatile("" ::: "memory");
    bf16x8 af[2][4];
#pragma unroll
    for (int mt = 0; mt < 2; ++mt)
#pragma unroll
        for (int kk = 0; kk < 4; ++kk) af[mt][kk] = *(const LAS bf16x8*)(xt + (16 * mt + fr) * 136 + 32 * kk + 8 * fq);
    bf16x8 bw[2][4]; float sc3[3];
#define LRU_REQ(dstw, dsts, q_) do { const int d_ = (q_) & 1, chl_ = 16 * ((q_) >> 1) + fr; const bf16* wa_ = LW + (size_t)((d_ * 8 + hh) * 2) * 16384 + chl_ * 128 + 8 * fq; \
        _Pragma("unroll") for (int kk = 0; kk < 4; ++kk) { dstw[0][kk] = *(const bf16x8*)(wa_ + 32 * kk); dstw[1][kk] = *(const bf16x8*)(wa_ + 16384 + 32 * kk); } \
        dsts[0] = a.in[24][d_ * 1024 + hh * 128 + chl_]; dsts[1] = a.in[26][d_ * 1024 + hh * 128 + chl_]; dsts[2] = a.in[27][d_ * 1024 + hh * 128 + chl_]; } while (0)
    LRU_REQ(bw, sc3, 0);
    for (int jt = 0; jt < 8; ++jt) {
        const int chl = 16 * jt + fr, ch = hh * 128 + chl;
        bf16 gbr[2][4];
        if (PASS == 2) {
#pragma unroll
            for (int mt = 0; mt < 2; ++mt)
#pragma unroll
                for (int r = 0; r < 4; ++r) gbr[mt][r] = Z[((size_t)S0 + t0 + 16 * mt + 4 * fq + r) * 5120 + 4096 + ch]; }
        float xv[2][4];
#pragma unroll
        for (int mt = 0; mt < 2; ++mt)
#pragma unroll
            for (int r = 0; r < 4; ++r) xv[mt][r] = bf2f(xt[(16 * mt + 4 * fq + r) * 136 + chl]);
        float av[2][2][4], uv[2][2][4];
#pragma unroll
        for (int dir = 0; dir < 2; ++dir) {
            f32x4 acca[2], accx[2];
            acca[0] = acca[1] = accx[0] = accx[1] = (f32x4){0.f, 0.f, 0.f, 0.f};
            bf16x8 bn[2][4]; float sn3[3];
            if (2 * jt + dir < 15) LRU_REQ(bn, sn3, 2 * jt + dir + 1);
#pragma unroll
            for (int kk = 0; kk < 4; ++kk) {
#pragma unroll
                for (int mt = 0; mt < 2; ++mt) { acca[mt] = MFMA16(af[mt][kk], bw[0][kk], acca[mt]); accx[mt] = MFMA16(af[mt][kk], bw[1][kk], accx[mt]); } }
            const float bav = sc3[0] * -1.4426950408889634f, bxv = sc3[1] * -1.4426950408889634f, lm = sc3[2];
            const float c8 = -8.0f * 1.4426950408889634f * log1pf(__expf(-lm));
#pragma unroll
            for (int mt = 0; mt < 2; ++mt)
#pragma unroll
                for (int r = 0; r < 4; ++r) { const float ra = __builtin_amdgcn_rcpf(1.0f + __builtin_amdgcn_exp2f(acca[mt][r] + bav)), ix = __builtin_amdgcn_rcpf(1.0f + __builtin_amdgcn_exp2f(accx[mt][r] + bxv)); const float la = c8 * ra;
                    const float aa = __builtin_amdgcn_exp2f(la); av[dir][mt][r] = aa; uv[dir][mt][r] = __builtin_amdgcn_sqrtf(fmaxf(1.0f - aa * aa, 0.f)) * ix * xv[mt][r]; }
            if (2 * jt + dir < 15) {
#pragma unroll
                for (int x_ = 0; x_ < 2; ++x_)
#pragma unroll
                    for (int kk = 0; kk < 4; ++kk) bw[x_][kk] = bn[x_][kk];
                sc3[0] = sn3[0]; sc3[1] = sn3[1]; sc3[2] = sn3[2]; }
        }
        float GA[2][2][4], GB[2][2][4];
#pragma unroll
        for (int dir = 0; dir < 2; ++dir)
#pragma unroll
            for (int mt = 0; mt < 2; ++mt) { float A = 1.f, B = 0.f;
#pragma unroll
                for (int rr = 0; rr < 4; ++rr) { const int r = dir ? 3 - rr : rr; A *= av[dir][mt][r]; B = av[dir][mt][r] * B + uv[dir][mt][r]; }
#pragma unroll
                for (int q = 0; q < 4; ++q) { GA[dir][mt][q] = __shfl(A, fr + 16 * q); GB[dir][mt][q] = __shfl(B, fr + 16 * q); } }
        if (PASS == 1) {
#pragma unroll
            for (int dir = 0; dir < 2; ++dir) { float A = 1.f, B = 0.f;
#pragma unroll
                for (int mm = 0; mm < 2; ++mm)
#pragma unroll
                    for (int qq = 0; qq < 4; ++qq) { const int mt = dir ? 1 - mm : mm, q = dir ? 3 - qq : qq; B = GA[dir][mt][q] * B + GB[dir][mt][q]; A *= GA[dir][mt][q]; }
                if (fq == 0) { WS[((wave * 2 + dir) * 128 + chl) * 2] = A; WS[((wave * 2 + dir) * 128 + chl) * 2 + 1] = B;
                    float* g = SUMW + ((size_t)((cq * 8 + hh) * 8 + wave)) * 512 + dir * 256 + 2 * chl; g[0] = A; g[1] = B; } }
        } else {
            float hsum[2][4] = {{0.f, 0.f, 0.f, 0.f}, {0.f, 0.f, 0.f, 0.f}};
#pragma unroll
            for (int dir = 0; dir < 2; ++dir) { float st = HW[(wave * 2 + dir) * 128 + chl]; float hin[2] = {0.f, 0.f};
#pragma unroll
                for (int mm = 0; mm < 2; ++mm)
#pragma unroll
                    for (int qq = 0; qq < 4; ++qq) { const int mt = dir ? 1 - mm : mm, q = dir ? 3 - qq : qq; if (q == fq) hin[mt] = st; st = GA[dir][mt][q] * st + GB[dir][mt][q]; }
#pragma unroll
                for (int mt = 0; mt < 2; ++mt) { float h = hin[mt];
#pragma unroll
                    for (int rr = 0; rr < 4; ++rr) { const int r = dir ? 3 - rr : rr; h = av[dir][mt][r] * h + uv[dir][mt][r]; hsum[mt][r] += h;
                        if (cq < 16) { if (dir == 0 && wave == 7 && mt == 1 && fq == 3 && r == 3) a.out[83886080 + (size_t)(cq * 2 + 0) * 1024 + ch] = h;
                                       if (dir == 1 && wave == 0 && mt == 0 && fq == 0 && r == 0) a.out[83886080 + (size_t)(cq * 2 + 1) * 1024 + ch] = h; } } } }
            bf16* Hb = (bf16*)(a.ws + WS_H);
#pragma unroll
            for (int mt = 0; mt < 2; ++mt)
#pragma unroll
                for (int r = 0; r < 4; ++r) { const size_t row = (size_t)S0 + t0 + 16 * mt + 4 * fq + r; const float gb = bf2f(gbr[mt][r]);
                    Hb[row * DM + 1024 + ch] = (bf16)f2bf(hsum[mt][r] * gelu_tanh(gb)); }
        }
    }
#undef LRU_REQ
    if (PASS == 1) {
        LDS_WAIT(); __syncthreads();
        if (tid < 256) { const int dir = tid >> 7, chl = tid & 127; float A = 1.f, B = 0.f;
            for (int ww = 0; ww < 8; ++ww) { const int w = dir ? 7 - ww : ww; const float wa_ = WS[((w * 2 + dir) * 128 + chl) * 2], wb_ = WS[((w * 2 + dir) * 128 + chl) * 2 + 1]; B = wa_ * B + wb_; A *= wa_; }
            float* g = SUMB + ((size_t)(cq * 8 + hh) * 2 + dir) * 256 + 2 * chl; g[0] = A; g[1] = B; }
    }
    __syncthreads();
}

__device__ __forceinline__ bf16x8 pack8(const float (&p)[8]) { v4u w; w.x = pk2(p[0], p[1]); w.y = pk2(p[2], p[3]); w.z = pk2(p[4], p[5]); w.w = pk2(p[6], p[7]); return __builtin_bit_cast(bf16x8, w); }
__device__ __forceinline__ void c_post_item(const Args& a, int item, LAS unsigned char* lds, int wave, int lane, int tid) {
    bf16* PL = (bf16*)(a.ws + WS_PL);
    const int R0 = item * 64; const bool prompt = R0 < MP;
    int b, tok0; size_t T, tbase;
    if (prompt) { b = R0 >> 8; tok0 = R0 & 255; T = 256; tbase = ((size_t)(b * 8 + wave) * 256) * 256; }
    else { const int rs = R0 - MP; b = rs >> 12; tok0 = rs & 4095; T = 4096; tbase = (size_t)MP * DM + ((size_t)(b * 8 + wave) * 256) * 4096; }
    LAS bf16* tl = (LAS bf16*)(lds + wave * 17408);
    const float* ROPE = (const float*)(a.ws + WS_ROPE);
    const int prow = tok0 >> 6;
    for (int pl = 0; pl < 3; ++pl)
        for (int hf = 0; hf < 2; ++hf) {
            if (pl == 0 && prompt) continue;
            bf16* src = PL + (size_t)pl * PLANE + (size_t)R0 * DM + wave * 256 + hf * 128;
            tile_load(src, DM, tl, lane);
            LDS_WAIT(); asm volatile("" ::: "memory");
            if (pl < 2) {
                const float ksc = pl == 1 ? 0.0625f : 1.0f;
                if (!prompt) {
                    float cr = 0.f, sr = 0.f; if (hf == 0) { cr = ROPE[(prow * 64 + lane) * 2]; sr = ROPE[(prow * 64 + lane) * 2 + 1]; }
#pragma unroll 4
                    for (int t = 0; t < 64; ++t) { float c = cr, s = sr; if (hf) { c = ROPE[(t * 64 + lane) * 2]; s = ROPE[(t * 64 + lane) * 2 + 1]; }
                        const float x1 = bf2f(tl[t * 136 + lane]), x2 = bf2f(tl[t * 136 + 64 + lane]);
                        tl[t * 136 + lane] = (bf16)f2bf((x1 * c - x2 * s) * ksc); tl[t * 136 + 64 + lane] = (bf16)f2bf((x1 * s + x2 * c) * ksc); }
                } else {
#pragma unroll 4
                    for (int t = 0; t < 64; ++t) { const float x1 = bf2f(tl[t * 136 + lane]), x2 = bf2f(tl[t * 136 + 64 + lane]);
                        tl[t * 136 + lane] = (bf16)f2bf(x1 * ksc); tl[t * 136 + 64 + lane] = (bf16)f2bf(x2 * ksc); }
                }
                LDS_WAIT(); asm volatile("" ::: "memory");
                tile_store_rows(src, DM, tl, lane);
            }
            if (pl >= 1) { bf16* dstT = (pl == 1 ? (bf16*)(a.ws + WS_KT) : (bf16*)(a.ws + WS_H)) + tbase + (size_t)(hf * 128) * T + tok0; tile_store_T(dstT, T, tl, lane); }
            LDS_WAIT(); asm volatile("" ::: "memory");
        }
    float* GT = (float*)(a.ws + WS_GATES);
    float gt4[4];
#pragma unroll
    for (int i = 0; i < 4; ++i) { const int idx = tid + NTHR * i; gt4[i] = GT[(size_t)(R0 + (idx >> 5)) * 32 + (idx & 31)]; }
#pragma unroll
    for (int i = 0; i < 4; ++i) { const int idx = tid + NTHR * i, rl = idx >> 5, gi = idx & 31; float* p = GT + (size_t)(R0 + rl) * 32 + gi; float v = gt4[i] + a.in[29][gi];
        if ((gi >> 3) & 1) v = fminf(v, 0.f) - log1pf(__expf(-fabsf(v)));
        *p = v; }
}
constexpr int ML_KL = 0, ML_VTL = 33792, ML_CTL = 68608, ML_ARR = 136192;
__device__ __forceinline__ void c_final_pass(const Args& a, int G, int wave, int lane) {
    const bf16* HF = (const bf16*)(a.ws + WS_PL) + 2 * PLANE; const bf16* HB = (const bf16*)(a.ws + WS_HB); const bf16* OG = (const bf16*)(a.ws + WS_PL) + 3 * PLANE;
    bf16* H = (bf16*)(a.ws + WS_H);
    float gv[32];
#pragma unroll
    for (int e = 0; e < 32; ++e) gv[e] = a.in[30][32 * lane + e];
    v4u nfv[4], nbv[4], ngv[4];
#define CF_REQ(mm) do { const size_t off_ = (size_t)(mm) * DM + 32 * lane; _Pragma("unroll") for (int q = 0; q < 4; ++q) { nfv[q] = *(const v4u*)(HF + off_ + 8 * q); nbv[q] = *(const v4u*)(HB + off_ + 8 * q); ngv[q] = *(const v4u*)(OG + off_ + 8 * q); } } while (0)
    if ((int)(blockIdx.x * NWAVES + wave) < MT) CF_REQ(blockIdx.x * NWAVES + wave);
    for (int m = blockIdx.x * NWAVES + wave; m < MT; m += G * NWAVES) {
        const size_t off = (size_t)m * DM + 32 * lane;
        v4u fv[4], bv[4], gv4[4];
#pragma unroll
        for (int q = 0; q < 4; ++q) { fv[q] = nfv[q]; bv[q] = nbv[q]; gv4[q] = ngv[q]; }
        if (m + G * NWAVES < MT) CF_REQ(m + G * NWAVES);
        float x[32]; float ss = 0.f;
#pragma unroll
        for (int q = 0; q < 4; ++q) { const unsigned fw[4] = {fv[q].x, fv[q].y, fv[q].z, fv[q].w}, bw[4] = {bv[q].x, bv[q].y, bv[q].z, bv[q].w};
#pragma unroll
            for (int e = 0; e < 4; ++e) { x[8 * q + 2 * e] = __uint_as_float(fw[e] << 16) + __uint_as_float(bw[e] << 16); x[8 * q + 2 * e + 1] = __uint_as_float(fw[e] & 0xffff0000u) + __uint_as_float(bw[e] & 0xffff0000u); } }
#pragma unroll
        for (int e = 0; e < 32; ++e) ss += x[e] * x[e];
        ss += __shfl_xor(ss, 1); ss += __shfl_xor(ss, 2); ss += __shfl_xor(ss, 4);
        const float rs = rsqrtf(ss * (1.0f / 256.0f) + EPS);
        float y[32]; float am = 0.f;
#pragma unroll
        for (int q = 0; q < 4; ++q) { const unsigned ow[4] = {gv4[q].x, gv4[q].y, gv4[q].z, gv4[q].w};
#pragma unroll
            for (int e = 0; e < 4; ++e) { y[8 * q + 2 * e] = x[8 * q + 2 * e] * rs * gv[8 * q + 2 * e] * sigmoidf_(__uint_as_float(ow[e] << 16)); y[8 * q + 2 * e + 1] = x[8 * q + 2 * e + 1] * rs * gv[8 * q + 2 * e + 1] * sigmoidf_(__uint_as_float(ow[e] & 0xffff0000u)); } }
#pragma unroll
        for (int e = 0; e < 32; ++e) am = fmaxf(am, fabsf(y[e]));
        am = wave_max(am);
        const float inv = am > 0.f ? 127.0f / am : 0.f;
        unsigned wq[8];
#pragma unroll
        for (int q = 0; q < 8; ++q) { const int q0 = (int)rintf(y[4 * q] * inv) & 0xff, q1 = (int)rintf(y[4 * q + 1] * inv) & 0xff, q2 = (int)rintf(y[4 * q + 2] * inv) & 0xff, q3 = (int)rintf(y[4 * q + 3] * inv) & 0xff; wq[q] = (unsigned)(q0 | (q1 << 8) | (q2 << 16) | (q3 << 24)); }
        unsigned char* o8 = a.ws + WS_H + (size_t)m * DM + 32 * lane;
        *(v4u*)o8 = (v4u){wq[0], wq[1], wq[2], wq[3]}; *(v4u*)(o8 + 16) = (v4u){wq[4], wq[5], wq[6], wq[7]};
        if (lane == 0) ((float*)(a.ws + WS_SA))[m] = am * (1.0f / 127.0f);
    }
#undef CF_REQ
}

#ifndef AT_DV
#define AT_DV 4
#endif
constexpr int AT_K0 = 0, AT_V0 = 34816, AT_K1 = 69632, AT_V1 = 104448, AT_RPB = 139264;
__device__ __forceinline__ void attn_block(const Args& a, int kind, int b, int h, int rp, LAS unsigned char* lds, int wave, int lane, int tid) {
    const bf16* Z = (const bf16*)(a.ws + WS_Z);
    const int fr = lane & 15, fq = lane >> 4;
    const float NINF = -__builtin_inff();
    const int rq = 2 * rp + (wave >> 2), j = kind ? (wave & 3) : 0;
    const size_t qrow = kind ? (size_t)MP + (size_t)b * 4096 + rq * 64 + 16 * j + fr : (size_t)b * 256 + 16 * (8 * rp + wave) + fr;
    bf16x8 bq[4];
    { const bf16* qp = Z + qrow * 5120 + h * 128 + 8 * fq; const float qs = 0.08838834764831845f * 1.4426950408889634f;
#pragma unroll
      for (int kk = 0; kk < 4; ++kk) { const v4u raw = *(const v4u*)(qp + 32 * kk); const unsigned rw[4] = {raw.x, raw.y, raw.z, raw.w}; v4u w;
          w.x = pk2(__uint_as_float(rw[0] << 16) * qs, __uint_as_float(rw[0] & 0xffff0000u) * qs); w.y = pk2(__uint_as_float(rw[1] << 16) * qs, __uint_as_float(rw[1] & 0xffff0000u) * qs);
          w.z = pk2(__uint_as_float(rw[2] << 16) * qs, __uint_as_float(rw[2] & 0xffff0000u) * qs); w.w = pk2(__uint_as_float(rw[3] << 16) * qs, __uint_as_float(rw[3] & 0xffff0000u) * qs);
          bq[kk] = __builtin_bit_cast(bf16x8, w); } }
    const int rlo = min(max(2 * rp - 4, 0), 56), rhi = min(max(2 * rp + 1 - 4, 0), 56) + 8;
    const int nsw = kind ? (rhi - rlo + 1) >> 1 : 0, ntile = kind ? nsw + 4 : 2;
    const int r0 = min(max(rq - 4, 0), 56), start = min(max(16 * j - 8, 0), 32);
    float m_run = NINF, l_run = 0.f;
    f32x4 o[8];
#pragma unroll
    for (int dt = 0; dt < 8; ++dt) o[dt] = (f32x4){0.f, 0.f, 0.f, 0.f};
    v4u sk[4], sv[4], sk2[4], sv2[4];
#define AT_LOAD(t, SK, SV) do { _Pragma("unroll") for (int i_ = 0; i_ < 4; ++i_) { const int id_ = tid + NTHR * i_, key_ = id_ >> 4, ch_ = id_ & 15; \
        if (kind == 0) { SK[i_] = *(const v4u*)(Z + ((size_t)b * 256 + 128 * (t) + key_) * 5120 + 1024 + h * 128 + 8 * ch_); SV[i_] = *(const v4u*)((const bf16*)(a.ws + WS_VTP) + ((size_t)(b * 8 + h) * 128 + key_) * 256 + 128 * (t) + 8 * ch_); } \
        else if ((t) < nsw) { const int rk_ = min(rlo + 2 * (t) + (key_ >> 6), rhi - 1), rv_ = min(rlo + 2 * (t) + (ch_ >> 3), rhi - 1); \
            SK[i_] = *(const v4u*)(Z + ((size_t)MP + (size_t)b * 4096 + rk_ * 64 + (key_ & 63)) * 5120 + 1024 + h * 128 + 8 * ch_); SV[i_] = *(const v4u*)((const bf16*)(a.ws + WS_VTS) + ((size_t)(b * 8 + h) * 128 + key_) * 4096 + rv_ * 64 + 8 * (ch_ & 7)); } \
        else { const int c_ = (t) - nsw; SK[i_] = *(const v4u*)((const bf16*)(a.ws + WS_KC) + ((size_t)(b * 512 + 128 * c_ + key_) * 8 + h) * 128 + 8 * ch_); SV[i_] = *(const v4u*)((const bf16*)(a.ws + WS_VCT) + ((size_t)b * 1024 + h * 128 + key_) * 512 + 128 * c_ + 8 * ch_); } } } while (0)
#define AT_STORE(buf) do { LAS bf16* kl_ = (LAS bf16*)(lds + ((buf) ? AT_K1 : AT_K0)); LAS bf16* vl_ = (LAS bf16*)(lds + ((buf) ? AT_V1 : AT_V0)); \
        _Pragma("unroll") for (int i_ = 0; i_ < 4; ++i_) { const int id_ = tid + NTHR * i_; *(LAS v4u*)(kl_ + (id_ >> 4) * 136 + 8 * (id_ & 15)) = sk[i_]; *(LAS v4u*)(vl_ + (id_ >> 4) * 136 + 8 * (id_ & 15)) = sv[i_]; } } while (0)
    __syncthreads();
    LAS float* rpbl = (LAS float*)(lds + AT_RPB);
    if (kind && tid < 465) rpbl[tid] = a.in[20][h * 465 + tid] * 1.4426950408889634f;
    AT_LOAD(0, sk, sv); AT_STORE(0);
    AT_LOAD(1, sk, sv);
    if (ntile > 2) AT_LOAD(2, sk2, sv2);
    LDS_WAIT(); __syncthreads();
    for (int t = 0; t < ntile; ++t) {
        const LAS bf16* kl = (const LAS bf16*)(lds + ((t & 1) ? AT_K1 : AT_K0)); const LAS bf16* vl = (const LAS bf16*)(lds + ((t & 1) ? AT_V1 : AT_V0));
        const bool win = kind && t < nsw;
        const int ng = win ? 2 : 4;
        for (int g = 0; g < ng; ++g) {
            const int rr = rlo + 2 * t + g;
            if (win && !(rr >= r0 && rr < r0 + 8)) continue;
            const int koff = win ? 64 * g + start : 32 * g;
            f32x4 s0 = (f32x4){0.f, 0.f, 0.f, 0.f}, s1 = (f32x4){0.f, 0.f, 0.f, 0.f};
            const LAS bf16* k0p = kl + (koff + fr) * 136 + 8 * fq;
#pragma unroll
            for (int kk = 0; kk < 4; ++kk) { const bf16x8 a0 = *(const LAS bf16x8*)(k0p + 32 * kk), a1 = *(const LAS bf16x8*)(k0p + 16 * 136 + 32 * kk); s0 = MFMA16(a0, bq[kk], s0); s1 = MFMA16(a1, bq[kk], s1); }
            const LAS bf16* vq0 = vl + fr * 136 + koff + 4 * fq;
            v2u rlo[AT_DV], rhi[AT_DV];
#pragma unroll
            for (int d = 0; d < AT_DV; ++d) { rlo[d] = *(const LAS v2u*)(vq0 + (16 * d) * 136); rhi[d] = *(const LAS v2u*)(vq0 + (16 * d) * 136 + 16); }
            __builtin_amdgcn_sched_barrier(0);
            float p[8];
#pragma unroll
            for (int e = 0; e < 4; ++e) { p[e] = s0[e]; p[4 + e] = s1[e]; }
            if (win) {
                const int qc = 16 * j + fr, c0 = min(max(qc - 8, 0), 48); const LAS float* rb = rpbl + (rr - rq + 7) * 31;
#pragma unroll
                for (int e = 0; e < 8; ++e) { const int kc = start + (e < 4 ? 4 * fq + e : 16 + 4 * fq + (e - 4)); const bool ok = kc >= c0 && kc < c0 + 16; const int dci = min(max(kc - qc + 15, 0), 30);
                    p[e] = ok ? p[e] + rb[dci] : NINF; }
            }
            float mx = fmaxf(fmaxf(fmaxf(p[0], p[1]), fmaxf(p[2], p[3])), fmaxf(fmaxf(p[4], p[5]), fmaxf(p[6], p[7])));
            mx = rows_max(mx);
            const float m_new = fmaxf(m_run, mx); const float corr = __builtin_amdgcn_exp2f(m_run - m_new);
            float rs = 0.f;
#pragma unroll
            for (int e = 0; e < 8; ++e) { p[e] = __builtin_amdgcn_exp2f(p[e] - m_new); rs += p[e]; }
            rs = rows_sum(rs);
            l_run = l_run * corr + rs; m_run = m_new;
            const bf16x8 pb = pack8(p); const bool resc = !__all(corr == 1.0f);
#pragma unroll
            for (int dt = 0; dt < 8; ++dt) {
                __builtin_amdgcn_sched_barrier(0);
                const v4u vv = (v4u){rlo[dt % AT_DV].x, rlo[dt % AT_DV].y, rhi[dt % AT_DV].x, rhi[dt % AT_DV].y}; if (resc) o[dt] = o[dt] * corr; o[dt] = MFMA16(__builtin_bit_cast(bf16x8, vv), pb, o[dt]);
                if (dt + AT_DV < 8) { rlo[dt % AT_DV] = *(const LAS v2u*)(vq0 + (16 * (dt + AT_DV)) * 136); rhi[dt % AT_DV] = *(const LAS v2u*)(vq0 + (16 * (dt + AT_DV)) * 136 + 16); }
                __builtin_amdgcn_sched_barrier(0); }
        }
        if (t + 1 < ntile) AT_STORE((t + 1) & 1);
#pragma unroll
        for (int i_ = 0; i_ < 4; ++i_) { sk[i_] = sk2[i_]; sv[i_] = sv2[i_]; }
        if (t + 3 < ntile) AT_LOAD(t + 3, sk2, sv2);
        LDS_WAIT(); __syncthreads();
    }
#undef AT_LOAD
#undef AT_STORE
    const float inv = 1.0f / l_run;
    bf16* op = (bf16*)(a.ws + WS_H) + qrow * DM + h * 128 + 4 * fq;
#pragma unroll
    for (int dp = 0; dp < 4; ++dp) {
        const v2u A = (v2u){pk2(o[2 * dp][0] * inv, o[2 * dp][1] * inv), pk2(o[2 * dp][2] * inv, o[2 * dp][3] * inv)}, B = (v2u){pk2(o[2 * dp + 1][0] * inv, o[2 * dp + 1][1] * inv), pk2(o[2 * dp + 1][2] * inv, o[2 * dp + 1][3] * inv)};
        const u32x2s sx = __builtin_amdgcn_permlane16_swap(A.x, B.x, false, false), sy = __builtin_amdgcn_permlane16_swap(A.y, B.y, false, false);
        *(v4u*)(op + ((fq & 1) ? 12 : 0) + 32 * dp) = (v4u){sx.x, sy.x, sx.y, sy.y}; }
}

#ifndef ML_DA
#define ML_DA 4
#endif
#ifndef ML_DB
#define ML_DB 3
#endif
#ifndef ML_DV
#define ML_DV 3
#endif
#ifndef ML_DC
#define ML_DC 2
#endif
constexpr int ML2_ARR0 = 136192, ML2_ARR1 = 138784, ML2_NV = 141376;
__device__ __forceinline__ void ml2_scan(LAS float* arr, float ii0, float ff0, float ii1, float ff1, float m_prev, int dir, int lane) {
    const int p0 = 2 * lane, p1 = 2 * lane + 1, i0 = dir ? 127 - p0 : p0, i1 = dir ? 127 - p1 : p1;
    const float s1 = ff0 + ff1; float inc = s1;
#pragma unroll
    for (int o = 1; o < 64; o <<= 1) { const float t = __shfl_up(inc, o); if (lane >= o) inc += t; }
    const float exc = inc - s1, bc0 = exc + ff0, bc1 = inc;
    const float a0 = ii0 - bc0, a1 = ii1 - bc1;
    float im = fmaxf(a0, a1);
#pragma unroll
    for (int o = 1; o < 64; o <<= 1) { const float t = __shfl_up(im, o); if (lane >= o) im = fmaxf(im, t); }
    float em = __shfl_up(im, 1); if (lane == 0) em = -__builtin_inff();
    const float mm0 = fmaxf(m_prev, fmaxf(em, a0)), mm1 = fmaxf(m_prev, im);
    const float mml = fmaxf(m_prev, __shfl(im, 63)), bk = __shfl(inc, 63);
    arr[i0] = a0; arr[i1] = a1; arr[128 + i0] = mm0; arr[128 + i1] = mm1; arr[256 + i0] = __expf(m_prev - mm0); arr[256 + i1] = __expf(m_prev - mm1);
    arr[384 + i0] = __expf(-(bc0 + mm0)); arr[384 + i1] = __expf(-(bc1 + mm1)); arr[512 + i0] = __expf(a0 - mml); arr[512 + i1] = __expf(a1 - mml);
    if (lane == 0) { arr[640] = __expf(m_prev - mml); arr[641] = bk + mml; }
}
__device__ __forceinline__ void mlstm_unit2(const Args& a, int kind, int b, int hh, int dir, int dvh, LAS unsigned char* lds, int wave, int lane0, int tid0) {
    asm volatile("" : "+v"(lane0), "+v"(tid0));
    int lane = lane0, tid = tid0;
    const int fr0 = lane0 & 15, fq0 = lane0 >> 4; int fr = fr0, fq = fq0;
    const int T = kind ? 4096 : 256, nch = T >> 7;
    const size_t row0 = kind ? (size_t)MP + (size_t)b * 4096 : (size_t)b * 256;
    const size_t tb = kind ? (size_t)MP * DM + ((size_t)(b * 8 + hh) * 256) * 4096 : ((size_t)(b * 8 + hh) * 256) * 256;
    const bf16* Qp = (const bf16*)(a.ws + WS_PL); const bf16* Kp = Qp + PLANE;
    const bf16* KT = (const bf16*)(a.ws + WS_KT) + tb; const bf16* VT = (const bf16*)(a.ws + WS_H) + tb + (size_t)(dvh * 128) * T;
    bf16* HO = dir ? (bf16*)(a.ws + WS_HB) : (bf16*)(a.ws + WS_PL) + 2 * PLANE;
    const float* GT = (const float*)(a.ws + WS_GATES);
    LAS bf16* KL = (LAS bf16*)(lds + ML_KL); LAS bf16* VTL = (LAS bf16*)(lds + ML_VTL); LAS bf16* CTL = (LAS bf16*)(lds + ML_CTL);
    LAS float* NV = (LAS float*)(lds + ML2_NV);
    const int scan_wave = dir ? 7 : 0, scan_half = dir ? 0 : 1;
    const int gi_off = (dir ? 16 : 0) + hh, gf_off = (dir ? 24 : 8) + hh;
    f32x4 C[2][8];
    float m0 = 0.f;
    __syncthreads();
    if (kind) {
        const float* c0 = a.in[5] + ((size_t)((b * 2 + dir) * 8 + hh) * 256) * 256 + dvh * 128;
#pragma unroll
        for (int mt = 0; mt < 2; ++mt)
#pragma unroll
            for (int nt = 0; nt < 8; ++nt)
#pragma unroll
                for (int e = 0; e < 4; ++e) C[mt][nt][e] = c0[(unsigned)((32 * wave + 16 * mt + 4 * fq + e) * 256 + 16 * nt + fr)];
        if (tid < 256) NV[tid] = a.in[6][(size_t)((b * 2 + dir) * 8 + hh) * 256 + tid];
        m0 = a.in[7][(b * 2 + dir) * 8 + hh];
    } else {
#pragma unroll
        for (int mt = 0; mt < 2; ++mt)
#pragma unroll
            for (int nt = 0; nt < 8; ++nt) C[mt][nt] = (f32x4){0.f, 0.f, 0.f, 0.f};
        if (tid < 256) NV[tid] = 0.f;
    }
#pragma unroll
    for (int mt = 0; mt < 2; ++mt)
#pragma unroll
        for (int nt = 0; nt < 8; ++nt) *(LAS v2u*)(CTL + (16 * nt + fr) * 264 + 32 * wave + 16 * mt + 4 * fq) = (v2u){pk2(C[mt][nt][0], C[mt][nt][1]), pk2(C[mt][nt][2], C[mt][nt][3])};
    v4u vtn[4], k0n[4]; bf16x8 qf[8];
    {
        const int c = dir ? nch - 1 : 0; const size_t rb = row0 + (size_t)c * 128;
        if (wave == scan_wave) { const int i0 = dir ? 127 - 2 * lane : 2 * lane, i1 = dir ? 126 - 2 * lane : 2 * lane + 1;
            ml2_scan((LAS float*)(lds + ML2_ARR0), GT[(rb + i0) * 32 + gi_off], GT[(rb + i0) * 32 + gf_off], GT[(rb + i1) * 32 + gi_off], GT[(rb + i1) * 32 + gf_off], m0, dir, lane); }
#pragma unroll
        for (int i = 0; i < 4; ++i) { vtn[i] = *(const v4u*)(VT + c * 128 + (unsigned)(((tid >> 4) + 32 * i) * T + 8 * (tid & 15))); k0n[i] = *(const v4u*)(Kp + rb * DM + hh * 256 + (unsigned)(((tid >> 5) + 16 * i) * DM + 8 * (tid & 31))); }
        const bf16* qp = Qp + (rb + 16 * wave) * DM + hh * 256 + (unsigned)(fr * DM + 8 * fq);
#pragma unroll
        for (int kk = 0; kk < 8; ++kk) qf[kk] = *(const bf16x8*)(qp + 32 * kk);
    }
    for (int step = 0; step < nch; ++step) {
        const int c = dir ? nch - 1 - step : step; const int tok0 = c * 128; const size_t rb = row0 + tok0;
        const bool has_next = step + 1 < nch; const int cn = dir ? c - 1 : c + 1; const size_t rbn = row0 + (size_t)cn * 128;
        fr = fr0; fq = fq0; lane = lane0; tid = tid0; asm volatile("" : "+v"(fr), "+v"(fq), "+v"(lane), "+v"(tid));
        LAS float* arr = (LAS float*)(lds + ((step & 1) ? ML2_ARR1 : ML2_ARR0)); LAS float* arn = (LAS float*)(lds + ((step & 1) ? ML2_ARR0 : ML2_ARR1));
        LAS float* A_ = arr; LAS float* MM = arr + 128; LAS float* G_ = arr + 256; LAS float* EMT = arr + 384; LAS float* WE = arr + 512;
        if (step > 0) {
#pragma unroll
            for (int i = 0; i < 4; ++i) { vtn[i] = *(const v4u*)(VT + c * 128 + (unsigned)(((tid >> 4) + 32 * i) * T + 8 * (tid & 15))); k0n[i] = *(const v4u*)(Kp + rb * DM + hh * 256 + (unsigned)(((tid >> 5) + 16 * i) * DM + 8 * (tid & 31))); }
        }
        __syncthreads();
#pragma unroll
        for (int i = 0; i < 4; ++i) { const int cc = tid + NTHR * i; *(LAS v4u*)(VTL + (cc >> 4) * 136 + 8 * (cc & 15)) = vtn[i]; *(LAS v4u*)(KL + (cc >> 5) * 264 + 8 * (cc & 31)) = k0n[i]; }
        v4u k1r[4], akr[2][4];
        if (step > 0) { const bf16* qp = Qp + (rb + 16 * wave) * DM + hh * 256 + (unsigned)(fr * DM + 8 * fq);
#pragma unroll
            for (int kk = 0; kk < 8; ++kk) qf[kk] = *(const bf16x8*)(qp + 32 * kk); }
        float gn[4] = {0.f, 0.f, 0.f, 0.f};
        if (wave == scan_wave && has_next) { const int i0 = dir ? 127 - 2 * lane : 2 * lane, i1 = dir ? 126 - 2 * lane : 2 * lane + 1;
            gn[0] = GT[(rbn + i0) * 32 + gi_off]; gn[1] = GT[(rbn + i0) * 32 + gf_off]; gn[2] = GT[(rbn + i1) * 32 + gi_off]; gn[3] = GT[(rbn + i1) * 32 + gf_off]; }
        LDS_WAIT(); __syncthreads();
        const int tl_ = 16 * wave + fr;
        const float mm_t = MM[tl_], g_t = G_[tl_], emt = EMT[tl_];
        f32x4 o[8];
        {
            const LAS bf16* cb = CTL + fr * 264 + 8 * fq; bf16x8 ring[ML_DA]; const f32x4 zero4 = (f32x4){0.f, 0.f, 0.f, 0.f};
#define ML_A_RD(i_) (*(const LAS bf16x8*)(cb + (16 * (2 * ((i_) >> 4) + ((i_) & 1))) * 264 + 32 * (((i_) >> 1) & 7)))
#pragma unroll
            for (int d = 0; d < ML_DA; ++d) ring[d] = ML_A_RD(d);
#pragma unroll
            for (int i = 0; i < 64; ++i) { const int nt = 2 * (i >> 4) + (i & 1), kk = (i >> 1) & 7;
                __builtin_amdgcn_sched_barrier(0);
                const f32x4 oin = kk == 0 ? zero4 : o[nt]; o[nt] = MFMA16(ring[i % ML_DA], qf[kk], oin);
                if (kk == 7) o[nt] = o[nt] * g_t;
                if (i + ML_DA < 64) ring[i % ML_DA] = ML_A_RD(i + ML_DA);
                __builtin_amdgcn_sched_barrier(0); }
#undef ML_A_RD
        }
        float qn = 0.f;
#pragma unroll
        for (int kk = 0; kk < 8; ++kk) { const f32x4 n0 = *(const LAS f32x4*)(NV + 32 * kk + 8 * fq), n1 = *(const LAS f32x4*)(NV + 32 * kk + 8 * fq + 4);
#pragma unroll
            for (int jj = 0; jj < 4; ++jj) { qn += bf2f((unsigned short)qf[kk][jj]) * n0[jj]; qn += bf2f((unsigned short)qf[kk][4 + jj]) * n1[jj]; } }
        qn = rows_sum(qn);
        __builtin_amdgcn_sched_barrier(0);
#pragma unroll
        for (int i = 0; i < 4; ++i) k1r[i] = *(const v4u*)(Kp + (rb + 64) * DM + hh * 256 + (unsigned)(((tid >> 5) + 16 * i) * DM + 8 * (tid & 31)));
        float rsum = 0.f;
#pragma unroll
        for (int half = 0; half < 2; ++half) {
            if (half == 1) {
                __syncthreads();
#pragma unroll
                for (int i = 0; i < 4; ++i) { const int cc = tid + NTHR * i; *(LAS v4u*)(KL + (cc >> 5) * 264 + 8 * (cc & 31)) = k1r[i]; }
                LDS_WAIT(); __syncthreads();
            }
            if (half == scan_half && wave == scan_wave && has_next) ml2_scan(arn, gn[0], gn[1], gn[2], gn[3], arr[641], dir, lane);
#pragma unroll
            for (int pp = 0; pp < 2; ++pp) {
                const int p = 2 * half + pp, ta = 2 * p, tbb = 2 * p + 1;
                const bool na = dir ? ta >= wave : ta <= wave, nb = dir ? tbb >= wave : tbb <= wave;
                if (!na && !nb) continue;
                float pv[8];
#pragma unroll
                for (int which = 0; which < 2; ++which) {
                    const int st = which ? tbb : ta; const bool need = which ? nb : na;
                    f32x4 s4 = (f32x4){0.f, 0.f, 0.f, 0.f};
                    if (need) {
                        const LAS bf16* kb = KL + ((st & 3) * 16 + fr) * 264 + 8 * fq; bf16x8 ring[ML_DB];
#pragma unroll
                        for (int d = 0; d < ML_DB; ++d) ring[d] = *(const LAS bf16x8*)(kb + 32 * d);
#pragma unroll
                        for (int kk = 0; kk < 8; ++kk) {
                            __builtin_amdgcn_sched_barrier(0);
                            s4 = MFMA16(ring[kk % ML_DB], qf[kk], s4);
                            if (kk + ML_DB < 8) ring[kk % ML_DB] = *(const LAS bf16x8*)(kb + 32 * (kk + ML_DB));
                            __builtin_amdgcn_sched_barrier(0); }
                    }
                    if (need) {
                        const f32x4 a4 = *(const LAS f32x4*)(A_ + 16 * st + 4 * fq);
                        const int sgn = dir ? 1 : -1, d0 = sgn * (16 * st + 4 * fq - tl_), dlim = st == wave ? 0 : -(1 << 20);
#pragma unroll
                        for (int e = 0; e < 4; ++e) { float w = __expf(a4[e] - mm_t); w = (d0 + sgn * e >= dlim) ? w : 0.f;
                            pv[4 * which + e] = s4[e] * w; rsum += pv[4 * which + e]; }
                    } else {
#pragma unroll
                        for (int e = 0; e < 4; ++e) pv[4 * which + e] = 0.f; }
                }
                const bf16x8 pb = pack8(pv);
                {   const LAS bf16* vq = VTL + fr * 136 + 32 * p + 4 * fq; v2u rlo[ML_DV], rhi[ML_DV];
#pragma unroll
                    for (int d = 0; d < ML_DV; ++d) { rlo[d] = *(const LAS v2u*)(vq + (16 * d) * 136); rhi[d] = *(const LAS v2u*)(vq + (16 * d) * 136 + 16); }
#pragma unroll
                    for (int nt = 0; nt < 8; ++nt) {
                        __builtin_amdgcn_sched_barrier(0);
                        const v4u vv = (v4u){rlo[nt % ML_DV].x, rlo[nt % ML_DV].y, rhi[nt % ML_DV].x, rhi[nt % ML_DV].y}; o[nt] = MFMA16(__builtin_bit_cast(bf16x8, vv), pb, o[nt]);
                        if (nt + ML_DV < 8) { rlo[nt % ML_DV] = *(const LAS v2u*)(vq + (16 * (nt + ML_DV)) * 136); rhi[nt % ML_DV] = *(const LAS v2u*)(vq + (16 * (nt + ML_DV)) * 136 + 16); }
                        __builtin_amdgcn_sched_barrier(0); } }
            }
        }
        __builtin_amdgcn_sched_barrier(0);
#pragma unroll
        for (int mt = 0; mt < 2; ++mt) { const bf16* kp = KT + (size_t)(32 * wave + 16 * mt) * T + tok0 + (unsigned)(fr * T + 8 * fq);
#pragma unroll
            for (int kk = 0; kk < 4; ++kk) akr[mt][kk] = *(const v4u*)(kp + 32 * kk); }
        rsum = rows_sum(rsum);
        { const float den = rsum + g_t * qn; const float inv = 1.0f / fmaxf(fabsf(den), emt);
          bf16* op = HO + (rb + 16 * wave) * DM + hh * 256 + dvh * 128 + (unsigned)(fr * DM + 4 * fq);
#pragma unroll
          for (int np = 0; np < 4; ++np) {
              const v2u A = (v2u){pk2(o[2 * np][0] * inv, o[2 * np][1] * inv), pk2(o[2 * np][2] * inv, o[2 * np][3] * inv)}, B = (v2u){pk2(o[2 * np + 1][0] * inv, o[2 * np + 1][1] * inv), pk2(o[2 * np + 1][2] * inv, o[2 * np + 1][3] * inv)};
              const u32x2s sx = __builtin_amdgcn_permlane16_swap(A.x, B.x, false, false), sy = __builtin_amdgcn_permlane16_swap(A.y, B.y, false, false);
              *(v4u*)(op + ((fq & 1) ? 12 : 0) + 32 * np) = (v4u){sx.x, sy.x, sx.y, sy.y}; } }
        const float ge = arr[640];
        float nsum[2]; bf16x8 ak[2][4];
#pragma unroll
        for (int mt = 0; mt < 2; ++mt) { float ns = 0.f;
#pragma unroll
            for (int kk = 0; kk < 4; ++kk) { const v4u raw = akr[mt][kk]; const f32x4 w0 = *(const LAS f32x4*)(WE + 32 * kk + 8 * fq), w1 = *(const LAS f32x4*)(WE + 32 * kk + 8 * fq + 4);
                const unsigned rw[4] = {raw.x, raw.y, raw.z, raw.w}; float f[8];
#pragma unroll
                for (int e = 0; e < 4; ++e) { f[2 * e] = __uint_as_float(rw[e] << 16); f[2 * e + 1] = __uint_as_float(rw[e] & 0xffff0000u); }
                f[0] *= w0[0]; f[1] *= w0[1]; f[2] *= w0[2]; f[3] *= w0[3]; f[4] *= w1[0]; f[5] *= w1[1]; f[6] *= w1[2]; f[7] *= w1[3];
#pragma unroll
                for (int e = 0; e < 8; ++e) ns += f[e];
                ak[mt][kk] = pack8(f); }
            nsum[mt] = rows_sum(ns); }
        {   const LAS bf16* vb = VTL + fr * 136 + 8 * fq; bf16x8 ring[ML_DC];
#define ML_C_RD(i_) (*(const LAS bf16x8*)(vb + (16 * ((i_) >> 2)) * 136 + 32 * ((i_) & 3)))
#pragma unroll
            for (int d = 0; d < ML_DC; ++d) ring[d] = ML_C_RD(d);
#pragma unroll
            for (int i = 0; i < 32; ++i) { const int nt = i >> 2, kk = i & 3;
                __builtin_amdgcn_sched_barrier(0);
                if (kk == 0) { C[0][nt] = C[0][nt] * ge; C[1][nt] = C[1][nt] * ge; }
                C[0][nt] = MFMA16(ak[0][kk], ring[i % ML_DC], C[0][nt]); C[1][nt] = MFMA16(ak[1][kk], ring[i % ML_DC], C[1][nt]);
                if (i + ML_DC < 32) ring[i % ML_DC] = ML_C_RD(i + ML_DC);
                __builtin_amdgcn_sched_barrier(0); }
#undef ML_C_RD
        }
#pragma unroll
        for (int mt = 0; mt < 2; ++mt) {
#pragma unroll
            for (int nt = 0; nt < 8; ++nt) *(LAS v2u*)(CTL + (16 * nt + fr) * 264 + 32 * wave + 16 * mt + 4 * fq) = (v2u){pk2(C[mt][nt][0], C[mt][nt][1]), pk2(C[mt][nt][2], C[mt][nt][3])};
            if (fq == 0) { const int dk = 32 * wave + 16 * mt + fr; NV[dk] = ge * NV[dk] + nsum[mt]; }
        }
    }
    if (kind == 0) {
        float* oc = a.out + 83918848 + ((size_t)((b * 2 + dir) * 8 + hh) * 256) * 256 + dvh * 128;
#pragma unroll
        for (int mt = 0; mt < 2; ++mt)
#pragma unroll
            for (int nt = 0; nt < 8; ++nt)
#pragma unroll
                for (int e = 0; e < 4; ++e) oc[(unsigned)((32 * wave + 16 * mt + 4 * fq + e) * 256 + 16 * nt + fr)] = C[mt][nt][e];
        if (dvh == 0) { LDS_WAIT(); __syncthreads();
            if (tid < 256) a.out[100696064 + (size_t)((b * 2 + dir) * 8 + hh) * 256 + tid] = NV[tid];
            if (tid == 0) a.out[100761600 + (b * 2 + dir) * 8 + hh] = ((LAS float*)(lds + (((nch - 1) & 1) ? ML2_ARR1 : ML2_ARR0)))[641]; }
    }
}

#ifndef WGM_G1
#define WGM_G1 4
#endif
#ifndef WGM_N8
#define WGM_N8 4
#endif
template <int L, int F, bool FIRST>
__device__ __forceinline__ void ffn_gemm1(const Args& a, LAS unsigned char* lds, int G) {
    pg8::Gemm g{(const bf16*)(a.ws + WS_H), (const bf16*)(a.ws + (F == 0 ? WS_W1A : WS_W1B)), MT, 2 * DFF, DM / 2}; pg8::StaticOrder S; S.init(MT, 2 * DFF, G, (int)blockIdx.x, WGM_G1);
    pg8::EpiGluQ E{a.ws + WS_ACT, (const float*)(a.ws + WS_SA), (const float*)(a.ws + WS_SB1) + (F == 0 ? 0 : 11264)};
    pg8::gemm_phase<pg8::EpiGluQ, pg8::StaticOrder, PG8_ALIGN, PG8_SP2, 1>(lds, g, S, E);
}
template <int L, int F, bool FIRST>
__device__ __forceinline__ void ffn_gemm2(const Args& a, LAS unsigned char* lds, int G) {
    pg8::Gemm g{(const bf16*)(a.ws + WS_ACT), (const bf16*)(a.ws + (F == 0 ? WS_W2A : WS_W2B)), MT, DM, DFF / 2}; pg8::StaticOrder S; S.init(MT, DM, G, (int)blockIdx.x, WGM_N8);
    const float* modg = (const float*)(a.ws + WS_MOD) + (size_t)L * 9 * MODS + (size_t)(F == 0 ? 2 : 8) * DM;
    constexpr bool LAST = (L == 1 && F == 1);
    typedef pg8::EpiRes2<FIRST, LAST, true> EpiT;
    EpiT E{FIRST ? (const void*)a.in[0] : (LAST ? (const void*)(a.ws + WS_XB2) : (const void*)a.out), FIRST ? (const void*)(a.in[1] - (size_t)MP * DM) : nullptr, a.out, modg, (const float*)(a.ws + WS_SB2) + (F == 0 ? 0 : 2048), nullptr, LAST ? DM : XPITCH, XPITCH, 0.5f};
    pg8::gemm_phase<EpiT, pg8::StaticOrder, PG8_ALIGN, PG8_SP2, 2>(lds, g, S, E);
}
#define FFN_NORM norm_pass_q
#define FFN_CONV_ITEMS 416
#define FFN_CONV(l, f, slot, it) ffn_quant_item(a, l, f, slot, it, lds, wave, lane, tid)
__global__ void __launch_bounds__(NTHR, 2) fwd_kernel(Args a) {
    extern __shared__ __attribute__((aligned(16))) unsigned char lds_raw[];
    LAS unsigned char* lds = (LAS unsigned char*)lds_raw;
    const int tid = threadIdx.x, lane = tid & 63, wave = __builtin_amdgcn_readfirstlane(tid >> 6);
    const int G = gridDim.x;
    volatile LAS unsigned* MISC = (volatile LAS unsigned*)(lds + MISC_OFF);
    if (tid < 64) MISC[tid] = 0u;
    __syncthreads();
#if MK_ONE_LAUNCH
    XcdBarrier bar = xcd_barrier_post((unsigned*)(a.ws + WS_CTL) + CW_BAR, MISC + 8);
#define GRID_BAR() xcd_barrier(bar)
#else
#define GRID_BAR() do { } while (0)
#endif
    const int lo = a.ph_lo, hi = a.ph_hi;
#define IN(k) (lo <= (k) && (k) < hi)
#define SEAM(k) do { if (IN(k) && IN((k) + 1)) GRID_BAR(); } while (0)
    const int NGW = G * NWAVES, gw = blockIdx.x * NWAVES + wave;

    if (IN(0)) { phase_p0(a, lds, G, wave, lane, tid); } SEAM(0);
    if (IN(1)) { FFN_NORM<true>(a, 0, 0, G, wave, lane); } SEAM(1);
    if (IN(2)) { ffn_gemm1<0, 0, true>(a, lds, G); } SEAM(2);
    if (IN(3)) { ffn_gemm2<0, 0, true>(a, lds, G); } SEAM(3);
    if (IN(4)) { norm_pass<false>(a, 0, 1, G, wave, lane);
        for (int it = blockIdx.x; it < FFN_CONV_ITEMS; it += G) FFN_CONV(1, 0, 0, it); }
    if (IN(5)) { pg8::Gemm g{(const bf16*)(a.ws + WS_H), (const bf16*)(a.ws + WS_WINAB), MT, 5120, DM}; pg8::StaticOrder S; S.init(MT, 5120, G, (int)blockIdx.x);
        pg8::EpiBf16<0> E{(bf16*)(a.ws + WS_Z), 5120, nullptr, 0, 0, 1.f};
        pg8::gemm_phase<pg8::EpiBf16<0>, pg8::StaticOrder, PG8_ALIGN, PG8_SP2>(lds, g, S, E); } SEAM(5);
    if (IN(6)) { for (int it = blockIdx.x; it < 1152; it += G) lru_item<1>(a, it >> 3, it & 7, lds, wave, lane, tid);
        { int ib, ni; tail_ids(1152, G, ib, ni); if (ib >= 0) for (int it = ib; it < 576; it += ni) ab_post_item(a, it, lds, wave, lane); } } SEAM(6);
    if (IN(7)) { { for (int it = blockIdx.x; it < 1152; it += G) lru_item<2>(a, it >> 3, it & 7, lds, wave, lane, tid); }
        { const int xu = (G % 8 == 0) ? ((int)blockIdx.x % 8) * (G / 8) + (int)blockIdx.x / 8 : (int)blockIdx.x;
          for (int u = xu; u < 2048; u += G) attn_block(a, 1, u >> 8, (u >> 5) & 7, u & 31, lds, wave, lane, tid);
        { int ib, ni; tail_ids(1152, G, ib, ni); if (ib >= 0) for (int u = ib; u < 256; u += ni) attn_block(a, 0, u >> 4, (u >> 1) & 7, u & 1, lds, wave, lane, tid); } } } SEAM(7);
    if (IN(8)) { pg8::Gemm g{(const bf16*)(a.ws + WS_H), (const bf16*)(a.ws + WS_WOUTAB), MT, DM, DM}; pg8::StaticOrder S; S.init(MT, DM, G, (int)blockIdx.x, WGM_N8);
        typedef pg8::EpiRes2<false, false, false> EpiT; EpiT E{a.out, nullptr, a.out, (const float*)(a.ws + WS_MOD) + 5 * DM, nullptr, nullptr, XPITCH, XPITCH, 1.0f};
        pg8::gemm_phase<EpiT, pg8::StaticOrder, PG8_ALIGN, PG8_SP2>(lds, g, S, E); } SEAM(8);
    if (IN(9)) { FFN_NORM<false>(a, 0, 2, G, wave, lane); } SEAM(9);
    if (IN(10)) { ffn_gemm1<0, 1, false>(a, lds, G); } SEAM(10);
    if (IN(11)) { ffn_gemm2<0, 1, false>(a, lds, G); } SEAM(11);
    if (IN(12)) { FFN_NORM<false>(a, 1, 0, G, wave, lane);
        for (int it = blockIdx.x; it < FFN_CONV_ITEMS; it += G) FFN_CONV(1, 1, 1, it); }
    if (IN(13)) { ffn_gemm1<1, 0, false>(a, lds, G); } SEAM(13);
    if (IN(14)) { ffn_gemm2<1, 0, false>(a, lds, G); } SEAM(14);
    if (IN(15)) { norm_pass_dual<false>(a, 1, 1, G, wave, lane); } SEAM(15);
    if (IN(16)) {
        { pg8::Gemm g{(const bf16*)(a.ws + WS_H), (const bf16*)(a.ws + WS_WINC), MT, 4352, DM}; pg8::StaticOrder S; S.init(MT, 4352, G, (int)blockIdx.x);
          typedef pg8::EpiProj<false, 1> EpiT; EpiT E{(bf16*)(a.ws + WS_PL), (float*)(a.ws + WS_GATES), nullptr, nullptr};
          pg8::gemm_phase<EpiT, pg8::StaticOrder, PG8_ALIGN, PG8_SP2>(lds, g, S, E); }
        { pg8::Gemm g{(const bf16*)(a.ws + WS_H8M), (const bf16*)(a.ws + WS_WQC), MT, 4096, DM / 2}; pg8::StaticOrder S; S.init(MT, 4096, G, G - 1 - (int)blockIdx.x);
          typedef pg8::EpiProj<true, 1> EpiT; EpiT E{(bf16*)(a.ws + WS_PL), nullptr, (const float*)(a.ws + WS_SA), (const float*)(a.ws + WS_SBQC)};
          pg8::gemm_phase<EpiT, pg8::StaticOrder, PG8_ALIGN, PG8_SP2, 1>(lds, g, S, E); } } SEAM(16);
    if (IN(17)) { for (int it = blockIdx.x; it < 576; it += G) c_post_item(a, it, lds, wave, lane, tid); } SEAM(17);
    if (IN(18)) {
        const int xu = (G % 8 == 0) ? ((int)blockIdx.x % 8) * (G / 8) + (int)blockIdx.x / 8 : (int)blockIdx.x;
        for (int u = xu; u < 256; u += G) mlstm_unit2(a, 1, u >> 5, (u >> 2) & 7, (u >> 1) & 1, u & 1, lds, wave, lane, tid);
        for (int u = xu; u < 512; u += G) mlstm_unit2(a, 0, u >> 5, (u >> 2) & 7, (u >> 1) & 1, u & 1, lds, wave, lane, tid); } SEAM(18);
    if (IN(19)) { c_final_pass(a, G, wave, lane); } SEAM(19);
    if (IN(20)) { pg8::Gemm g{(const bf16*)(a.ws + WS_H), (const bf16*)(a.ws + WS_WQOC), MT, DM, DM / 2}; pg8::StaticOrder S; S.init(MT, DM, G, (int)blockIdx.x, WGM_N8);
        typedef pg8::EpiRes2<false, false, true, true> EpiT; EpiT E{a.out, nullptr, a.ws + WS_XB2, (const float*)(a.ws + WS_MOD) + (size_t)9 * MODS + 5 * DM, (const float*)(a.ws + WS_SBOC), (const float*)(a.ws + WS_SA), XPITCH, DM, 1.0f};
        pg8::gemm_phase<EpiT, pg8::StaticOrder, PG8_ALIGN, PG8_SP2, 1>(lds, g, S, E); } SEAM(20);
    if (IN(21)) { FFN_NORM<false, true>(a, 1, 2, G, wave, lane); } SEAM(21);
    if (IN(22)) { ffn_gemm1<1, 1, false>(a, lds, G); } SEAM(22);
    if (IN(23)) { ffn_gemm2<1, 1, false>(a, lds, G); }
#undef IN
#undef SEAM
}

extern "C" void kernel_launch(void* const* d_in, const int* in_sizes, int n_in, void* d_out, int out_size, void* d_ws, size_t ws_size, hipStream_t stream) {
    static int grid = 0;
    if (grid == 0) {
        if (n_in != 32 || out_size != 100761856 || ws_size < WS_END) { fprintf(stderr, "kernel_launch: unexpected problem (n_in %d, out %d, ws %zu < %zu)\n", n_in, out_size, ws_size, (size_t)WS_END); grid = -1; return; }
        int dev = 0, cus = 0, per_cu = 0;
        if (hipGetDevice(&dev) != hipSuccess || hipDeviceGetAttribute(&cus, hipDeviceAttributeMultiprocessorCount, dev) != hipSuccess) { grid = -1; return; }
        if (hipFuncSetAttribute((const void*)fwd_kernel, hipFuncAttributeMaxDynamicSharedMemorySize, LDS_BYTES) != hipSuccess) { fprintf(stderr, "kernel_launch: hipFuncSetAttribute failed\n"); grid = -1; return; }
        if (hipOccupancyMaxActiveBlocksPerMultiprocessor(&per_cu, (const void*)fwd_kernel, NTHR, LDS_BYTES) != hipSuccess || per_cu < 1) fprintf(stderr, "kernel_launch: occupancy query says %d\n", per_cu);
        (void)hipGetLastError();
        grid = cus;
    }
    if (grid < 0) return;
    (void)hipMemsetAsync((char*)d_ws + WS_CTL, 0, CTL_ZERO_BYTES, stream);
    Args a{};
    for (int i = 0; i < 32; ++i) a.in[i] = (const float*)d_in[i];
    a.out = (float*)d_out; a.ws = (unsigned char*)d_ws;
#if MK_ONE_LAUNCH
    a.ph_lo = 0; a.ph_hi = N_PHASES;
    hipLaunchKernelGGL(fwd_kernel, dim3(grid), dim3(NTHR), LDS_BYTES, stream, a);
#else
    for (int p = 0; p < N_PHASES; ++p) { a.ph_lo = p; a.ph_hi = p + 1; hipLaunchKernelGGL(fwd_kernel, dim3(grid), dim3(NTHR), LDS_BYTES, stream, a); }
#endif
}
```
